# Optimizing an MI355X kernel written in HIP

```python
import jax, jax.numpy as jnp
from jax import lax
import numpy as np

D_MODEL = 2048
BATCH = 1
SEQ = 8192
DEPTH = 4

N_MIXERS = 2
N_HEADS = 16
HEAD_DIM = D_MODEL // N_HEADS
ROT_DIM = HEAD_DIM // 4
ROPE_THETA = 500000.0
EPS = 1e-6
A_KV_HEADS = 4
IDX_HEADS = 16
IDX_DIM = 64
IDX_ROT_DIM = IDX_DIM // 4
IDX_TOPK_MAX = 256
A_QBLOCK = 128
A_IN = N_HEADS * HEAD_DIM + 2 * A_KV_HEADS * HEAD_DIM + IDX_HEADS * IDX_DIM + IDX_DIM + IDX_HEADS
MOBA_BLOCK = 256
MOBA_TOPK = 3
B_QBLOCK = 32
B_IN = 3 * N_HEADS * HEAD_DIM
D_FF = -(-8 * D_MODEL // (3 * 256)) * 256
N_A = (DEPTH + 1) // 2
N_B = DEPTH // 2

kernel_name = "hybrid_dsa_moba_sandwich_adaln"


def rms_norm(x, g):
    xf = x.astype(jnp.float32)
    y = xf * lax.rsqrt(jnp.mean(xf * xf, axis=-1, keepdims=True) + EPS)
    return (y * g.astype(jnp.float32)).astype(x.dtype)


def partial_rope(x, positions, rot_dim):
    half = rot_dim // 2
    inv_freq = ROPE_THETA ** (-jnp.arange(half, dtype=jnp.float32) / half)
    ang = positions.astype(jnp.float32)[:, :, None] * inv_freq
    cos = jnp.cos(ang)[:, :, None, :]
    sin = jnp.sin(ang)[:, :, None, :]
    xf = x.astype(jnp.float32)
    x1 = xf[..., :half]
    x2 = xf[..., half:rot_dim]
    out = jnp.concatenate([x1 * cos - x2 * sin, x2 * cos + x1 * sin, xf[..., rot_dim:]], axis=-1)
    return out.astype(x.dtype)


def dsa_mixer(h, positions, w_in, w_o):
    B, S, _ = h.shape
    sizes = [N_HEADS * HEAD_DIM, A_KV_HEADS * HEAD_DIM, A_KV_HEADS * HEAD_DIM,
             IDX_HEADS * IDX_DIM, IDX_DIM]
    cuts = [int(v) for v in np.cumsum(sizes)]
    q, k, v, qi, ki, wi = jnp.split(h @ w_in, cuts, axis=-1)
    q = partial_rope(q.reshape(B, S, N_HEADS, HEAD_DIM), positions, ROT_DIM)
    k = partial_rope(k.reshape(B, S, A_KV_HEADS, HEAD_DIM), positions, ROT_DIM)
    v = v.reshape(B, S, A_KV_HEADS, HEAD_DIM)
    qi = partial_rope(qi.reshape(B, S, IDX_HEADS, IDX_DIM), positions, IDX_ROT_DIM)
    ki = partial_rope(ki.reshape(B, S, 1, IDX_DIM), positions, IDX_ROT_DIM)[:, :, 0]
    wi = wi.astype(jnp.float32) * (IDX_HEADS ** -0.5 * IDX_DIM ** -0.5)
    n_sel = min(IDX_TOPK_MAX, S // 4)
    rep = N_HEADS // A_KV_HEADS
    scale = HEAD_DIM ** -0.5
    key_pos = jnp.arange(S)

    def block(i):
        start = i * A_QBLOCK
        qpos = start + jnp.arange(A_QBLOCK)
        qb = lax.dynamic_slice_in_dim(q, start, A_QBLOCK, axis=1)
        qib = lax.dynamic_slice_in_dim(qi, start, A_QBLOCK, axis=1)
        wib = lax.dynamic_slice_in_dim(wi, start, A_QBLOCK, axis=1)
        dots = jnp.einsum('bqhd,bsd->bqhs', qib, ki, preferred_element_type=jnp.float32)
        isc = jnp.einsum('bqhs,bqh->bqs', jax.nn.relu(dots), wib)
        causal = key_pos[None, :] <= qpos[:, None]
        isc = jnp.where(causal[None], isc, -jnp.inf)
        _, sel = lax.top_k(isc, n_sel)
        valid = sel <= qpos[None, :, None]
        kg = jax.vmap(lambda kb, ib: kb[ib])(k, sel)
        vg = jax.vmap(lambda vb, ib: vb[ib])(v, sel)
        qg = qb.reshape(B, A_QBLOCK, A_KV_HEADS, rep, HEAD_DIM)
        logits = jnp.einsum('bqgrd,bqkgd->bqgrk', qg, kg, preferred_element_type=jnp.float32) * scale
        logits = jnp.where(valid[:, :, None, None, :], logits, -jnp.inf)
        p = jax.nn.softmax(logits, axis=-1)
        o = jnp.einsum('bqgrk,bqkgd->bqgrd', p.astype(vg.dtype), vg)
        return o.reshape(B, A_QBLOCK, N_HEADS * HEAD_DIM)

    out = lax.map(block, jnp.arange(S // A_QBLOCK))
    out = jnp.transpose(out, (1, 0, 2, 3)).reshape(B, S, N_HEADS * HEAD_DIM)
    return out @ w_o


def moba_mixer(h, positions, w_in, w_o):
    B, S, _ = h.shape
    q, k, v = jnp.split(h @ w_in, 3, axis=-1)
    q = partial_rope(q.reshape(B, S, N_HEADS, HEAD_DIM), positions, ROT_DIM)
    k = partial_rope(k.reshape(B, S, N_HEADS, HEAD_DIM), positions, ROT_DIM)
    v = v.reshape(B, S, N_HEADS, HEAD_DIM)
    nb = -(-S // MOBA_BLOCK)
    pad = nb * MOBA_BLOCK - S
    kp = jnp.pad(k, ((0, 0), (0, pad), (0, 0), (0, 0)))
    vp = jnp.pad(v, ((0, 0), (0, pad), (0, 0), (0, 0)))
    kblk = kp.reshape(B, nb, MOBA_BLOCK, N_HEADS, HEAD_DIM)
    vblk = vp.reshape(B, nb, MOBA_BLOCK, N_HEADS, HEAD_DIM)
    kmean = jnp.mean(kblk.astype(jnp.float32), axis=2)
    k_bh = jnp.transpose(kblk, (0, 3, 1, 2, 4))
    v_bh = jnp.transpose(vblk, (0, 3, 1, 2, 4))
    n_sel = min(MOBA_TOPK, nb)
    scale = HEAD_DIM ** -0.5
    blk_ids = jnp.arange(nb)
    bi = jnp.arange(B)[:, None, None, None]
    hi = jnp.arange(N_HEADS)[None, None, :, None]

    def block(i):
        start = i * B_QBLOCK
        qpos = start + jnp.arange(B_QBLOCK)
        j = start // MOBA_BLOCK
        qb = lax.dynamic_slice_in_dim(q, start, B_QBLOCK, axis=1)
        gate = jnp.einsum('bqhd,bnhd->bqhn', qb.astype(jnp.float32), kmean)
        gate = jnp.where((blk_ids < j)[None, None, None, :], gate, -jnp.inf)
        _, sel = lax.top_k(gate, n_sel)
        sel_valid = sel < j
        kg = k_bh[bi, hi, sel]
        vg = v_bh[bi, hi, sel]
        past = jnp.einsum('bqhd,bqhnkd->bqhnk', qb, kg, preferred_element_type=jnp.float32) * scale
        past = jnp.where(sel_valid[..., None], past, -jnp.inf).reshape(B, B_QBLOCK, N_HEADS, n_sel * MOBA_BLOCK)
        own_k = lax.dynamic_slice_in_dim(kp, j * MOBA_BLOCK, MOBA_BLOCK, axis=1)
        own_v = lax.dynamic_slice_in_dim(vp, j * MOBA_BLOCK, MOBA_BLOCK, axis=1)
        own = jnp.einsum('bqhd,bkhd->bqhk', qb, own_k, preferred_element_type=jnp.float32) * scale
        own_pos = j * MOBA_BLOCK + jnp.arange(MOBA_BLOCK)
        own = jnp.where((own_pos[None, :] <= qpos[:, None])[None, :, None, :], own, -jnp.inf)
        p = jax.nn.softmax(jnp.concatenate([past, own], axis=-1), axis=-1)
        p_past = p[..., :n_sel * MOBA_BLOCK].reshape(B, B_QBLOCK, N_HEADS, n_sel, MOBA_BLOCK).astype(vg.dtype)
        p_own = p[..., n_sel * MOBA_BLOCK:].astype(own_v.dtype)
        o = (jnp.einsum('bqhnk,bqhnkd->bqhd', p_past, vg)
             + jnp.einsum('bqhk,bkhd->bqhd', p_own, own_v))
        return o.reshape(B, B_QBLOCK, N_HEADS * HEAD_DIM)

    out = lax.map(block, jnp.arange(S // B_QBLOCK))
    out = jnp.transpose(out, (1, 0, 2, 3)).reshape(B, S, N_HEADS * HEAD_DIM)
    return out @ w_o


def swiglu(h, w_in, w_out):
    u, g = jnp.split(h @ w_in, 2, axis=-1)
    return (jax.nn.silu(g) * u) @ w_out


def setup_inputs(seed: int = 0) -> dict:
    key = jax.random.key(seed)
    ks = jax.random.split(key, 13)
    f32 = jnp.float32
    hd = N_HEADS * HEAD_DIM
    x = jax.random.normal(ks[0], (BATCH, SEQ, D_MODEL), f32)
    c = jax.random.normal(ks[1], (BATCH, D_MODEL), f32)
    start = jax.random.randint(ks[2], (BATCH, 1), 0, 4096, dtype=jnp.int32)
    positions = start + jnp.arange(SEQ, dtype=jnp.int32)[None, :]
    a_w_in = jax.random.normal(ks[3], (N_A, D_MODEL, A_IN), f32) * D_MODEL ** -0.5
    a_w_o = jax.random.normal(ks[4], (N_A, hd, D_MODEL), f32) * hd ** -0.5
    b_w_in = jax.random.normal(ks[5], (N_B, D_MODEL, B_IN), f32) * D_MODEL ** -0.5
    b_w_o = jax.random.normal(ks[6], (N_B, hd, D_MODEL), f32) * hd ** -0.5
    ada_w = jax.random.normal(ks[7], (DEPTH, D_MODEL, 6 * D_MODEL), f32) * (0.5 * D_MODEL ** -0.5)
    ada_b = jax.random.normal(ks[8], (DEPTH, 6 * D_MODEL), f32) * 0.01
    norm_g = 1.0 + 0.02 * jax.random.normal(ks[9], (DEPTH, 4, D_MODEL), f32)
    ffn_w_in = jax.random.normal(ks[10], (DEPTH, D_MODEL, 2 * D_FF), f32) * D_MODEL ** -0.5
    ffn_w_out = jax.random.normal(ks[11], (DEPTH, D_FF, D_MODEL), f32) * D_FF ** -0.5
    return {"x": x, "c": c, "positions": positions,
            "a_w_in": a_w_in, "a_w_o": a_w_o, "b_w_in": b_w_in, "b_w_o": b_w_o,
            "ada_w": ada_w, "ada_b": ada_b, "norm_g": norm_g,
            "ffn_w_in": ffn_w_in, "ffn_w_out": ffn_w_out}


def reference(x, c, positions, a_w_in, a_w_o, b_w_in, b_w_o, ada_w, ada_b, norm_g, ffn_w_in, ffn_w_out):
    c_act = jax.nn.silu(c)
    for i in range(DEPTH):
        mod = (c_act @ ada_w[i] + ada_b[i])[:, None, :]
        sh1, sc1, g1, sh2, sc2, g2 = jnp.split(mod, 6, axis=-1)
        h = rms_norm(x, norm_g[i, 0]) * (1 + sc1) + sh1
        if i % N_MIXERS == 0:
            y = dsa_mixer(h, positions, a_w_in[i // 2], a_w_o[i // 2])
        else:
            y = moba_mixer(h, positions, b_w_in[i // 2], b_w_o[i // 2])
        x = x + g1 * rms_norm(y, norm_g[i, 1])
        h = rms_norm(x, norm_g[i, 2]) * (1 + sc2) + sh2
        y = swiglu(h, ffn_w_in[i], ffn_w_out[i])
        x = x + g2 * rms_norm(y, norm_g[i, 3])
    return x
```

```cpp
#include <hip/hip_runtime.h>
#include <cstdio>
#include <cstdint>

#define LAS __attribute__((address_space(3)))
typedef unsigned short f16_t;
typedef _Float16 f16x8 __attribute__((ext_vector_type(8)));
typedef _Float16 f16x4 __attribute__((ext_vector_type(4)));
typedef _Float16 f16x2 __attribute__((ext_vector_type(2)));
typedef float f32x2 __attribute__((ext_vector_type(2)));
typedef float f32x4 __attribute__((ext_vector_type(4)));
typedef unsigned u32x4 __attribute__((ext_vector_type(4)));
typedef unsigned u32x2 __attribute__((ext_vector_type(2)));

constexpr int S_ = 8192, D_ = 2048, NH = 16, HD = 128, DFF = 5632;
constexpr int A_IN = 4176, A_INP = 4352, B_IN = 6144;
constexpr int NSEL = 256;
constexpr float EPS = 1e-6f;

__device__ __forceinline__ unsigned pk_f16(float lo, float hi) { f16x2 r = __builtin_convertvector((f32x2){lo, hi}, f16x2); return __builtin_bit_cast(unsigned, r); }
__device__ __forceinline__ float h2f(f16_t v) { return (float)__builtin_bit_cast(_Float16, v); }
__device__ __forceinline__ float wave_sum(float v) {
#pragma unroll
    for (int o = 1; o < 64; o <<= 1) v += __shfl_xor(v, o);
    return v;
}
__device__ __forceinline__ float wave_max(float v) {
#pragma unroll
    for (int o = 1; o < 64; o <<= 1) v = fmaxf(v, __shfl_xor(v, o));
    return v;
}

namespace pg8 {
constexpr int BM = 256, BK = 64, HALF = 128, HTB = HALF * BK * 2, STAGE_BYTES = 8 * HTB, NXCD = 8, WGM = 8;
__host__ __device__ __forceinline__ int lds_byte(int r, int c) { const int st = (r >> 4) * 2 + (c >> 5), rr = r & 15, cc = c & 31, ob = rr * 64 + cc * 2; return st * 1024 + (ob ^ (((ob >> 9) & 1) << 5)); }
__host__ __device__ __forceinline__ void stage_rc(int b, int& R, int& C) { const int st = b / 1024, sb = b % 1024, swz = sb ^ (((sb >> 9) & 1) << 5); R = (st >> 1) * 16 + swz / 64; C = (st & 1) * 32 + (swz % 64) / 2; }
__host__ __device__ __forceinline__ int perm32(int rho) { const int n = rho >> 4, i = rho & 15; return 8 * (i >> 2) + 4 * n + (i & 3); }
struct Unit { int pm, pn; };
struct Gemm { const f16_t* A; const f16_t* Bt; int M, N, K, pad; };
struct StaticOrder {
    int nM, nN, nwg, G, c;
    __host__ __device__ void init(int M, int N, int G_, int c_) { nM = M / BM; nN = N / BM; nwg = nM * nN; G = G_; c = c_; }
    __host__ __device__ bool next(int i, Unit& u) const {
        const long L = (long)i * G + c; if (L >= nwg) return false;
        int wgid = (int)L; { const int q = nwg / NXCD, r = nwg % NXCD, xcd = wgid % NXCD, off = wgid / NXCD; wgid = (xcd < r ? xcd * (q + 1) : r * (q + 1) + (xcd - r) * q) + off; }
        const int nig = WGM * nN, gid = wgid / nig, fm = gid * WGM, gsz = (nM - fm) < WGM ? (nM - fm) : WGM;
        u.pm = fm + ((wgid % nig) % gsz); u.pn = (wgid % nig) / gsz; return true;
    }
    __device__ __forceinline__ void a_ready(const Unit&) const {}
    __device__ __forceinline__ void done(const Unit&) const {}
};

struct EpiF32 {
    static constexpr bool PERM = false, AFTER_DRAIN = false;
    float* C; int ldc, pad;
    __device__ __forceinline__ void operator()(const f32x4 (&acc)[2][2][4][2], const Unit& u, int wr, int wc, int fr, int fq) const {
        const int row0 = u.pm * BM + wr * 64 + fr, col0 = u.pn * BM + wc * 32 + 4 * fq;
#pragma unroll
        for (int ai = 0; ai < 2; ++ai)
#pragma unroll
            for (int m = 0; m < 4; ++m) { float* rowp = C + (size_t)(row0 + ai * HALF + m * 16) * ldc + col0;
#pragma unroll
                for (int bj = 0; bj < 2; ++bj)
#pragma unroll
                    for (int n = 0; n < 2; ++n) *(f32x4*)(rowp + bj * HALF + n * 16) = acc[ai][bj][m][n]; }
    }
};
struct EpiSwiglu {
    static constexpr bool PERM = true, AFTER_DRAIN = false;
    f16_t* O; int ldc, pad;
    __device__ __forceinline__ void operator()(const f32x4 (&acc)[2][2][4][2], const Unit& u, int wr, int wc, int fr, int fq) const {
        const int row0 = u.pm * BM + wr * 64 + fr, col0 = u.pn * HALF + wc * 32 + 8 * fq;
#pragma unroll
        for (int ai = 0; ai < 2; ++ai)
#pragma unroll
            for (int m = 0; m < 4; ++m) { f16_t* rowp = O + (size_t)(row0 + ai * HALF + m * 16) * ldc + col0;
                float o[8];
#pragma unroll
                for (int n = 0; n < 2; ++n)
#pragma unroll
                    for (int j = 0; j < 4; ++j) { const float uu = acc[ai][0][m][n][j], g = acc[ai][1][m][n][j]; o[4 * n + j] = uu * g * __builtin_amdgcn_rcpf(1.0f + __expf(-g)); }
                u32x4 w; w.x = pk_f16(o[0], o[1]); w.y = pk_f16(o[2], o[3]); w.z = pk_f16(o[4], o[5]); w.w = pk_f16(o[6], o[7]);
                *(u32x4*)rowp = w; }
    }
};
__device__ __forceinline__ void rope8(f32x4& v0, f32x4& v1, const f32x4 c0, const f32x4 c1, const f32x4 s0, const f32x4 s1, float sgn, int xm, bool apply) {
#pragma unroll
    for (int j = 0; j < 4; ++j) {
        const float o0 = __shfl_xor(v0[j], xm), o1 = __shfl_xor(v1[j], xm);
        if (apply) { v0[j] = v0[j] * c0[j] + sgn * o0 * s0[j]; v1[j] = v1[j] * c1[j] + sgn * o1 * s1[j]; }
    }
}
template <int MODE> struct EpiIn {
    static constexpr bool PERM = true, AFTER_DRAIN = false;
    f16_t *Q, *K, *V, *QI, *KI; float* WI;
    const float *rcA, *rsA, *rcI, *rsI;
    __device__ __forceinline__ void operator()(const f32x4 (&acc)[2][2][4][2], const Unit& u, int wr, int wc, int fr, int fq) const {
        const int row0 = u.pm * BM + wr * 64 + fr; const int pn = u.pn;
        constexpr int NQ = 8, NK = (MODE == 0) ? 2 : 8, NV = (MODE == 0) ? 2 : 8;
        if (pn < NQ + NK + NV) {
            f16_t* base; int ldc, colt; bool rope;
            if (pn < NQ) { base = Q; ldc = 2048; colt = pn * BM; rope = true; }
            else if (pn < NQ + NK) { base = K; ldc = NK * BM; colt = (pn - NQ) * BM; rope = true; }
            else { base = V; ldc = NV * BM; colt = (pn - NQ - NK) * BM; rope = false; }
            const int col0 = colt + wc * 32 + 8 * fq; const bool dorope = rope && (wc == 0);
            const float sgn = (fq < 2) ? -1.f : 1.f;
#pragma unroll
            for (int ai = 0; ai < 2; ++ai)
#pragma unroll
                for (int m = 0; m < 4; ++m) { const int row = row0 + ai * HALF + m * 16; f16_t* rowp = base + (size_t)row * ldc + col0;
                    f32x4 c0, c1, s0, s1;
                    if (dorope) { const float* cp = rcA + (size_t)row * 16 + 8 * (fq & 1); const float* sp = rsA + (size_t)row * 16 + 8 * (fq & 1);
                        c0 = *(const f32x4*)cp; c1 = *(const f32x4*)(cp + 4); s0 = *(const f32x4*)sp; s1 = *(const f32x4*)(sp + 4); }
#pragma unroll
                    for (int bj = 0; bj < 2; ++bj) { f32x4 v0 = acc[ai][bj][m][0], v1 = acc[ai][bj][m][1];
                        if (dorope) rope8(v0, v1, c0, c1, s0, s1, sgn, 32, true);
                        u32x4 w; w.x = pk_f16(v0[0], v0[1]); w.y = pk_f16(v0[2], v0[3]); w.z = pk_f16(v1[0], v1[1]); w.w = pk_f16(v1[2], v1[3]);
                        *(u32x4*)(rowp + bj * HALF) = w; } }
        } else if (MODE == 0 && pn < 16) {
            const int col0 = (pn - 12) * BM + wc * 32 + 8 * fq; const bool ropew = ((wc & 1) == 0); const bool app = fq < 2; const float sgn = (fq == 0) ? -1.f : 1.f;
#pragma unroll
            for (int ai = 0; ai < 2; ++ai)
#pragma unroll
                for (int m = 0; m < 4; ++m) { const int row = row0 + ai * HALF + m * 16; f16_t* rowp = QI + (size_t)row * 1024 + col0;
                    f32x4 c0, c1, s0, s1;
                    if (ropew) { const float* cp = rcI + (size_t)row * 8; const float* sp = rsI + (size_t)row * 8; c0 = *(const f32x4*)cp; c1 = *(const f32x4*)(cp + 4); s0 = *(const f32x4*)sp; s1 = *(const f32x4*)(sp + 4); }
#pragma unroll
                    for (int bj = 0; bj < 2; ++bj) { f32x4 v0 = acc[ai][bj][m][0], v1 = acc[ai][bj][m][1];
                        if (ropew) rope8(v0, v1, c0, c1, s0, s1, sgn, 16, app);
                        u32x4 w; w.x = pk_f16(v0[0], v0[1]); w.y = pk_f16(v0[2], v0[3]); w.z = pk_f16(v1[0], v1[1]); w.w = pk_f16(v1[2], v1[3]);
                        *(u32x4*)(rowp + bj * HALF) = w; } }
        } else if (MODE == 0) {
            const bool ropew = (wc == 0); const bool app = fq < 2; const float sgn = (fq == 0) ? -1.f : 1.f;
#pragma unroll
            for (int ai = 0; ai < 2; ++ai)
#pragma unroll
                for (int m = 0; m < 4; ++m) { const int row = row0 + ai * HALF + m * 16;
                    f32x4 v0 = acc[ai][0][m][0], v1 = acc[ai][0][m][1];
                    if (ropew) { const float* cp = rcI + (size_t)row * 8; const float* sp = rsI + (size_t)row * 8;
                        const f32x4 c0 = *(const f32x4*)cp, c1 = *(const f32x4*)(cp + 4), s0 = *(const f32x4*)sp, s1 = *(const f32x4*)(sp + 4);
                        rope8(v0, v1, c0, c1, s0, s1, sgn, 16, app); }
                    if (wc < 2) { u32x4 w; w.x = pk_f16(v0[0], v0[1]); w.y = pk_f16(v0[2], v0[3]); w.z = pk_f16(v1[0], v1[1]); w.w = pk_f16(v1[2], v1[3]);
                        *(u32x4*)(KI + (size_t)row * 64 + wc * 32 + 8 * fq) = w; }
                    else if (wc == 2 && fq < 2) { float* wp = WI + (size_t)row * 16 + 8 * fq; *(f32x4*)wp = v0 * 0.03125f; *(f32x4*)(wp + 4) = v1 * 0.03125f; } }
        }
    }
};

template <class Epi, class Sched, bool ALIGN_EPI>
__device__ __forceinline__ void gemm_phase(LAS unsigned char* lds, const Gemm g, const Sched& S, const Epi& E) {
    const int tid = threadIdx.x, wid = __builtin_amdgcn_readfirstlane(tid >> 6), lane = tid & 63, wr = wid >> 2, wc = wid & 3, fr = lane & 15, fq = lane >> 4;
    const int K = g.K, nt = K / BK;
    unsigned voffA[2], voffB[2];
#pragma unroll
    for (int i = 0; i < 2; ++i) { int R, C; stage_rc(tid * 16 + i * 8192, R, C); const int Rb = Epi::PERM ? ((R & ~31) + perm32(R & 31)) : R;
        voffA[i] = (unsigned)(R * K + C) * 2u; voffB[i] = (unsigned)(Rb * K + C) * 2u; }
    const size_t kstep = (size_t)(BK * 2);
    const size_t hstep = (size_t)HALF * K * 2;
    const size_t tstep = 2 * hstep;
    const unsigned ldsw = (unsigned)wid * 1024u;
    const int aoff = lds_byte(wr * 64 + fr, fq * 8), boff = lds_byte(wc * 32 + fr, fq * 8);
#define PG8_SA(b, h) (((b) * 2 + (h)) * HTB)
#define PG8_SB(b, h) ((4 + (b) * 2 + (h)) * HTB)
#define PG8_STAGE(bufoff, gbase, voff) do { _Pragma("unroll") for (int _i = 0; _i < 2; ++_i) \
        __builtin_amdgcn_global_load_lds((const unsigned*)((const char*)(gbase) + (voff)[_i]), (LAS unsigned*)(lds + (bufoff) + ldsw + _i * 8192), 16, 0, 0); } while (0)
#define PG8_LDA(dst, b, h) do { _Pragma("unroll") for (int m = 0; m < 4; ++m) _Pragma("unroll") for (int k = 0; k < 2; ++k) dst[m][k] = *(const LAS f16x8*)(lds + PG8_SA(b, h) + aoff + m * 2048 + k * 1024); } while (0)
#define PG8_LDB(dst, b, h) do { _Pragma("unroll") for (int n = 0; n < 2; ++n) _Pragma("unroll") for (int k = 0; k < 2; ++k) dst[n][k] = *(const LAS f16x8*)(lds + PG8_SB(b, h) + boff + n * 2048 + k * 1024); } while (0)
#define PG8_MMA(ai, bj, At, Bt) do { __builtin_amdgcn_s_setprio(1); _Pragma("unroll") for (int m = 0; m < 4; ++m) _Pragma("unroll") for (int n = 0; n < 2; ++n) _Pragma("unroll") for (int k = 0; k < 2; ++k) \
        acc[ai][bj][m][n] = __builtin_amdgcn_mfma_f32_16x16x32_f16(Bt[n][k], At[m][k], acc[ai][bj][m][n], 0, 0, 0); __builtin_amdgcn_s_setprio(0); } while (0)
#define PG8_WAIT_V(n) asm volatile("s_waitcnt vmcnt(" #n ")" ::: "memory")
#define PG8_WAIT_L(n) asm volatile("s_waitcnt lgkmcnt(" #n ")" ::: "memory")
#define PG8_BAR __builtin_amdgcn_s_barrier()
#define PG8_SCHED __builtin_amdgcn_sched_barrier(0)
    Unit cur, nxt; int ui = 0;
    if (!S.next(0, cur)) return;
    f32x4 acc[2][2][4][2];
#pragma unroll
    for (int a = 0; a < 2; ++a)
#pragma unroll
        for (int b = 0; b < 2; ++b)
#pragma unroll
            for (int m = 0; m < 4; ++m)
#pragma unroll
                for (int n = 0; n < 2; ++n) acc[a][b][m][n] = (f32x4){0.f, 0.f, 0.f, 0.f};
    f16x8 At[4][2], B0[2][2], B1[2][2];
    const char* cA = (const char*)g.A + (size_t)cur.pm * tstep; const char* cB = (const char*)g.Bt + (size_t)cur.pn * tstep;
    S.a_ready(cur);
    PG8_STAGE(PG8_SB(0, 0), cB, voffB); PG8_STAGE(PG8_SB(0, 1), cB + hstep, voffB); PG8_STAGE(PG8_SA(0, 0), cA, voffA); PG8_STAGE(PG8_SA(0, 1), cA + hstep, voffA);
    if (wr == 1) PG8_BAR;
    PG8_WAIT_V(2); PG8_BAR;
    PG8_STAGE(PG8_SB(1, 0), cB + kstep, voffB); PG8_STAGE(PG8_SA(1, 0), cA + kstep, voffA); PG8_STAGE(PG8_SB(1, 1), cB + hstep + kstep, voffB);
    PG8_WAIT_V(6); PG8_BAR;
    for (;;) {
        const bool has_next = S.next(ui + 1, nxt);
        const char* nA = has_next ? (const char*)g.A + (size_t)nxt.pm * tstep : cA; const char* nB = has_next ? (const char*)g.Bt + (size_t)nxt.pn * tstep : cB;
        for (int t = 0; t < nt; t += 2) {
            const bool last = (t == nt - 2);
            const char* a1 = cA + (size_t)(t + 1) * kstep;
            const char* a2 = last ? nA : cA + (size_t)(t + 2) * kstep; const char* b2 = last ? nB : cB + (size_t)(t + 2) * kstep;
            const char* a3 = a2 + kstep; const char* b3 = b2 + kstep;
            if (last && has_next) S.a_ready(nxt);
            PG8_LDB(B0, 0, 0); PG8_LDB(B1, 0, 1); PG8_SCHED; PG8_LDA(At, 0, 0); PG8_STAGE(PG8_SA(1, 1), a1 + hstep, voffA);
            PG8_WAIT_V(8); PG8_WAIT_L(0); PG8_BAR; PG8_MMA(0, 0, At, B0); PG8_MMA(0, 1, At, B1); PG8_BAR; PG8_SCHED;
            PG8_LDA(At, 0, 1); PG8_STAGE(PG8_SB(0, 0), b2, voffB); PG8_STAGE(PG8_SB(0, 1), b2 + hstep, voffB); PG8_STAGE(PG8_SA(0, 0), a2, voffA);
            PG8_WAIT_V(8); PG8_WAIT_L(0); PG8_BAR; PG8_MMA(1, 0, At, B0); PG8_MMA(1, 1, At, B1); PG8_BAR; PG8_SCHED;
            PG8_LDB(B0, 1, 0); PG8_LDB(B1, 1, 1); PG8_SCHED; PG8_LDA(At, 1, 0); PG8_STAGE(PG8_SA(0, 1), a2 + hstep, voffA);
            PG8_WAIT_V(8); PG8_WAIT_L(0); PG8_BAR; PG8_MMA(0, 0, At, B0); PG8_MMA(0, 1, At, B1); PG8_BAR; PG8_SCHED;
            PG8_LDA(At, 1, 1); PG8_STAGE(PG8_SB(1, 0), b3, voffB); PG8_STAGE(PG8_SB(1, 1), b3 + hstep, voffB); PG8_STAGE(PG8_SA(1, 0), a3, voffA);
            PG8_WAIT_V(8); PG8_WAIT_L(0); PG8_BAR; PG8_MMA(1, 0, At, B0); PG8_MMA(1, 1, At, B1); PG8_BAR; PG8_SCHED;
        }
        if constexpr (ALIGN_EPI) { if (wr == 0) PG8_BAR; }
        E(acc, cur, wr, wc, fr, fq); S.done(cur);
        if (!has_next) break;
#pragma unroll
        for (int a = 0; a < 2; ++a)
#pragma unroll
            for (int b = 0; b < 2; ++b)
#pragma unroll
                for (int m = 0; m < 4; ++m)
#pragma unroll
                    for (int n = 0; n < 2; ++n) acc[a][b][m][n] = (f32x4){0.f, 0.f, 0.f, 0.f};
        cur = nxt; cA = nA; cB = nB; ++ui;
        if constexpr (ALIGN_EPI) { if (wr == 1) PG8_BAR; }
    }
    PG8_WAIT_V(0);
    if constexpr (!ALIGN_EPI) { if (wr == 0) PG8_BAR; }
    PG8_BAR;
#undef PG8_SA
#undef PG8_SB
#undef PG8_STAGE
#undef PG8_LDA
#undef PG8_LDB
#undef PG8_MMA
#undef PG8_WAIT_V
#undef PG8_WAIT_L
#undef PG8_BAR
#undef PG8_SCHED
}
}

constexpr size_t MiB = 1u << 20;
constexpr size_t WS_CTL = 0;
constexpr size_t WS_MOD = 1 * MiB;
constexpr size_t WS_MODP = 2 * MiB;
constexpr size_t WS_ROPE = 6 * MiB;
constexpr size_t WS_KMEAN = 8 * MiB;
constexpr size_t WS_WAIN = 16 * MiB;
constexpr size_t WS_WAO = WS_WAIN + 2 * (size_t)A_INP * D_ * 2;
constexpr size_t WS_WBIN = WS_WAO + 2 * (size_t)D_ * D_ * 2;
constexpr size_t WS_WBO = WS_WBIN + 2 * (size_t)B_IN * D_ * 2;
constexpr size_t WS_WF1 = WS_WBO + 2 * (size_t)D_ * D_ * 2;
constexpr size_t WS_WF2 = WS_WF1 + 4 * (size_t)2 * DFF * D_ * 2;
constexpr size_t WS_H = WS_WF2 + 4 * (size_t)D_ * DFF * 2;
constexpr size_t WS_Q = WS_H + (size_t)S_ * D_ * 2;
constexpr size_t WS_K = WS_Q + (size_t)S_ * D_ * 2;
constexpr size_t WS_V = WS_K + (size_t)S_ * D_ * 2;
constexpr size_t WS_QI = WS_V + (size_t)S_ * D_ * 2;
constexpr size_t WS_KI = WS_QI + (size_t)S_ * 1024 * 2;
constexpr size_t WS_WI = WS_KI + (size_t)S_ * 64 * 2;
constexpr size_t WS_SEL = WS_WI + (size_t)S_ * 16 * 4;
constexpr size_t WS_O = WS_SEL + (size_t)S_ * NSEL * 4;
constexpr size_t WS_Y = WS_O + (size_t)S_ * D_ * 2;
constexpr size_t WS_ACT = WS_Y + (size_t)S_ * D_ * 4;
constexpr size_t WS_END = WS_ACT + (size_t)S_ * DFF * 2;

struct P {
    const float *x, *c; const int* pos; const float *a_w_in, *a_w_o, *b_w_in, *b_w_o, *ada_w, *ada_b, *norm_g, *ffn_w_in, *ffn_w_out;
    float* out; unsigned char* ws;
};

template <int MAP> __device__ __forceinline__ void transpose_item(const float* W, int K, int N, f16_t* WT, LAS float* scr, int item, int nblk, int lane) {
    const int kb = item / nblk, nb = item % nblk, k0 = 64 * kb, n0 = 32 * nb;
    const int ncol = n0 + (lane & 31); const bool ok = ncol < N;
#pragma unroll 8
    for (int i = 0; i < 32; ++i) { const int kk = 2 * i + (lane >> 5); scr[kk * 33 + (lane & 31)] = ok ? W[(size_t)(k0 + kk) * N + ncol] : 0.f; }
    asm volatile("s_waitcnt lgkmcnt(0)" ::: "memory");
    const int c = lane & 7;
#pragma unroll
    for (int j = 0; j < 4; ++j) { const int n = (lane >> 3) + 8 * j; const LAS float* s = scr + (8 * c) * 33 + n;
        u32x4 o; o.x = pk_f16(s[0 * 33], s[1 * 33]); o.y = pk_f16(s[2 * 33], s[3 * 33]); o.z = pk_f16(s[4 * 33], s[5 * 33]); o.w = pk_f16(s[6 * 33], s[7 * 33]);
        int nn = n0 + n, row;
        if (MAP == 1) { const int isg = nn >= DFF ? 1 : 0, cc = nn - isg * DFF; row = (cc >> 7) * 256 + isg * 128 + (cc & 127); } else row = nn;
        *(u32x4*)(WT + (size_t)row * K + k0 + 8 * c) = o; }
    asm volatile("s_waitcnt lgkmcnt(0)" ::: "memory");
}

__global__ void __launch_bounds__(512, 2) k_prologue(P p) {
    extern __shared__ __attribute__((aligned(16))) unsigned char lds[];
    const int tid = threadIdx.x, lane = tid & 63, wave = tid >> 6;
    LAS float* scr = (LAS float*)((LAS unsigned char*)lds + wave * 8704);
    const int gw = blockIdx.x * 8 + wave, NGW = gridDim.x * 8;
    unsigned char* ws = p.ws;
    {
        constexpr int NB_A = A_INP / 32, I_A = (D_ / 64) * NB_A;
        constexpr int NB_O = D_ / 32, I_O = (D_ / 64) * NB_O;
        constexpr int NB_B = B_IN / 32, I_B = (D_ / 64) * NB_B;
        constexpr int NB_1 = 2 * DFF / 32, I_1 = (D_ / 64) * NB_1;
        constexpr int NB_2 = D_ / 32, I_2 = (DFF / 64) * NB_2;
        constexpr int TOT = 2 * I_A + 2 * I_O + 2 * I_B + 2 * I_O + 4 * I_1 + 4 * I_2;
        for (int it = gw; it < TOT; it += NGW) {
            int r = it;
            if (r < 2 * I_A) { const int l = r / I_A; transpose_item<0>(p.a_w_in + (size_t)l * D_ * A_IN, D_, A_IN, (f16_t*)(ws + WS_WAIN) + (size_t)l * A_INP * D_, scr, r % I_A, NB_A, lane); continue; } r -= 2 * I_A;
            if (r < 2 * I_O) { const int l = r / I_O; transpose_item<0>(p.a_w_o + (size_t)l * D_ * D_, D_, D_, (f16_t*)(ws + WS_WAO) + (size_t)l * D_ * D_, scr, r % I_O, NB_O, lane); continue; } r -= 2 * I_O;
            if (r < 2 * I_B) { const int l = r / I_B; transpose_item<0>(p.b_w_in + (size_t)l * D_ * B_IN, D_, B_IN, (f16_t*)(ws + WS_WBIN) + (size_t)l * B_IN * D_, scr, r % I_B, NB_B, lane); continue; } r -= 2 * I_B;
            if (r < 2 * I_O) { const int l = r / I_O; transpose_item<0>(p.b_w_o + (size_t)l * D_ * D_, D_, D_, (f16_t*)(ws + WS_WBO) + (size_t)l * D_ * D_, scr, r % I_O, NB_O, lane); continue; } r -= 2 * I_O;
            if (r < 4 * I_1) { const int l = r / I_1; transpose_item<1>(p.ffn_w_in + (size_t)l * D_ * 2 * DFF, D_, 2 * DFF, (f16_t*)(ws + WS_WF1) + (size_t)l * 2 * DFF * D_, scr, r % I_1, NB_1, lane); continue; } r -= 4 * I_1;
            { const int l = r / I_2; transpose_item<0>(p.ffn_w_out + (size_t)l * DFF * D_, DFF, D_, (f16_t*)(ws + WS_WF2) + (size_t)l * D_ * DFF, scr, r % I_2, NB_2, lane); }
        }
    }
    {
        float* part = (float*)(ws + WS_MODP);
        for (int it = gw; it < 4 * 16 * 48; it += NGW) {
            const int l = it / 768, kc = (it % 768) / 48, nc = it % 48;
            const float* W = p.ada_w + ((size_t)l * D_ + kc * 128) * 12288 + nc * 256 + 4 * lane;
            f32x4 a = {0.f, 0.f, 0.f, 0.f};
#pragma unroll 8
            for (int k = 0; k < 128; ++k) { const float cv = p.c[kc * 128 + k]; const float sv = cv / (1.0f + __expf(-cv)); a += sv * *(const f32x4*)(W + (size_t)k * 12288); }
            *(f32x4*)(part + ((size_t)(l * 16 + kc)) * 12288 + nc * 256 + 4 * lane) = a;
        }
    }
    {
        float* rcA = (float*)(ws + WS_ROPE); float* rsA = rcA + S_ * 16; float* rcI = rsA + S_ * 16; float* rsI = rcI + S_ * 8;
        for (int i = blockIdx.x * 512 + tid; i < S_ * 24; i += gridDim.x * 512) {
            const int t = i / 24, j = i % 24; const double pos = (double)p.pos[t];
            if (j < 16) { const double ang = pos * pow(500000.0, -(double)j / 16.0); rcA[t * 16 + j] = (float)cos(ang); rsA[t * 16 + j] = (float)sin(ang); }
            else { const int jj = j - 16; const double ang = pos * pow(500000.0, -(double)jj / 8.0); rcI[t * 8 + jj] = (float)cos(ang); rsI[t * 8 + jj] = (float)sin(ang); }
        }
    }
}
__global__ void __launch_bounds__(256) k_mod_reduce(P p) {
    const int i = blockIdx.x * 256 + threadIdx.x; if (i >= 4 * 12288) return;
    const int l = i / 12288, n = i % 12288; const float* part = (const float*)(p.ws + WS_MODP);
    float s = p.ada_b[i];
#pragma unroll
    for (int kc = 0; kc < 16; ++kc) s += part[(size_t)(l * 16 + kc) * 12288 + n];
    ((float*)(p.ws + WS_MOD))[i] = s;
}

__device__ __forceinline__ void norm_row(const float* xin, const float* y, const float* gate, const float* gamY, float* xout,
                                         const float* gamH, const float* sc, const float* sh, f16_t* hout, int lane) {
    f32x4 xv[8];
#pragma unroll
    for (int j = 0; j < 8; ++j) xv[j] = *(const f32x4*)(xin + 4 * lane + 256 * j);
    if (y) {
        f32x4 yv[8]; float ss = 0.f;
#pragma unroll
        for (int j = 0; j < 8; ++j) { yv[j] = *(const f32x4*)(y + 4 * lane + 256 * j); ss += (yv[j].x * yv[j].x + yv[j].y * yv[j].y) + (yv[j].z * yv[j].z + yv[j].w * yv[j].w); }
        const float rstd = 1.0f / sqrtf(wave_sum(ss) * (1.0f / D_) + EPS);
#pragma unroll
        for (int j = 0; j < 8; ++j) { const f32x4 g = *(const f32x4*)(gate + 4 * lane + 256 * j), gm = *(const f32x4*)(gamY + 4 * lane + 256 * j);
            xv[j] = xv[j] + g * ((yv[j] * rstd) * gm); *(f32x4*)(xout + 4 * lane + 256 * j) = xv[j]; }
    }
    if (hout) {
        float ss = 0.f;
#pragma unroll
        for (int j = 0; j < 8; ++j) ss += (xv[j].x * xv[j].x + xv[j].y * xv[j].y) + (xv[j].z * xv[j].z + xv[j].w * xv[j].w);
        const float rstd = 1.0f / sqrtf(wave_sum(ss) * (1.0f / D_) + EPS);
#pragma unroll
        for (int j = 0; j < 8; ++j) { const f32x4 gm = *(const f32x4*)(gamH + 4 * lane + 256 * j), s1 = *(const f32x4*)(sc + 4 * lane + 256 * j), s0 = *(const f32x4*)(sh + 4 * lane + 256 * j);
            const f32x4 h = ((xv[j] * rstd) * gm) * (1.0f + s1) + s0;
            u32x2 w; w.x = pk_f16(h.x, h.y); w.y = pk_f16(h.z, h.w); *(u32x2*)(hout + 4 * lane + 256 * j) = w; }
    }
}
__global__ void __launch_bounds__(512, 2) k_norm(P p, int mode, int l) {
    const int lane = threadIdx.x & 63, gw = blockIdx.x * 8 + (threadIdx.x >> 6), NGW = gridDim.x * 8;
    const float* mod = (const float*)(p.ws + WS_MOD) + (size_t)l * 12288; const float* ng = p.norm_g + (size_t)l * 4 * D_;
    const float* y = (const float*)(p.ws + WS_Y); f16_t* H = (f16_t*)(p.ws + WS_H);
    for (int r = gw; r < S_; r += NGW) {
        const size_t o = (size_t)r * D_;
        if (mode == 0) norm_row(p.x + o, nullptr, nullptr, nullptr, nullptr, ng, mod + 1 * D_, mod + 0 * D_, H + o, lane);
        else if (mode == 1) norm_row((l == 0 ? p.x : p.out) + o, y + o, mod + 2 * D_, ng + D_, p.out + o, ng + 2 * D_, mod + 4 * D_, mod + 3 * D_, H + o, lane);
        else { const float* modn = mod + 12288; const float* ngn = ng + 4 * D_;
            norm_row(p.out + o, y + o, mod + 5 * D_, ng + 3 * D_, p.out + o, ngn, modn + 1 * D_, modn + 0 * D_, (l < 3) ? H + o : nullptr, lane); }
    }
}

template <class Epi, bool ALIGN> __global__ void __launch_bounds__(512, 2) k_gemm(pg8::Gemm g, Epi E) {
    extern __shared__ __attribute__((aligned(16))) unsigned char lds[];
    pg8::StaticOrder S; S.init(g.M, g.N, (int)gridDim.x, (int)blockIdx.x);
    pg8::gemm_phase<Epi, pg8::StaticOrder, ALIGN>((LAS unsigned char*)lds, g, S, E);
}

__device__ __forceinline__ unsigned ordkey(float f) { const unsigned u = __float_as_uint(f); return (u & 0x80000000u) ? ~u : (u | 0x80000000u); }
__global__ void __launch_bounds__(256) k_naive_topk(P p) {
    __shared__ float qi[1024]; __shared__ float wv[16]; __shared__ unsigned keys[S_]; __shared__ unsigned red[8];
    const int t = blockIdx.x, tid = threadIdx.x, lane = tid & 63, wave = tid >> 6;
    const f16_t* QI = (const f16_t*)(p.ws + WS_QI) + (size_t)t * 1024; const f16_t* KI = (const f16_t*)(p.ws + WS_KI); const float* WI = (const float*)(p.ws + WS_WI) + (size_t)t * 16;
    int* sel = (int*)(p.ws + WS_SEL) + (size_t)t * NSEL;
    for (int i = tid; i < 1024; i += 256) qi[i] = h2f(QI[i]);
    if (tid < 16) wv[tid] = WI[tid];
    __syncthreads();
    const int n = t + 1;
    if (n <= NSEL) { sel[tid] = tid < n ? tid : -1; return; }
    for (int s = tid; s < n; s += 256) {
        float kk[64];
        const u32x4* kp = (const u32x4*)(KI + (size_t)s * 64);
#pragma unroll
        for (int c = 0; c < 8; ++c) { const u32x4 w = kp[c];
#pragma unroll
            for (int e = 0; e < 4; ++e) { kk[8 * c + 2 * e] = h2f((f16_t)(w[e] & 0xffff)); kk[8 * c + 2 * e + 1] = h2f((f16_t)(w[e] >> 16)); } }
        float sc = 0.f;
        for (int h = 0; h < 16; ++h) { float d = 0.f;
#pragma unroll
            for (int e = 0; e < 64; ++e) d = fmaf(qi[h * 64 + e], kk[e], d);
            sc = fmaf(wv[h], fmaxf(d, 0.f), sc); }
        keys[s] = ordkey(sc + 0.0f);
    }
    __syncthreads();
    unsigned prefix = 0u; int k = NSEL;
    for (int bit = 31; bit >= 0; --bit) {
        const unsigned want = (prefix >> bit) | 1u; int cnt = 0;
        for (int s = tid; s < n; s += 256) cnt += ((keys[s] >> bit) == want) ? 1 : 0;
#pragma unroll
        for (int o = 1; o < 64; o <<= 1) cnt += __shfl_xor(cnt, o);
        if (lane == 0) red[wave] = (unsigned)cnt;
        __syncthreads();
        const int tot = (int)(red[0] + red[1] + red[2] + red[3]);
        __syncthreads();
        if (tot >= k) prefix |= (1u << bit); else k -= tot;
    }
    if (wave == 0) {
        int outc = 0, eqc = 0;
        for (int s0 = 0; s0 < n; s0 += 64) { const int s = s0 + lane; const unsigned key = s < n ? keys[s] : 0u; const bool gt = s < n && key > prefix, eq = s < n && key == prefix;
            const unsigned long long beq = __ballot(eq); const unsigned long long lt = (1ull << lane) - 1ull;
            const bool take = gt || (eq && (eqc + __popcll(beq & lt)) < k);
            const unsigned long long bt = __ballot(take);
            if (take) { const int pos = outc + __popcll(bt & lt); if (pos < NSEL) sel[pos] = s; }
            outc += __popcll(bt); eqc += __popcll(beq); }
    }
}
__global__ void __launch_bounds__(256) k_naive_dsa_attn(P p) {
    __shared__ float q[2048]; __shared__ float Sm[16][NSEL]; __shared__ int sl[NSEL];
    const int t = blockIdx.x, tid = threadIdx.x, lane = tid & 63, wave = tid >> 6;
    const f16_t* Q = (const f16_t*)(p.ws + WS_Q) + (size_t)t * 2048; const f16_t* K = (const f16_t*)(p.ws + WS_K); const f16_t* V = (const f16_t*)(p.ws + WS_V);
    const int* sel = (const int*)(p.ws + WS_SEL) + (size_t)t * NSEL;
    for (int i = tid; i < 2048; i += 256) q[i] = h2f(Q[i]);
    sl[tid] = sel[tid];
    __syncthreads();
    { const int key = sl[tid]; const bool valid = key >= 0 && key <= t; const float scale = 0.08838834764831845f;
        for (int g = 0; g < 4; ++g) { float kk[128];
            if (valid) { const u32x4* kp = (const u32x4*)(K + (size_t)key * 512 + g * 128);
#pragma unroll
                for (int c = 0; c < 16; ++c) { const u32x4 w = kp[c];
#pragma unroll
                    for (int e = 0; e < 4; ++e) { kk[8 * c + 2 * e] = h2f((f16_t)(w[e] & 0xffff)); kk[8 * c + 2 * e + 1] = h2f((f16_t)(w[e] >> 16)); } } }
            for (int r = 0; r < 4; ++r) { const int h = 4 * g + r; float d = 0.f;
                if (valid) {
#pragma unroll
                    for (int e = 0; e < 128; ++e) d = fmaf(q[h * 128 + e], kk[e], d); }
                Sm[h][tid] = valid ? d * scale : -INFINITY; } } }
    __syncthreads();
    for (int r = 0; r < 4; ++r) { const int h = 4 * wave + r; float v[4]; float mx = -INFINITY;
#pragma unroll
        for (int i = 0; i < 4; ++i) { v[i] = Sm[h][lane + 64 * i]; mx = fmaxf(mx, v[i]); }
        mx = wave_max(mx); float sum = 0.f;
#pragma unroll
        for (int i = 0; i < 4; ++i) { v[i] = __expf(v[i] - mx); sum += v[i]; }
        sum = wave_sum(sum); const float inv = 1.0f / sum;
#pragma unroll
        for (int i = 0; i < 4; ++i) Sm[h][lane + 64 * i] = v[i] * inv; }
    __syncthreads();
    { const int h = tid >> 4, dc = tid & 15, g = h >> 2; float acc[8];
#pragma unroll
        for (int e = 0; e < 8; ++e) acc[e] = 0.f;
        for (int k = 0; k < NSEL; ++k) { const float pr = Sm[h][k]; if (pr == 0.f) continue; const int key = sl[k];
            const u32x4 w = *(const u32x4*)(V + (size_t)key * 512 + g * 128 + 8 * dc);
#pragma unroll
            for (int e = 0; e < 4; ++e) { acc[2 * e] = fmaf(pr, h2f((f16_t)(w[e] & 0xffff)), acc[2 * e]); acc[2 * e + 1] = fmaf(pr, h2f((f16_t)(w[e] >> 16)), acc[2 * e + 1]); } }
        u32x4 o; o.x = pk_f16(acc[0], acc[1]); o.y = pk_f16(acc[2], acc[3]); o.z = pk_f16(acc[4], acc[5]); o.w = pk_f16(acc[6], acc[7]);
        *(u32x4*)((f16_t*)(p.ws + WS_O) + (size_t)t * 2048 + h * 128 + 8 * dc) = o; }
}
__global__ void __launch_bounds__(128) k_moba_kmean(P p) {
    const int n = blockIdx.x >> 4, h = blockIdx.x & 15, d = threadIdx.x; const f16_t* K = (const f16_t*)(p.ws + WS_K) + (size_t)n * 256 * 2048 + h * 128 + d;
    float s = 0.f; for (int i = 0; i < 256; ++i) s += h2f(K[(size_t)i * 2048]);
    ((float*)(p.ws + WS_KMEAN))[(size_t)blockIdx.x * 128 + d] = s * (1.0f / 256.0f);
}
__global__ void __launch_bounds__(256) k_naive_moba_attn(P p) {
    __shared__ float q[128]; __shared__ float gate[32]; __shared__ int sb[4]; __shared__ float Sm[1024]; __shared__ float red[8]; __shared__ float oacc[4][128];
    const int t = blockIdx.x >> 4, h = blockIdx.x & 15, tid = threadIdx.x, lane = tid & 63, wave = tid >> 6, j = t >> 8;
    const f16_t* Q = (const f16_t*)(p.ws + WS_Q) + (size_t)t * 2048 + h * 128; const f16_t* K = (const f16_t*)(p.ws + WS_K) + h * 128; const f16_t* V = (const f16_t*)(p.ws + WS_V) + h * 128;
    const float* km = (const float*)(p.ws + WS_KMEAN);
    if (tid < 128) q[tid] = h2f(Q[tid]);
    __syncthreads();
    if (tid < 32) { float g = -INFINITY; if (tid < j) { g = 0.f; const float* kp = km + ((size_t)tid * 16 + h) * 128; for (int d = 0; d < 128; ++d) g = fmaf(q[d], kp[d], g); } gate[tid] = g; }
    __syncthreads();
    if (tid == 0) { unsigned used = 0u;
        for (int s = 0; s < 3; ++s) { int best = -1; float bv = -INFINITY; for (int n = 0; n < 32; ++n) if (!((used >> n) & 1u) && n < j && (best < 0 || gate[n] > bv)) { best = n; bv = gate[n]; }
            sb[s] = best; if (best >= 0) used |= 1u << best; } }
    __syncthreads();
    const float scale = 0.08838834764831845f;
    for (int slot = 0; slot < 4; ++slot) { const int i = slot * 256 + tid; int key; bool valid;
        if (slot < 3) { valid = sb[slot] >= 0; key = (valid ? sb[slot] : 0) * 256 + tid; } else { key = j * 256 + tid; valid = key <= t; }
        float d = -INFINITY;
        if (valid) { d = 0.f; const u32x4* kp = (const u32x4*)(K + (size_t)key * 2048);
#pragma unroll
            for (int c = 0; c < 16; ++c) { const u32x4 w = kp[c];
#pragma unroll
                for (int e = 0; e < 4; ++e) { d = fmaf(q[8 * c + 2 * e], h2f((f16_t)(w[e] & 0xffff)), d); d = fmaf(q[8 * c + 2 * e + 1], h2f((f16_t)(w[e] >> 16)), d); } }
            d *= scale; }
        Sm[i] = d; }
    __syncthreads();
    float mx = -INFINITY;
#pragma unroll
    for (int i = 0; i < 4; ++i) mx = fmaxf(mx, Sm[tid + 256 * i]);
    mx = wave_max(mx); if (lane == 0) red[wave] = mx; __syncthreads();
    mx = fmaxf(fmaxf(red[0], red[1]), fmaxf(red[2], red[3])); __syncthreads();
    float sum = 0.f;
#pragma unroll
    for (int i = 0; i < 4; ++i) { const float e = __expf(Sm[tid + 256 * i] - mx); Sm[tid + 256 * i] = e; sum += e; }
    sum = wave_sum(sum); if (lane == 0) red[wave] = sum; __syncthreads();
    const float inv = 1.0f / (red[0] + red[1] + red[2] + red[3]);
    { const int part = tid >> 6; float a0 = 0.f, a1 = 0.f;
        int blk; if (part < 3) blk = sb[part]; else blk = j;
        if (blk >= 0) for (int i = 0; i < 256; ++i) { const float pr = Sm[part * 256 + i]; if (pr == 0.f) continue; const int key = blk * 256 + i;
            const unsigned w = *(const unsigned*)(V + (size_t)key * 2048 + 2 * lane); a0 = fmaf(pr, h2f((f16_t)(w & 0xffff)), a0); a1 = fmaf(pr, h2f((f16_t)(w >> 16)), a1); }
        oacc[part][2 * lane] = a0; oacc[part][2 * lane + 1] = a1; }
    __syncthreads();
    if (tid < 64) { const float o0 = (oacc[0][2 * tid] + oacc[1][2 * tid] + oacc[2][2 * tid] + oacc[3][2 * tid]) * inv, o1 = (oacc[0][2 * tid + 1] + oacc[1][2 * tid + 1] + oacc[2][2 * tid + 1] + oacc[3][2 * tid + 1]) * inv;
        *(unsigned*)((f16_t*)(p.ws + WS_O) + (size_t)t * 2048 + h * 128 + 2 * tid) = pk_f16(o0, o1); }
}

template <class Epi, bool ALIGN> static void launch_gemm(const pg8::Gemm& g, const Epi& E, int grid, hipStream_t st) {
    static bool attr = false; if (!attr) { (void)hipFuncSetAttribute((const void*)k_gemm<Epi, ALIGN>, hipFuncAttributeMaxDynamicSharedMemorySize, pg8::STAGE_BYTES); attr = true; }
    hipLaunchKernelGGL((k_gemm<Epi, ALIGN>), dim3(grid), dim3(512), pg8::STAGE_BYTES, st, g, E);
}
extern "C" void kernel_launch(void* const* d_in, const int* in_sizes, int n_in, void* d_out, int out_size, void* d_ws, size_t ws_size, hipStream_t stream) {
    if (n_in != 12 || ws_size < WS_END) { fprintf(stderr, "kernel_launch: unexpected inputs (n_in %d, ws %zu < %zu)\n", n_in, ws_size, (size_t)WS_END); return; }
    static int grid = 0;
    if (!grid) { int dev = 0, cus = 0; (void)hipGetDevice(&dev); (void)hipDeviceGetAttribute(&cus, hipDeviceAttributeMultiprocessorCount, dev); grid = cus > 0 ? cus : 256;
        (void)hipFuncSetAttribute((const void*)k_prologue, hipFuncAttributeMaxDynamicSharedMemorySize, 8 * 8704); }
    P p{}; p.x = (const float*)d_in[0]; p.c = (const float*)d_in[1]; p.pos = (const int*)d_in[2]; p.a_w_in = (const float*)d_in[3]; p.a_w_o = (const float*)d_in[4];
    p.b_w_in = (const float*)d_in[5]; p.b_w_o = (const float*)d_in[6]; p.ada_w = (const float*)d_in[7]; p.ada_b = (const float*)d_in[8]; p.norm_g = (const float*)d_in[9];
    p.ffn_w_in = (const float*)d_in[10]; p.ffn_w_out = (const float*)d_in[11]; p.out = (float*)d_out; p.ws = (unsigned char*)d_ws;
    unsigned char* ws = p.ws;
    hipLaunchKernelGGL(k_prologue, dim3(grid), dim3(512), 8 * 8704, stream, p);
    hipLaunchKernelGGL(k_mod_reduce, dim3(4 * 12288 / 256), dim3(256), 0, stream, p);
    hipLaunchKernelGGL(k_norm, dim3(grid), dim3(512), 0, stream, p, 0, 0);
    const float* rope = (const float*)(ws + WS_ROPE);
    for (int l = 0; l < 4; ++l) {
        const int li = l >> 1;
        if ((l & 1) == 0) {
            pg8::Gemm g{(const f16_t*)(ws + WS_H), (const f16_t*)(ws + WS_WAIN) + (size_t)li * A_INP * D_, S_, A_INP, D_, 0};
            pg8::EpiIn<0> E{(f16_t*)(ws + WS_Q), (f16_t*)(ws + WS_K), (f16_t*)(ws + WS_V), (f16_t*)(ws + WS_QI), (f16_t*)(ws + WS_KI), (float*)(ws + WS_WI), rope, rope + S_ * 16, rope + S_ * 32, rope + S_ * 40};
            launch_gemm<pg8::EpiIn<0>, true>(g, E, grid, stream);
            hipLaunchKernelGGL(k_naive_topk, dim3(S_), dim3(256), 0, stream, p);
            hipLaunchKernelGGL(k_naive_dsa_attn, dim3(S_), dim3(256), 0, stream, p);
            pg8::Gemm g2{(const f16_t*)(ws + WS_O), (const f16_t*)(ws + WS_WAO) + (size_t)li * D_ * D_, S_, D_, D_, 0};
            pg8::EpiF32 E2{(float*)(ws + WS_Y), D_, 0};
            launch_gemm<pg8::EpiF32, false>(g2, E2, grid, stream);
        } else {
            pg8::Gemm g{(const f16_t*)(ws + WS_H), (const f16_t*)(ws + WS_WBIN) + (size_t)li * B_IN * D_, S_, B_IN, D_, 0};
            pg8::EpiIn<1> E{(f16_t*)(ws + WS_Q), (f16_t*)(ws + WS_K), (f16_t*)(ws + WS_V), nullptr, nullptr, nullptr, rope, rope + S_ * 16, rope + S_ * 32, rope + S_ * 40};
            launch_gemm<pg8::EpiIn<1>, true>(g, E, grid, stream);
            hipLaunchKernelGGL(k_moba_kmean, dim3(512), dim3(128), 0, stream, p);
            hipLaunchKernelGGL(k_naive_moba_attn, dim3(S_ * 16), dim3(256), 0, stream, p);
            pg8::Gemm g2{(const f16_t*)(ws + WS_O), (const f16_t*)(ws + WS_WBO) + (size_t)li * D_ * D_, S_, D_, D_, 0};
            pg8::EpiF32 E2{(float*)(ws + WS_Y), D_, 0};
            launch_gemm<pg8::EpiF32, false>(g2, E2, grid, stream);
        }
        hipLaunchKernelGGL(k_norm, dim3(grid), dim3(512), 0, stream, p, 1, l);
        { pg8::Gemm g{(const f16_t*)(ws + WS_H), (const f16_t*)(ws + WS_WF1) + (size_t)l * 2 * DFF * D_, S_, 2 * DFF, D_, 0};
          pg8::EpiSwiglu E{(f16_t*)(ws + WS_ACT), DFF, 0};
          launch_gemm<pg8::EpiSwiglu, true>(g, E, grid, stream); }
        { pg8::Gemm g{(const f16_t*)(ws + WS_ACT), (const f16_t*)(ws + WS_WF2) + (size_t)l * D_ * DFF, S_, D_, DFF, 0};
          pg8::EpiF32 E{(float*)(ws + WS_Y), D_, 0};
          launch_gemm<pg8::EpiF32, false>(g, E, grid, stream); }
        hipLaunchKernelGGL(k_norm, dim3(grid), dim3(512), 0, stream, p, 2, l);
    }
}
```

```cpp
#include <hip/hip_runtime.h>
#include <cstdio>
#include <cstdint>

#define LAS __attribute__((address_space(3)))
typedef unsigned short f16_t;
typedef _Float16 f16x8 __attribute__((ext_vector_type(8)));
typedef _Float16 f16x4 __attribute__((ext_vector_type(4)));
typedef _Float16 f16x2 __attribute__((ext_vector_type(2)));
typedef float f32x2 __attribute__((ext_vector_type(2)));
typedef float f32x4 __attribute__((ext_vector_type(4)));
typedef unsigned u32x4 __attribute__((ext_vector_type(4)));
typedef unsigned u32x2 __attribute__((ext_vector_type(2)));

constexpr int S_ = 8192, D_ = 2048, NH = 16, HD = 128, DFF = 5632;
constexpr int A_IN = 4176, A_INP = 4352, B_IN = 6144;
constexpr int NSEL = 256;
constexpr float EPS = 1e-6f;

__device__ __forceinline__ unsigned pk_f16(float lo, float hi) { f16x2 r = __builtin_convertvector((f32x2){lo, hi}, f16x2); return __builtin_bit_cast(unsigned, r); }
__device__ __forceinline__ float h2f(f16_t v) { return (float)__builtin_bit_cast(_Float16, v); }
__device__ __forceinline__ float wave_sum(float v) {
#pragma unroll
    for (int o = 1; o < 64; o <<= 1) v += __shfl_xor(v, o);
    return v;
}
__device__ __forceinline__ float wave_max(float v) {
#pragma unroll
    for (int o = 1; o < 64; o <<= 1) v = fmaxf(v, __shfl_xor(v, o));
    return v;
}

__device__ __forceinline__ int otid() { int t = (int)threadIdx.x; asm volatile("" : "+v"(t)); return t; }
__device__ __forceinline__ int obid() { int b = (int)blockIdx.x; asm volatile("" : "+s"(b)); return b; }

#ifndef AT_NI
#define AT_NI 4
#endif
#ifndef MK_CONV_HOST
#define MK_CONV_HOST 1
#endif
namespace pg8 {
constexpr int BM = 256, BK = 64, HALF = 128, HTB = HALF * BK * 2, STAGE_BYTES = 8 * HTB, NXCD = 8, WGM = 8;
__host__ __device__ __forceinline__ int lds_byte(int r, int c) { const int st = (r >> 4) * 2 + (c >> 5), rr = r & 15, cc = c & 31, ob = rr * 64 + cc * 2; return st * 1024 + (ob ^ (((ob >> 9) & 1) << 5)); }
__host__ __device__ __forceinline__ void stage_rc(int b, int& R, int& C) { const int st = b / 1024, sb = b % 1024, swz = sb ^ (((sb >> 9) & 1) << 5); R = (st >> 1) * 16 + swz / 64; C = (st & 1) * 32 + (swz % 64) / 2; }
__host__ __device__ __forceinline__ int perm32(int rho) { const int n = rho >> 4, i = rho & 15; return 8 * (i >> 2) + 4 * n + (i & 3); }
struct Unit { int pm, pn, ks; };
struct Gemm { const f16_t* A; const f16_t* Bt; int M, N, K, pad; };
struct StaticOrder {
    int nM, nN, nwg, G, c;
    __host__ __device__ void init(int M, int N, int G_, int c_) { nM = M / BM; nN = N / BM; nwg = nM * nN; G = G_; c = c_; }
    static constexpr bool SPLIT = false;
    __host__ __device__ bool next(int i, Unit& u) const { return map((long)i * G + c, u); }
    __host__ __device__ bool map(long L, Unit& u) const {
        u.ks = -1; if (L >= nwg) return false;
        int wgid = (int)L; { const int q = nwg / NXCD, r = nwg % NXCD, xcd = wgid % NXCD, off = wgid / NXCD; wgid = (xcd < r ? xcd * (q + 1) : r * (q + 1) + (xcd - r) * q) + off; }
        const int nig = WGM * nN, gid = wgid / nig, fm = gid * WGM, gsz = (nM - fm) < WGM ? (nM - fm) : WGM;
        u.pm = fm + ((wgid % nig) % gsz); u.pn = (wgid % nig) / gsz; return true;
    }
    __device__ __forceinline__ void a_ready(const Unit&) const {}
    __device__ __forceinline__ void done(const Unit&) const {}
};

struct SplitTailOrder {
    static constexpr bool SPLIT = true;
    StaticOrder s; int nfull, en; float* pb; unsigned* fl;
    __device__ void init(int M, int N, int G_, int c_, float* pb_, unsigned* fl_) { s.init(M, N, G_, c_); nfull = s.nwg / G_; const int tail = s.nwg - nfull * G_; en = ((G_ & 1) == 0 && tail > 0 && tail <= G_ / 2) ? 1 : 0; pb = pb_; fl = fl_; }
    __device__ bool next(int i, Unit& u) const {
        if (!en || i < nfull) return s.next(i, u);
        if (i > nfull) return false;
        const int half = s.G / 2, j = s.c % half;
        if (!s.map((long)nfull * s.G + j, u)) return false;
        u.ks = s.c / half; return true;
    }
    __device__ int slot() const { return s.c % (s.G / 2); }
    __device__ __forceinline__ void a_ready(const Unit&) const {}
    __device__ __forceinline__ void done(const Unit&) const {}
};

struct EpiF32 {
    static constexpr bool PERM = false, AFTER_DRAIN = false;
    float* C; int ldc, pad;
    __device__ __forceinline__ void operator()(const f32x4 (&acc)[2][2][4][2], const Unit& u, int wr, int wc, int fr, int fq) const {
        const int row0 = u.pm * BM + wr * 64 + fr, col0 = u.pn * BM + wc * 32 + 4 * fq;
#pragma unroll
        for (int ai = 0; ai < 2; ++ai)
#pragma unroll
            for (int m = 0; m < 4; ++m) { float* rowp = C + (size_t)(row0 + ai * HALF + m * 16) * ldc + col0;
#pragma unroll
                for (int bj = 0; bj < 2; ++bj)
#pragma unroll
                    for (int n = 0; n < 2; ++n) *(f32x4*)(rowp + bj * HALF + n * 16) = acc[ai][bj][m][n]; }
    }
};
struct EpiF16 {
    static constexpr bool PERM = true, AFTER_DRAIN = false;
    f16_t* C; int ldc, pad;
    __device__ __forceinline__ void operator()(const f32x4 (&acc)[2][2][4][2], const Unit& u, int wr, int wc, int fr, int fq) const {
        const int row0 = u.pm * BM + wr * 64 + fr, col0 = u.pn * BM + wc * 32 + 8 * fq;
#pragma unroll
        for (int ai = 0; ai < 2; ++ai)
#pragma unroll
            for (int m = 0; m < 4; ++m) { f16_t* rowp = C + (size_t)(row0 + ai * HALF + m * 16) * ldc + col0;
#pragma unroll
                for (int bj = 0; bj < 2; ++bj) { const f32x4 v0 = acc[ai][bj][m][0], v1 = acc[ai][bj][m][1];
                    u32x4 w; w.x = pk_f16(v0[0], v0[1]); w.y = pk_f16(v0[2], v0[3]); w.z = pk_f16(v1[0], v1[1]); w.w = pk_f16(v1[2], v1[3]);
                    *(u32x4*)(rowp + bj * HALF) = w; } }
    }
};
struct EpiSwiglu {
    static constexpr bool PERM = true, AFTER_DRAIN = false;
    f16_t* O; int ldc, pad;
    __device__ __forceinline__ void operator()(const f32x4 (&acc)[2][2][4][2], const Unit& u, int wr, int wc, int fr, int fq) const {
        const int row0 = u.pm * BM + wr * 64 + fr, col0 = u.pn * HALF + wc * 32 + 8 * fq;
#pragma unroll
        for (int ai = 0; ai < 2; ++ai)
#pragma unroll
            for (int m = 0; m < 4; ++m) { f16_t* rowp = O + (size_t)(row0 + ai * HALF + m * 16) * ldc + col0;
                float o[8];
#pragma unroll
                for (int n = 0; n < 2; ++n)
#pragma unroll
                    for (int j = 0; j < 4; ++j) { const float uu = acc[ai][0][m][n][j], g = acc[ai][1][m][n][j]; o[4 * n + j] = uu * g * __builtin_amdgcn_rcpf(1.0f + __expf(-g)); }
                u32x4 w; w.x = pk_f16(o[0], o[1]); w.y = pk_f16(o[2], o[3]); w.z = pk_f16(o[4], o[5]); w.w = pk_f16(o[6], o[7]);
                *(u32x4*)rowp = w; }
    }
};
__device__ __forceinline__ void rope8(f32x4& v0, f32x4& v1, const f32x4 c0, const f32x4 c1, const f32x4 s0, const f32x4 s1, float sgn, int xm, bool apply) {
#pragma unroll
    for (int j = 0; j < 4; ++j) {
        const float o0 = __shfl_xor(v0[j], xm), o1 = __shfl_xor(v1[j], xm);
        if (apply) { v0[j] = v0[j] * c0[j] + sgn * o0 * s0[j]; v1[j] = v1[j] * c1[j] + sgn * o1 * s1[j]; }
    }
}
template <int MODE> struct EpiIn {
    static constexpr bool PERM = true, AFTER_DRAIN = false;
    f16_t *Q, *K, *V, *QI, *KI; float* WI; float* KS;
    const float *rcA, *rsA, *rcI, *rsI;
    __device__ __forceinline__ void operator()(const f32x4 (&acc)[2][2][4][2], const Unit& u, int wr, int wc, int fr, int fq) const {
        const int row0 = u.pm * BM + wr * 64 + fr; const int pn = u.pn;
        constexpr int NQ = 8, NK = (MODE == 0) ? 2 : 8, NV = (MODE == 0) ? 2 : 8;
        if (pn < NQ + NK + NV) {
            f16_t* base; int ldc, colt; bool rope;
            if (pn < NQ) { base = Q; ldc = 2048; colt = pn * BM; rope = true; }
            else if (pn < NQ + NK) { base = K; ldc = NK * BM; colt = (pn - NQ) * BM; rope = true; }
            else { base = V; ldc = NV * BM; colt = (pn - NQ - NK) * BM; rope = false; }
            size_t hstride = HALF;
            if (MODE == 0 && pn >= NQ) { base += (size_t)(colt >> 7) * S_ * 128; colt = 0; ldc = 128; hstride = (size_t)S_ * 128; }
            const int col0 = colt + wc * 32 + 8 * fq; const bool dorope = rope && (wc == 0);
            const float sgn = (fq < 2) ? -1.f : 1.f;
            const bool ksum = (MODE == 1) && pn >= NQ && pn < NQ + NK;
            float cs[2][8];
#pragma unroll
            for (int bj = 0; bj < 2; ++bj)
#pragma unroll
                for (int e = 0; e < 8; ++e) cs[bj][e] = 0.f;
#pragma unroll
            for (int ai = 0; ai < 2; ++ai)
#pragma unroll
                for (int m = 0; m < 4; ++m) { const int row = row0 + ai * HALF + m * 16; f16_t* rowp = base + (size_t)row * ldc + col0;
                    f32x4 c0, c1, s0, s1;
                    if (dorope) { const float* cp = rcA + (size_t)row * 16 + 8 * (fq & 1); const float* sp = rsA + (size_t)row * 16 + 8 * (fq & 1);
                        c0 = *(const f32x4*)cp; c1 = *(const f32x4*)(cp + 4); s0 = *(const f32x4*)sp; s1 = *(const f32x4*)(sp + 4); }
#pragma unroll
                    for (int bj = 0; bj < 2; ++bj) { f32x4 v0 = acc[ai][bj][m][0], v1 = acc[ai][bj][m][1];
                        if (dorope) rope8(v0, v1, c0, c1, s0, s1, sgn, 32, true);
                        if (ksum) {
#pragma unroll
                            for (int e = 0; e < 4; ++e) { cs[bj][e] += v0[e]; cs[bj][4 + e] += v1[e]; } }
                        u32x4 w; w.x = pk_f16(v0[0], v0[1]); w.y = pk_f16(v0[2], v0[3]); w.z = pk_f16(v1[0], v1[1]); w.w = pk_f16(v1[2], v1[3]);
                        *(u32x4*)(rowp + bj * hstride) = w; } }
            if (ksum) {
#pragma unroll
                for (int bj = 0; bj < 2; ++bj)
#pragma unroll
                    for (int e = 0; e < 8; ++e) { float v = cs[bj][e]; v += __shfl_xor(v, 1); v += __shfl_xor(v, 2); v += __shfl_xor(v, 4); v += __shfl_xor(v, 8);
                        if (fr == 0) atomicAdd(KS + ((size_t)(2 * (pn - NQ) + bj) * 32 + u.pm) * 128 + wc * 32 + 8 * fq + e, v); } }
        } else if (MODE == 0 && pn < 16) {
            const int col0 = (pn - 12) * BM + wc * 32 + 8 * fq; const bool ropew = ((wc & 1) == 0); const bool app = fq < 2; const float sgn = (fq == 0) ? -1.f : 1.f;
#pragma unroll
            for (int ai = 0; ai < 2; ++ai)
#pragma unroll
                for (int m = 0; m < 4; ++m) { const int row = row0 + ai * HALF + m * 16; f16_t* rowp = QI + (size_t)row * 1024 + col0;
                    f32x4 c0, c1, s0, s1;
                    if (ropew) { const float* cp = rcI + (size_t)row * 8; const float* sp = rsI + (size_t)row * 8; c0 = *(const f32x4*)cp; c1 = *(const f32x4*)(cp + 4); s0 = *(const f32x4*)sp; s1 = *(const f32x4*)(sp + 4); }
#pragma unroll
                    for (int bj = 0; bj < 2; ++bj) { f32x4 v0 = acc[ai][bj][m][0], v1 = acc[ai][bj][m][1];
                        if (ropew) rope8(v0, v1, c0, c1, s0, s1, sgn, 16, app);
                        u32x4 w; w.x = pk_f16(v0[0], v0[1]); w.y = pk_f16(v0[2], v0[3]); w.z = pk_f16(v1[0], v1[1]); w.w = pk_f16(v1[2], v1[3]);
                        *(u32x4*)(rowp + bj * HALF) = w; } }
        } else if (MODE == 0) {
            const bool ropew = (wc == 0); const bool app = fq < 2; const float sgn = (fq == 0) ? -1.f : 1.f;
#pragma unroll
            for (int ai = 0; ai < 2; ++ai)
#pragma unroll
                for (int m = 0; m < 4; ++m) { const int row = row0 + ai * HALF + m * 16;
                    f32x4 v0 = acc[ai][0][m][0], v1 = acc[ai][0][m][1];
                    if (ropew) { const float* cp = rcI + (size_t)row * 8; const float* sp = rsI + (size_t)row * 8;
                        const f32x4 c0 = *(const f32x4*)cp, c1 = *(const f32x4*)(cp + 4), s0 = *(const f32x4*)sp, s1 = *(const f32x4*)(sp + 4);
                        rope8(v0, v1, c0, c1, s0, s1, sgn, 16, app); }
                    if (wc < 2) { u32x4 w; w.x = pk_f16(v0[0], v0[1]); w.y = pk_f16(v0[2], v0[3]); w.z = pk_f16(v1[0], v1[1]); w.w = pk_f16(v1[2], v1[3]);
                        *(u32x4*)(KI + (size_t)row * 64 + wc * 32 + 8 * fq) = w; }
                    else if (wc == 2 && fq < 2) { float* wp = WI + (size_t)row * 16 + 8 * fq; *(f32x4*)wp = v0 * 0.03125f; *(f32x4*)(wp + 4) = v1 * 0.03125f; } }
        }
    }
};

template <class Epi, class Sched, bool ALIGN_EPI>
__device__ __forceinline__ void gemm_phase(LAS unsigned char* lds, const Gemm g, const Sched& S, const Epi& E) {
    const int tid = otid(), wid = __builtin_amdgcn_readfirstlane(tid >> 6), lane = tid & 63, wr = wid >> 2, wc = wid & 3, fr = lane & 15, fq = lane >> 4;
    const int K = g.K, nt = K / BK;
    unsigned voffA[2], voffB[2];
#pragma unroll
    for (int i = 0; i < 2; ++i) { int R, C; stage_rc(tid * 16 + i * 8192, R, C); const int Rb = Epi::PERM ? ((R & ~31) + perm32(R & 31)) : R;
        voffA[i] = (unsigned)(R * K + C) * 2u; voffB[i] = (unsigned)(Rb * K + C) * 2u; }
    const size_t kstep = (size_t)(BK * 2);
    const size_t hstep = (size_t)HALF * K * 2;
    const size_t tstep = 2 * hstep;
    const unsigned ldsw = (unsigned)wid * 1024u;
    const int aoff = lds_byte(wr * 64 + fr, fq * 8), boff = lds_byte(wc * 32 + fr, fq * 8);
#define PG8_SA(b, h) (((b) * 2 + (h)) * HTB)
#define PG8_SB(b, h) ((4 + (b) * 2 + (h)) * HTB)
#define PG8_STAGE(bufoff, gbase, voff) do { _Pragma("unroll") for (int _i = 0; _i < 2; ++_i) \
        __builtin_amdgcn_global_load_lds((const unsigned*)((const char*)(gbase) + (voff)[_i]), (LAS unsigned*)(lds + (bufoff) + ldsw + _i * 8192), 16, 0, 0); } while (0)
#define PG8_LDA(dst, b, h) do { _Pragma("unroll") for (int m = 0; m < 4; ++m) _Pragma("unroll") for (int k = 0; k < 2; ++k) dst[m][k] = *(const LAS f16x8*)(lds + PG8_SA(b, h) + aoff + m * 2048 + k * 1024); } while (0)
#define PG8_LDB(dst, b, h) do { _Pragma("unroll") for (int n = 0; n < 2; ++n) _Pragma("unroll") for (int k = 0; k < 2; ++k) dst[n][k] = *(const LAS f16x8*)(lds + PG8_SB(b, h) + boff + n * 2048 + k * 1024); } while (0)
#define PG8_MMA(ai, bj, At, Bt) do { __builtin_amdgcn_s_setprio(1); _Pragma("unroll") for (int m = 0; m < 4; ++m) _Pragma("unroll") for (int n = 0; n < 2; ++n) _Pragma("unroll") for (int k = 0; k < 2; ++k) \
        acc[ai][bj][m][n] = __builtin_amdgcn_mfma_f32_16x16x32_f16(Bt[n][k], At[m][k], acc[ai][bj][m][n], 0, 0, 0); __builtin_amdgcn_s_setprio(0); } while (0)
#define PG8_WAIT_V(n) asm volatile("s_waitcnt vmcnt(" #n ")" ::: "memory")
#define PG8_WAIT_L(n) asm volatile("s_waitcnt lgkmcnt(" #n ")" ::: "memory")
#define PG8_BAR __builtin_amdgcn_s_barrier()
#define PG8_SCHED __builtin_amdgcn_sched_barrier(0)
    Unit cur, nxt; int ui = 0;
    if (!S.next(0, cur)) return;
    f32x4 acc[2][2][4][2];
#pragma unroll
    for (int a = 0; a < 2; ++a)
#pragma unroll
        for (int b = 0; b < 2; ++b)
#pragma unroll
            for (int m = 0; m < 4; ++m)
#pragma unroll
                for (int n = 0; n < 2; ++n) acc[a][b][m][n] = (f32x4){0.f, 0.f, 0.f, 0.f};
    f16x8 At[4][2], B0[2][2], B1[2][2];
    static_assert(ALIGN_EPI || !Sched::SPLIT, "the split hand-over needs the wave halves aligned");
    const char* cA = (const char*)g.A + (size_t)cur.pm * tstep; const char* cB = (const char*)g.Bt + (size_t)cur.pn * tstep;
    if constexpr (Sched::SPLIT) { if (cur.ks > 0) { cA += K; cB += K; } }
    S.a_ready(cur);
    PG8_STAGE(PG8_SB(0, 0), cB, voffB); PG8_STAGE(PG8_SB(0, 1), cB + hstep, voffB); PG8_STAGE(PG8_SA(0, 0), cA, voffA); PG8_STAGE(PG8_SA(0, 1), cA + hstep, voffA);
    if (wr == 1) PG8_BAR;
    PG8_WAIT_V(2); PG8_BAR;
    PG8_STAGE(PG8_SB(1, 0), cB + kstep, voffB); PG8_STAGE(PG8_SA(1, 0), cA + kstep, voffA); PG8_STAGE(PG8_SB(1, 1), cB + hstep + kstep, voffB);
    PG8_WAIT_V(6); PG8_BAR;
    for (;;) {
        const bool has_next = S.next(ui + 1, nxt);
        const char* nA = has_next ? (const char*)g.A + (size_t)nxt.pm * tstep : cA; const char* nB = has_next ? (const char*)g.Bt + (size_t)nxt.pn * tstep : cB;
        int ntu = nt;
        if constexpr (Sched::SPLIT) { if (has_next && nxt.ks > 0) { nA += K; nB += K; } if (cur.ks >= 0) ntu = nt >> 1; }
        for (int t = 0; t < ntu; t += 2) {
            const bool last = (t == ntu - 2);
            const char* a1 = cA + (size_t)(t + 1) * kstep;
            const char* a2 = last ? nA : cA + (size_t)(t + 2) * kstep; const char* b2 = last ? nB : cB + (size_t)(t + 2) * kstep;
            const char* a3 = a2 + kstep; const char* b3 = b2 + kstep;
            if (last && has_next) S.a_ready(nxt);
            PG8_LDB(B0, 0, 0); PG8_LDB(B1, 0, 1); PG8_SCHED; PG8_LDA(At, 0, 0); PG8_STAGE(PG8_SA(1, 1), a1 + hstep, voffA);
            PG8_WAIT_V(8); PG8_WAIT_L(0); PG8_BAR; PG8_MMA(0, 0, At, B0); PG8_MMA(0, 1, At, B1); PG8_BAR; PG8_SCHED;
            PG8_LDA(At, 0, 1); PG8_STAGE(PG8_SB(0, 0), b2, voffB); PG8_STAGE(PG8_SB(0, 1), b2 + hstep, voffB); PG8_STAGE(PG8_SA(0, 0), a2, voffA);
            PG8_WAIT_V(8); PG8_WAIT_L(0); PG8_BAR; PG8_MMA(1, 0, At, B0); PG8_MMA(1, 1, At, B1); PG8_BAR; PG8_SCHED;
            PG8_LDB(B0, 1, 0); PG8_LDB(B1, 1, 1); PG8_SCHED; PG8_LDA(At, 1, 0); PG8_STAGE(PG8_SA(0, 1), a2 + hstep, voffA);
            PG8_WAIT_V(8); PG8_WAIT_L(0); PG8_BAR; PG8_MMA(0, 0, At, B0); PG8_MMA(0, 1, At, B1); PG8_BAR; PG8_SCHED;
            PG8_LDA(At, 1, 1); PG8_STAGE(PG8_SB(1, 0), b3, voffB); PG8_STAGE(PG8_SB(1, 1), b3 + hstep, voffB); PG8_STAGE(PG8_SA(1, 0), a3, voffA);
            PG8_WAIT_V(8); PG8_WAIT_L(0); PG8_BAR; PG8_MMA(1, 0, At, B0); PG8_MMA(1, 1, At, B1); PG8_BAR; PG8_SCHED;
        }
        if constexpr (ALIGN_EPI) { if (wr == 0) PG8_BAR; }
        bool epi = true;
        if constexpr (Sched::SPLIT) {
            if (cur.ks == 1) {
                char* pbb = (char*)S.pb + (size_t)S.slot() * 262144; unsigned po = (unsigned)tid * 16u; asm volatile("" : "+v"(po));
#pragma unroll
                for (int i = 0; i < 32; ++i) *(f32x4*)(pbb + (po + (unsigned)i * 8192u)) = acc[i >> 4][(i >> 3) & 1][(i >> 1) & 3][i & 1];
                asm volatile("s_waitcnt vmcnt(0)" ::: "memory"); PG8_BAR;
                if (tid == 0) { __builtin_amdgcn_fence(__ATOMIC_RELEASE, "agent"); __hip_atomic_store(S.fl + S.slot(), 1u, __ATOMIC_RELAXED, __HIP_MEMORY_SCOPE_AGENT); }
                epi = false;
            } else if (cur.ks == 0) {
                if (tid == 0) { unsigned sp = 0u; while (__hip_atomic_load(S.fl + S.slot(), __ATOMIC_RELAXED, __HIP_MEMORY_SCOPE_AGENT) == 0u && ++sp < (1u << 24)) __builtin_amdgcn_s_sleep(1);
                                __builtin_amdgcn_fence(__ATOMIC_ACQUIRE, "agent"); }
                PG8_BAR; asm volatile("" ::: "memory");
                const char* pbb = (const char*)S.pb + (size_t)S.slot() * 262144; unsigned po = (unsigned)tid * 16u; asm volatile("" : "+v"(po));
#pragma unroll
                for (int i0 = 0; i0 < 32; i0 += 4) { f32x4 t8[4];
#pragma unroll
                    for (int i = 0; i < 4; ++i) t8[i] = *(const f32x4*)(pbb + (po + (unsigned)(i0 + i) * 8192u));
#pragma unroll
                    for (int i = 0; i < 4; ++i) { const int ii = i0 + i; acc[ii >> 4][(ii >> 3) & 1][(ii >> 1) & 3][ii & 1] += t8[i]; } }
            }
        }
        if (epi) E(acc, cur, wr, wc, fr, fq);
        S.done(cur);
        if (!has_next) break;
#pragma unroll
        for (int a = 0; a < 2; ++a)
#pragma unroll
            for (int b = 0; b < 2; ++b)
#pragma unroll
                for (int m = 0; m < 4; ++m)
#pragma unroll
                    for (int n = 0; n < 2; ++n) acc[a][b][m][n] = (f32x4){0.f, 0.f, 0.f, 0.f};
        cur = nxt; cA = nA; cB = nB; ++ui;
        if constexpr (ALIGN_EPI) { if (wr == 1) PG8_BAR; }
    }
    PG8_WAIT_V(0);
    if constexpr (!ALIGN_EPI) { if (wr == 0) PG8_BAR; }
    PG8_BAR;
#undef PG8_SA
#undef PG8_SB
#undef PG8_STAGE
#undef PG8_LDA
#undef PG8_LDB
#undef PG8_MMA
#undef PG8_WAIT_V
#undef PG8_WAIT_L
#undef PG8_BAR
#undef PG8_SCHED
}
}

constexpr size_t MiB = 1u << 20;
constexpr size_t WS_CTL = 0;
constexpr size_t WS_MOD = 1 * MiB;
constexpr size_t WS_MODP_OLD = 2 * MiB;
constexpr size_t WS_ROPE = 6 * MiB;
constexpr size_t WS_KMEAN = 8 * MiB;
constexpr size_t WS_WAIN = 16 * MiB;
constexpr size_t WS_WAO = WS_WAIN + 2 * (size_t)A_INP * D_ * 2;
constexpr size_t WS_WBIN = WS_WAO + 2 * (size_t)D_ * D_ * 2;
constexpr size_t WS_WBO = WS_WBIN + 2 * (size_t)B_IN * D_ * 2;
constexpr size_t WS_WF1 = WS_WBO + 2 * (size_t)D_ * D_ * 2;
constexpr size_t WS_WF2 = WS_WF1 + 4 * (size_t)2 * DFF * D_ * 2;
constexpr size_t WS_H = WS_WF2 + 4 * (size_t)D_ * DFF * 2;
constexpr size_t WS_Q = WS_H + (size_t)S_ * D_ * 2;
constexpr size_t WS_K = WS_Q + (size_t)S_ * D_ * 2;
constexpr size_t WS_V = WS_K + (size_t)S_ * D_ * 2;
constexpr size_t WS_QI = WS_V + (size_t)S_ * D_ * 2;
constexpr size_t WS_KI = WS_QI + (size_t)S_ * 1024 * 2;
constexpr size_t WS_WI = WS_KI + (size_t)S_ * 64 * 2;
constexpr size_t WS_SEL = WS_WI + (size_t)S_ * 16 * 4;
constexpr size_t WS_O = WS_SEL + (size_t)S_ * NSEL * 4;
constexpr size_t WS_Y = WS_O + (size_t)S_ * D_ * 2;
constexpr size_t WS_ACT = WS_Y + (size_t)S_ * D_ * 4;
constexpr size_t WS_LIST = WS_ACT + (size_t)S_ * DFF * 2;
constexpr size_t WS_PO = WS_LIST + (size_t)16 * 32 * 8192 * 2;
constexpr size_t WS_PML = WS_PO + (size_t)S_ * 16 * 3 * 128 * 2;
constexpr size_t WS_SC = WS_PML + (size_t)S_ * 16 * 3 * 2 * 4;
constexpr size_t WS_PB = WS_SC + (size_t)65792 * 2048;
constexpr size_t WS_END = WS_PB + (size_t)128 * 65536 * 4;
constexpr size_t WS_MODP = WS_PB;
constexpr int CW_CONVQ = 17408;
constexpr int CW_SPLIT = 16384;
constexpr size_t WS_KMH = 9 * MiB, WS_KML = 10 * MiB;
constexpr size_t WS_SEL3 = 11 * MiB;
constexpr int CW_DSAQ = 12288;
constexpr size_t WS_KSUM = 512 * 1024;
constexpr int CW_MCNT = 8192;

struct P {
    const float *x, *c; const int* pos; const float *a_w_in, *a_w_o, *b_w_in, *b_w_o, *ada_w, *ada_b, *norm_g, *ffn_w_in, *ffn_w_out;
    float* out; unsigned char* ws;
};

template <int MAP> __device__ __forceinline__ void transpose_item(const float* W, int K, int N, f16_t* WT, LAS float* scr, int item, int nblk, int lane) {
    const int kb = item / nblk, nb = item % nblk, k0 = 64 * kb, n0 = 32 * nb;
    const int ncol = n0 + (lane & 31); const bool ok = ncol < N;
#pragma unroll 8
    for (int i = 0; i < 32; ++i) { const int kk = 2 * i + (lane >> 5); scr[kk * 33 + (lane & 31)] = ok ? W[(size_t)(k0 + kk) * N + ncol] : 0.f; }
    asm volatile("s_waitcnt lgkmcnt(0)" ::: "memory");
    const int c = lane & 7;
#pragma unroll
    for (int j = 0; j < 4; ++j) { const int n = (lane >> 3) + 8 * j; const LAS float* s = scr + (8 * c) * 33 + n;
        u32x4 o; o.x = pk_f16(s[0 * 33], s[1 * 33]); o.y = pk_f16(s[2 * 33], s[3 * 33]); o.z = pk_f16(s[4 * 33], s[5 * 33]); o.w = pk_f16(s[6 * 33], s[7 * 33]);
        int nn = n0 + n, row;
        if (MAP == 1) { const int isg = nn >= DFF ? 1 : 0, cc = nn - isg * DFF; row = (cc >> 7) * 256 + isg * 128 + (cc & 127); } else row = nn;
        *(u32x4*)(WT + (size_t)row * K + k0 + 8 * c) = o; }
    asm volatile("s_waitcnt lgkmcnt(0)" ::: "memory");
}


#define XB_TMO      128
#define XB_XCNT(j)  (256  + 64 * (j))
#define XB_XSUB(j)  (1280 + 64 * (j))
#define XB_XGEN(j)  (2304 + 64 * (j))
#define XB_TOP      3328
#define XB_TOPGEN   3392
#define XCD_BAR_WORDS 3456
#define XB_SPIN_CAP (1u << 22)
__device__ __forceinline__ unsigned xb_ld(unsigned* p)              { return __hip_atomic_load(p, __ATOMIC_RELAXED, __HIP_MEMORY_SCOPE_AGENT); }
__device__ __forceinline__ unsigned xb_add(unsigned* p, unsigned v) { return __hip_atomic_fetch_add(p, v, __ATOMIC_RELAXED, __HIP_MEMORY_SCOPE_AGENT); }
__device__ __forceinline__ unsigned xb_xcc_id() { return (unsigned)__builtin_amdgcn_s_getreg((3 << 11) | 20) & 0xFu; }
#define XB_SPIN(cond, bar) do { unsigned _sp = 0; while (cond) { __builtin_amdgcn_s_sleep(1); \
    if ((++_sp & 255u) == 0u) { if (xb_ld(&(bar)[XB_TMO])) break; if (_sp > XB_SPIN_CAP) { atomicAdd(&(bar)[XB_TMO], 1u); break; } } } } while (0)
struct XcdBarrier { unsigned* bar; unsigned x; volatile LAS unsigned* st; };
__device__ __forceinline__ XcdBarrier xcd_barrier_post(unsigned* bar, volatile LAS unsigned* st) {
    XcdBarrier b; b.bar = bar; b.x = xb_xcc_id(); b.st = st;
    if (threadIdx.x == 0) (void)xb_add(&bar[XB_XCNT(b.x)], 1u);
    return b;
}
__device__ __forceinline__ void xcd_barrier_complete(unsigned* bar, unsigned x, unsigned& nloc, unsigned& nx) {
    const unsigned G = gridDim.x * gridDim.y * gridDim.z;
    unsigned sum, cnt, mine, sp = 0u;
    for (;;) {
        sum = 0u; cnt = 0u; mine = 0u;
#pragma unroll
        for (unsigned j = 0; j < 16; ++j) { const unsigned c = xb_ld(&bar[XB_XCNT(j)]); sum += c; cnt += (c > 0u) ? 1u : 0u; mine = (j == x) ? c : mine; }
        if (sum == G) break;
        __builtin_amdgcn_s_sleep(1);
        if ((++sp & 255u) == 0u) { if (xb_ld(&bar[XB_TMO])) break; if (sp > XB_SPIN_CAP) { atomicAdd(&bar[XB_TMO], 1u); break; } }
    }
    nloc = mine > 0u ? mine : 1u; nx = cnt > 0u ? cnt : 1u;
}
__device__ __forceinline__ void xcd_barrier(const XcdBarrier& b) {
    asm volatile("s_waitcnt vmcnt(0)" ::: "memory");
    __syncthreads();
    if (threadIdx.x == 0) {
        unsigned* bar = b.bar;
        __builtin_amdgcn_s_waitcnt(0);
        unsigned nloc = b.st[0], nx = b.st[1];
        if (nloc == 0u) { xcd_barrier_complete(bar, b.x, nloc, nx); b.st[0] = nloc; b.st[1] = nx; }
        const unsigned old = xb_add(&bar[XB_XSUB(b.x)], 1u);
        const unsigned gen = old / nloc;
        if (old + 1u == (gen + 1u) * nloc) {
            __builtin_amdgcn_fence(__ATOMIC_RELEASE, "agent");
            asm volatile("s_waitcnt vmcnt(0)" ::: "memory");
            const unsigned og = xb_add(&bar[XB_TOP], 1u);
            const unsigned tg = og / nx;
            if (og + 1u == (tg + 1u) * nx) xb_add(&bar[XB_TOPGEN], 1u);
            else XB_SPIN(xb_ld(&bar[XB_TOPGEN]) == tg, bar);
            __builtin_amdgcn_fence(__ATOMIC_ACQUIRE, "agent");
            xb_add(&bar[XB_XGEN(b.x)], 1u);
            asm volatile("s_waitcnt vmcnt(0)" ::: "memory");
        } else {
            XB_SPIN(xb_ld(&bar[XB_XGEN(b.x)]) == gen, bar);
            __builtin_amdgcn_fence(__ATOMIC_ACQUIRE, "agent");
            asm volatile("s_waitcnt vmcnt(0)" ::: "memory");
        }
    }
    __syncthreads();
}

constexpr int LDS_RING = 131072, LDS_MISC = LDS_RING, LDS_BYTES = 147456;
template <int MAP, bool NT> __device__ __forceinline__ void transpose_item64(const float* W, int K, int N, f16_t* WT, LAS float* scr, int item, int nblk, int lane) {
    const int kb = item / nblk, nb = item % nblk, k0 = 64 * kb, n0 = 64 * nb;
    const int r4 = lane >> 4, c4 = lane & 15, ncol = n0 + 4 * c4; const bool ok = ncol < N;
    f32x4 v[16];
#pragma unroll
    for (int i = 0; i < 16; ++i) { const f32x4* wp = (const f32x4*)(W + (size_t)(k0 + 4 * i + r4) * N + ncol); v[i] = ok ? (NT ? __builtin_nontemporal_load(wp) : *wp) : (f32x4){0.f, 0.f, 0.f, 0.f}; }
    __builtin_amdgcn_sched_barrier(0);
#pragma unroll
    for (int i = 0; i < 16; ++i) { const int kk = 4 * i + r4; *(LAS f32x4*)(scr + kk * 64 + ((4 * c4) ^ (8 * (kk >> 3)))) = v[i]; }
    asm volatile("s_waitcnt lgkmcnt(0)" ::: "memory");
    const int c = lane & 7;
#pragma unroll
    for (int j = 0; j < 8; ++j) { const int n = (lane >> 3) + 8 * j; const LAS float* s = scr + (8 * c) * 64 + (n ^ (8 * c));
        u32x4 o; o.x = pk_f16(s[0 * 64], s[1 * 64]); o.y = pk_f16(s[2 * 64], s[3 * 64]); o.z = pk_f16(s[4 * 64], s[5 * 64]); o.w = pk_f16(s[6 * 64], s[7 * 64]);
        int nn = n0 + n, row;
        if (MAP == 1) { const int isg = nn >= DFF ? 1 : 0, cc = nn - isg * DFF; row = (cc >> 7) * 256 + isg * 128 + (cc & 127); } else row = nn;
        if (NT) __builtin_nontemporal_store(o, (u32x4*)(WT + (size_t)row * K + k0 + 8 * c)); else *(u32x4*)(WT + (size_t)row * K + k0 + 8 * c) = o; }
    asm volatile("s_waitcnt lgkmcnt(0)" ::: "memory");
}

namespace cv {
constexpr int NB_A = A_INP / 64, I_A = (D_ / 64) * NB_A;
constexpr int NB_O = D_ / 64, I_O = (D_ / 64) * NB_O;
constexpr int NB_B = B_IN / 64, I_B = (D_ / 64) * NB_B;
constexpr int NB_1 = 2 * DFF / 64, I_1 = (D_ / 64) * NB_1;
constexpr int NB_2 = D_ / 64, I_2 = (DFF / 64) * NB_2;
constexpr int O_A = 0, O_AO = O_A + 2 * I_A, O_B = O_AO + 2 * I_O, O_BO = O_B + 2 * I_B, O_1 = O_BO + 2 * I_O, O_2 = O_1 + 4 * I_1, TOT = O_2 + 4 * I_2;
constexpr int N_LA = I_A + I_O + I_1 + I_2, N_LB = I_B + I_O + I_1 + I_2;
}
__device__ __forceinline__ int conv_map_a(int j, int la, int l) { using namespace cv;
    if (j < I_A) return O_A + la * I_A + j; j -= I_A; if (j < I_O) return O_AO + la * I_O + j; j -= I_O; if (j < I_1) return O_1 + l * I_1 + j; j -= I_1; return O_2 + l * I_2 + j; }
__device__ __forceinline__ int conv_map_b(int j, int lb, int l) { using namespace cv;
    if (j < I_B) return O_B + lb * I_B + j; j -= I_B; if (j < I_O) return O_BO + lb * I_O + j; j -= I_O; if (j < I_1) return O_1 + l * I_1 + j; j -= I_1; return O_2 + l * I_2 + j; }
__device__ __forceinline__ int conv_count(int stage) { return stage == 0 ? cv::N_LA : stage == 1 ? cv::N_LB + cv::N_LA : cv::N_LB; }
__device__ __forceinline__ int conv_map(int stage, int j) {
    if (stage == 0) return conv_map_a(j, 0, 0);
    if (stage == 1) return j < cv::N_LB ? conv_map_b(j, 0, 1) : conv_map_a(j - cv::N_LB, 1, 2);
    return conv_map_b(j, 1, 3);
}
template <bool NT> __device__ __forceinline__ void conv_item(const P& p, LAS float* scr, int it, int lane) {
    using namespace cv; unsigned char* ws = p.ws; int r = it;
    if (r < 2 * I_A) { const int l = r / I_A; transpose_item64<0, NT>(p.a_w_in + (size_t)l * D_ * A_IN, D_, A_IN, (f16_t*)(ws + WS_WAIN) + (size_t)l * A_INP * D_, scr, r % I_A, NB_A, lane); return; } r -= 2 * I_A;
    if (r < 2 * I_O) { const int l = r / I_O; transpose_item64<0, NT>(p.a_w_o + (size_t)l * D_ * D_, D_, D_, (f16_t*)(ws + WS_WAO) + (size_t)l * D_ * D_, scr, r % I_O, NB_O, lane); return; } r -= 2 * I_O;
    if (r < 2 * I_B) { const int l = r / I_B; transpose_item64<0, NT>(p.b_w_in + (size_t)l * D_ * B_IN, D_, B_IN, (f16_t*)(ws + WS_WBIN) + (size_t)l * B_IN * D_, scr, r % I_B, NB_B, lane); return; } r -= 2 * I_B;
    if (r < 2 * I_O) { const int l = r / I_O; transpose_item64<0, NT>(p.b_w_o + (size_t)l * D_ * D_, D_, D_, (f16_t*)(ws + WS_WBO) + (size_t)l * D_ * D_, scr, r % I_O, NB_O, lane); return; } r -= 2 * I_O;
    if (r < 4 * I_1) { const int l = r / I_1; transpose_item64<1, NT>(p.ffn_w_in + (size_t)l * D_ * 2 * DFF, D_, 2 * DFF, (f16_t*)(ws + WS_WF1) + (size_t)l * 2 * DFF * D_, scr, r % I_1, NB_1, lane); return; } r -= 4 * I_1;
    { const int l = r / I_2; transpose_item64<0, NT>(p.ffn_w_out + (size_t)l * DFF * D_, DFF, D_, (f16_t*)(ws + WS_WF2) + (size_t)l * D_ * DFF, scr, r % I_2, NB_2, lane); }
}

__device__ __forceinline__ void phase_prologue(const P& p, LAS unsigned char* lds) {
    const int tid = otid(), lane = tid & 63, wave = tid >> 6; const int bid = obid();
    LAS float* scr = (LAS float*)(lds + wave * 16384);
    const int gw = bid * 8 + wave, NGW = gridDim.x * 8;
    unsigned char* ws = p.ws;
    { const int n0 = conv_count(0);
        for (int j = gw; j < n0; j += NGW) conv_item<false>(p, scr, conv_map(0, j), lane); }
    {
        float* part = (float*)(ws + WS_MODP);
        for (int it = gw; it < 4 * 32 * 48; it += NGW) {
            const int l = it / 1536, kc = (it % 1536) / 48, nc = it % 48;
            const float* W = p.ada_w + ((size_t)l * D_ + kc * 64) * 12288 + nc * 256 + 4 * lane;
            f32x4 a = {0.f, 0.f, 0.f, 0.f};
#pragma unroll 8
            for (int k = 0; k < 64; ++k) { const float cv = p.c[kc * 64 + k]; const float sv = cv / (1.0f + __expf(-cv)); a += sv * *(const f32x4*)(W + (size_t)k * 12288); }
            *(f32x4*)(part + ((size_t)(l * 32 + kc)) * 12288 + nc * 256 + 4 * lane) = a;
        }
    }
    {
        float* rcA = (float*)(ws + WS_ROPE); float* rsA = rcA + S_ * 16; float* rcI = rsA + S_ * 16; float* rsI = rcI + S_ * 8;
        for (int i = bid * 512 + tid; i < S_ * 24; i += gridDim.x * 512) {
            const int t = i / 24, j = i % 24; const double pos = (double)p.pos[t];
            if (j < 16) { const double ang = pos * pow(500000.0, -(double)j / 16.0); rcA[t * 16 + j] = (float)cos(ang); rsA[t * 16 + j] = (float)sin(ang); }
            else { const int jj = j - 16; const double ang = pos * pow(500000.0, -(double)jj / 8.0); rcI[t * 8 + jj] = (float)cos(ang); rsI[t * 8 + jj] = (float)sin(ang); }
        }
    }
}
__device__ __forceinline__ void phase_mod_reduce(const P& p) {
    const float* part = (const float*)(p.ws + WS_MODP);
    for (int i = obid() * 512 + otid(); i < 4 * 12288; i += gridDim.x * 512) {
        const int l = i / 12288, n = i % 12288; float s = p.ada_b[i];
#pragma unroll
        for (int kc = 0; kc < 32; ++kc) s += part[(size_t)(l * 32 + kc) * 12288 + n];
        ((float*)(p.ws + WS_MOD))[i] = s; }
}

__device__ __forceinline__ void nr_unpack8(const u32x4 w, f32x4& a, f32x4& b) {
    const unsigned w0 = w.x, w1 = w.y, w2 = w.z, w3 = w.w;
    const f16x2 h0 = __builtin_bit_cast(f16x2, w0), h1 = __builtin_bit_cast(f16x2, w1), h2 = __builtin_bit_cast(f16x2, w2), h3 = __builtin_bit_cast(f16x2, w3);
    a = (f32x4){(float)h0[0], (float)h0[1], (float)h1[0], (float)h1[1]}; b = (f32x4){(float)h2[0], (float)h2[1], (float)h3[0], (float)h3[1]};
}
template <bool HAS_Y, bool HAS_H, bool XI16, bool XO16>
__device__ __forceinline__ void norm_rows(const void* xin_, const f16_t* y, const float* gate, const float* gamY, void* xout_,
                                          const float* gamH, const float* sc, const float* sh, f16_t* hout) {
    const int tid_ = otid(); const int lane = tid_ & 63, gw = obid() * 8 + (tid_ >> 6), NGW = (int)gridDim.x * 8;
    f32x4 cA[8], cB[8], cC[8];
#pragma unroll
    for (int j = 0; j < 8; ++j) { const int o = 8 * lane + 512 * (j >> 1) + 4 * (j & 1);
        if (HAS_Y) cA[j] = *(const f32x4*)(gate + o) * *(const f32x4*)(gamY + o);
        if (HAS_H) { cB[j] = *(const f32x4*)(gamH + o) * (1.0f + *(const f32x4*)(sc + o)); cC[j] = *(const f32x4*)(sh + o); } }
    f32x4 xv[8], yv[8];
    for (int r = gw; r < S_; r += NGW) {
        const size_t o = (size_t)r * D_ + 8 * lane;
#pragma unroll
        for (int jj = 0; jj < 4; ++jj) {
            if (XI16) { const u32x4 xw = *(const u32x4*)((const f16_t*)xin_ + o + 512 * jj); nr_unpack8(xw, xv[2 * jj], xv[2 * jj + 1]); }
            else { xv[2 * jj] = *(const f32x4*)((const float*)xin_ + o + 512 * jj); xv[2 * jj + 1] = *(const f32x4*)((const float*)xin_ + o + 512 * jj + 4); }
            if (HAS_Y) { const u32x4 yw = *(const u32x4*)(y + o + 512 * jj); nr_unpack8(yw, yv[2 * jj], yv[2 * jj + 1]); } }
        __builtin_amdgcn_sched_barrier(0);
        if (HAS_Y) {
            float ss = 0.f;
#pragma unroll
            for (int j = 0; j < 8; ++j) ss += (yv[j].x * yv[j].x + yv[j].y * yv[j].y) + (yv[j].z * yv[j].z + yv[j].w * yv[j].w);
            const float rstd = 1.0f / sqrtf(wave_sum(ss) * (1.0f / D_) + EPS);
#pragma unroll
            for (int j = 0; j < 8; ++j) xv[j] = xv[j] + cA[j] * (yv[j] * rstd);
#pragma unroll
            for (int jj = 0; jj < 4; ++jj) {
                if (XO16) { u32x4 w; w.x = pk_f16(xv[2 * jj].x, xv[2 * jj].y); w.y = pk_f16(xv[2 * jj].z, xv[2 * jj].w); w.z = pk_f16(xv[2 * jj + 1].x, xv[2 * jj + 1].y); w.w = pk_f16(xv[2 * jj + 1].z, xv[2 * jj + 1].w);
                    *(u32x4*)((f16_t*)xout_ + o + 512 * jj) = w; nr_unpack8(w, xv[2 * jj], xv[2 * jj + 1]); }
                else { *(f32x4*)((float*)xout_ + o + 512 * jj) = xv[2 * jj]; *(f32x4*)((float*)xout_ + o + 512 * jj + 4) = xv[2 * jj + 1]; } }
        }
        if (HAS_H) {
            float ss = 0.f;
#pragma unroll
            for (int j = 0; j < 8; ++j) ss += (xv[j].x * xv[j].x + xv[j].y * xv[j].y) + (xv[j].z * xv[j].z + xv[j].w * xv[j].w);
            const float rstd = 1.0f / sqrtf(wave_sum(ss) * (1.0f / D_) + EPS);
#pragma unroll
            for (int jj = 0; jj < 4; ++jj) { const f32x4 h0 = (xv[2 * jj] * rstd) * cB[2 * jj] + cC[2 * jj], h1 = (xv[2 * jj + 1] * rstd) * cB[2 * jj + 1] + cC[2 * jj + 1];
                u32x4 w; w.x = pk_f16(h0.x, h0.y); w.y = pk_f16(h0.z, h0.w); w.z = pk_f16(h1.x, h1.y); w.w = pk_f16(h1.z, h1.w); *(u32x4*)(hout + o + 512 * jj) = w; }
        }
        __builtin_amdgcn_sched_barrier(0);
    }
}
__device__ __forceinline__ void phase_norm(const P& p, int mode, int l) {
    const float* mod = (const float*)(p.ws + WS_MOD) + (size_t)l * 12288; const float* ng = p.norm_g + (size_t)l * 4 * D_;
    const f16_t* y = (const f16_t*)(p.ws + WS_Y); f16_t* H = (f16_t*)(p.ws + WS_H);
    f16_t* X16 = (f16_t*)(p.ws + WS_Y + (size_t)S_ * D_ * 2);
    if (mode == 0) norm_rows<false, true, false, false>(p.x, nullptr, nullptr, nullptr, nullptr, ng, mod + 1 * D_, mod + 0 * D_, H);
    else if (mode == 1) { if (l == 0) norm_rows<true, true, false, true>(p.x, y, mod + 2 * D_, ng + D_, X16, ng + 2 * D_, mod + 4 * D_, mod + 3 * D_, H);
                          else norm_rows<true, true, true, true>(X16, y, mod + 2 * D_, ng + D_, X16, ng + 2 * D_, mod + 4 * D_, mod + 3 * D_, H); }
    else { const float* modn = mod + 12288; const float* ngn = ng + 4 * D_;
        if (l < 3) norm_rows<true, true, true, true>(X16, y, mod + 5 * D_, ng + 3 * D_, X16, ngn, modn + 1 * D_, modn + 0 * D_, H);
        else norm_rows<true, false, true, false>(X16, y, mod + 5 * D_, ng + 3 * D_, p.out, nullptr, nullptr, nullptr, nullptr); }
}

__device__ __forceinline__ unsigned ordkey(float f) { const unsigned u = __float_as_uint(f); return (u & 0x80000000u) ? ~u : (u | 0x80000000u); }
__device__ __forceinline__ void phase_naive_topk(const P& p, LAS unsigned char* lds) {
    const int tid_ = otid(); const int half = tid_ >> 8, tid = tid_ & 255, lane = tid & 63, wave = tid >> 6; const int bid = obid();
    LAS float* qi = (LAS float*)(lds + half * 40960); LAS float* wv = qi + 1024; LAS unsigned* keys = (LAS unsigned*)(wv + 16); LAS unsigned* red = keys + S_;
    const f16_t* KI = (const f16_t*)(p.ws + WS_KI);
    for (int t0 = bid * 2; t0 < S_; t0 += gridDim.x * 2) {
        const int t = t0 + half;
        const f16_t* QI = (const f16_t*)(p.ws + WS_QI) + (size_t)t * 1024; const float* WI = (const float*)(p.ws + WS_WI) + (size_t)t * 16;
        int* sel = (int*)(p.ws + WS_SEL) + (size_t)t * NSEL;
        for (int i = tid; i < 1024; i += 256) qi[i] = h2f(QI[i]);
        if (tid < 16) wv[tid] = WI[tid];
        __syncthreads();
        const int n = t + 1; const bool small = n <= NSEL;
        if (!small) for (int s = tid; s < n; s += 256) {
            float kk[64];
            const u32x4* kp = (const u32x4*)(KI + (size_t)s * 64);
#pragma unroll
            for (int c = 0; c < 8; ++c) { const u32x4 w = kp[c];
#pragma unroll
                for (int e = 0; e < 4; ++e) { kk[8 * c + 2 * e] = h2f((f16_t)(w[e] & 0xffff)); kk[8 * c + 2 * e + 1] = h2f((f16_t)(w[e] >> 16)); } }
            float sc = 0.f;
            for (int h = 0; h < 16; ++h) { float d = 0.f;
#pragma unroll
                for (int e = 0; e < 64; ++e) d = fmaf(qi[h * 64 + e], kk[e], d);
                sc = fmaf(wv[h], fmaxf(d, 0.f), sc); }
            keys[s] = ordkey(sc + 0.0f);
        }
        __syncthreads();
        unsigned prefix = 0u; int k = NSEL;
        for (int bit = 31; bit >= 0; --bit) {
            const unsigned want = (prefix >> bit) | 1u; int cnt = 0;
            if (!small) for (int s = tid; s < n; s += 256) cnt += ((keys[s] >> bit) == want) ? 1 : 0;
#pragma unroll
            for (int o = 1; o < 64; o <<= 1) cnt += __shfl_xor(cnt, o);
            if (lane == 0) red[wave] = (unsigned)cnt;
            __syncthreads();
            const int tot = (int)(red[0] + red[1] + red[2] + red[3]);
            __syncthreads();
            if (tot >= k) prefix |= (1u << bit); else k -= tot;
        }
        if (small) sel[tid] = tid < n ? tid : -1;
        else if (wave == 0) {
            int outc = 0, eqc = 0;
            for (int s0 = 0; s0 < n; s0 += 64) { const int s = s0 + lane; const unsigned key = s < n ? keys[s] : 0u; const bool gt = s < n && key > prefix, eq = s < n && key == prefix;
                const unsigned long long beq = __ballot(eq); const unsigned long long lt = (1ull << lane) - 1ull;
                const bool take = gt || (eq && (eqc + __popcll(beq & lt)) < k);
                const unsigned long long bt = __ballot(take);
                if (take) { const int pos = outc + __popcll(bt & lt); if (pos < NSEL) sel[pos] = s; }
                outc += __popcll(bt); eqc += __popcll(beq); }
        }
        __syncthreads();
    }
}
__device__ __forceinline__ void phase_naive_dsa_attn(const P& p, LAS unsigned char* lds) {
    const int tid_ = otid(); const int half = tid_ >> 8, tid = tid_ & 255, lane = tid & 63, wave = tid >> 6; const int bid = obid();
    LAS float* q = (LAS float*)(lds + half * 32768); LAS float* Sm = q + 2048; LAS int* sl = (LAS int*)(Sm + 16 * NSEL);
    const f16_t* K = (const f16_t*)(p.ws + WS_K); const f16_t* V = (const f16_t*)(p.ws + WS_V);
    for (int t0 = bid * 2; t0 < S_; t0 += gridDim.x * 2) {
        const int t = t0 + half;
        const f16_t* Q = (const f16_t*)(p.ws + WS_Q) + (size_t)t * 2048; const int* sel = (const int*)(p.ws + WS_SEL) + (size_t)t * NSEL;
        for (int i = tid; i < 2048; i += 256) q[i] = h2f(Q[i]);
        sl[tid] = sel[tid];
        __syncthreads();
        { const int key = sl[tid]; const bool valid = key >= 0 && key <= t; const float scale = 0.08838834764831845f;
            for (int g = 0; g < 4; ++g) { float kk[128];
                if (valid) { const u32x4* kp = (const u32x4*)(K + (size_t)key * 512 + g * 128);
#pragma unroll
                    for (int c = 0; c < 16; ++c) { const u32x4 w = kp[c];
#pragma unroll
                        for (int e = 0; e < 4; ++e) { kk[8 * c + 2 * e] = h2f((f16_t)(w[e] & 0xffff)); kk[8 * c + 2 * e + 1] = h2f((f16_t)(w[e] >> 16)); } } }
                for (int r = 0; r < 4; ++r) { const int h = 4 * g + r; float d = 0.f;
                    if (valid) {
#pragma unroll
                        for (int e = 0; e < 128; ++e) d = fmaf(q[h * 128 + e], kk[e], d); }
                    Sm[h * NSEL + tid] = valid ? d * scale : -INFINITY; } } }
        __syncthreads();
        for (int r = 0; r < 4; ++r) { const int h = 4 * wave + r; float v[4]; float mx = -INFINITY;
#pragma unroll
            for (int i = 0; i < 4; ++i) { v[i] = Sm[h * NSEL + lane + 64 * i]; mx = fmaxf(mx, v[i]); }
            mx = wave_max(mx); float sum = 0.f;
#pragma unroll
            for (int i = 0; i < 4; ++i) { v[i] = __expf(v[i] - mx); sum += v[i]; }
            sum = wave_sum(sum); const float inv = 1.0f / sum;
#pragma unroll
            for (int i = 0; i < 4; ++i) Sm[h * NSEL + lane + 64 * i] = v[i] * inv; }
        __syncthreads();
        { const int h = tid >> 4, dc = tid & 15, g = h >> 2; float acc[8];
#pragma unroll
            for (int e = 0; e < 8; ++e) acc[e] = 0.f;
            for (int k = 0; k < NSEL; ++k) { const float pr = Sm[h * NSEL + k]; if (pr == 0.f) continue; const int key = sl[k];
                const u32x4 w = *(const u32x4*)(V + (size_t)key * 512 + g * 128 + 8 * dc);
#pragma unroll
                for (int e = 0; e < 4; ++e) { acc[2 * e] = fmaf(pr, h2f((f16_t)(w[e] & 0xffff)), acc[2 * e]); acc[2 * e + 1] = fmaf(pr, h2f((f16_t)(w[e] >> 16)), acc[2 * e + 1]); } }
            u32x4 o; o.x = pk_f16(acc[0], acc[1]); o.y = pk_f16(acc[2], acc[3]); o.z = pk_f16(acc[4], acc[5]); o.w = pk_f16(acc[6], acc[7]);
            *(u32x4*)((f16_t*)(p.ws + WS_O) + (size_t)t * 2048 + h * 128 + 8 * dc) = o; }
        __syncthreads();
    }
}
__device__ __forceinline__ void phase_naive_moba_kmean(const P& p) {
    const int tid_ = otid(); const int sub = tid_ >> 7, d = tid_ & 127;
    for (int it = obid() * 4 + sub; it < 512; it += gridDim.x * 4) {
        const int n = it >> 4, h = it & 15; const f16_t* K = (const f16_t*)(p.ws + WS_K) + (size_t)n * 256 * 2048 + h * 128 + d;
        float s = 0.f; for (int i = 0; i < 256; ++i) s += h2f(K[(size_t)i * 2048]);
        ((float*)(p.ws + WS_KMEAN))[(size_t)it * 128 + d] = s * (1.0f / 256.0f); }
}
__device__ __forceinline__ void phase_naive_moba_attn(const P& p, LAS unsigned char* lds) {
    const int tid_ = otid(); const int half = tid_ >> 8, tid = tid_ & 255, lane = tid & 63, wave = tid >> 6; const int bid = obid();
    LAS float* q = (LAS float*)(lds + half * 8192); LAS float* gate = q + 128; LAS int* sb = (LAS int*)(gate + 32); LAS float* Sm = (LAS float*)(sb + 4); LAS float* red = Sm + 1024; LAS float* oacc = red + 8;
    const float* km = (const float*)(p.ws + WS_KMEAN);
    for (int it0 = bid * 2; it0 < S_ * 16; it0 += gridDim.x * 2) {
        const int it = it0 + half, t = it >> 4, h = it & 15, j = t >> 8;
        const f16_t* Q = (const f16_t*)(p.ws + WS_Q) + (size_t)t * 2048 + h * 128; const f16_t* K = (const f16_t*)(p.ws + WS_K) + h * 128; const f16_t* V = (const f16_t*)(p.ws + WS_V) + h * 128;
        if (tid < 128) q[tid] = h2f(Q[tid]);
        __syncthreads();
        if (tid < 32) { float g = -INFINITY; if (tid < j) { g = 0.f; const float* kp = km + ((size_t)tid * 16 + h) * 128; for (int d = 0; d < 128; ++d) g = fmaf(q[d], kp[d], g); } gate[tid] = g; }
        __syncthreads();
        if (tid == 0) { unsigned used = 0u;
            for (int s = 0; s < 3; ++s) { int best = -1; float bv = -INFINITY; for (int n = 0; n < 32; ++n) if (!((used >> n) & 1u) && n < j && (best < 0 || gate[n] > bv)) { best = n; bv = gate[n]; }
                sb[s] = best; if (best >= 0) used |= 1u << best; } }
        __syncthreads();
        const float scale = 0.08838834764831845f;
        for (int slot = 0; slot < 4; ++slot) { const int i = slot * 256 + tid; int key; bool valid;
            if (slot < 3) { valid = sb[slot] >= 0; key = (valid ? sb[slot] : 0) * 256 + tid; } else { key = j * 256 + tid; valid = key <= t; }
            float d = -INFINITY;
            if (valid) { d = 0.f; const u32x4* kp = (const u32x4*)(K + (size_t)key * 2048);
#pragma unroll
                for (int c = 0; c < 16; ++c) { const u32x4 w = kp[c];
#pragma unroll
                    for (int e = 0; e < 4; ++e) { d = fmaf(q[8 * c + 2 * e], h2f((f16_t)(w[e] & 0xffff)), d); d = fmaf(q[8 * c + 2 * e + 1], h2f((f16_t)(w[e] >> 16)), d); } }
                d *= scale; }
            Sm[i] = d; }
        __syncthreads();
        float mx = -INFINITY;
#pragma unroll
        for (int i = 0; i < 4; ++i) mx = fmaxf(mx, Sm[tid + 256 * i]);
        mx = wave_max(mx); if (lane == 0) red[wave] = mx; __syncthreads();
        mx = fmaxf(fmaxf(red[0], red[1]), fmaxf(red[2], red[3])); __syncthreads();
        float sum = 0.f;
#pragma unroll
        for (int i = 0; i < 4; ++i) { const float e = __expf(Sm[tid + 256 * i] - mx); Sm[tid + 256 * i] = e; sum += e; }
        sum = wave_sum(sum); if (lane == 0) red[wave] = sum; __syncthreads();
        const float inv = 1.0f / (red[0] + red[1] + red[2] + red[3]);
        { const int part = tid >> 6; float a0 = 0.f, a1 = 0.f;
            int blk; if (part < 3) blk = sb[part]; else blk = j;
            if (blk >= 0) for (int i = 0; i < 256; ++i) { const float pr = Sm[part * 256 + i]; if (pr == 0.f) continue; const int key = blk * 256 + i;
                const unsigned w = *(const unsigned*)(V + (size_t)key * 2048 + 2 * lane); a0 = fmaf(pr, h2f((f16_t)(w & 0xffff)), a0); a1 = fmaf(pr, h2f((f16_t)(w >> 16)), a1); }
            oacc[part * 128 + 2 * lane] = a0; oacc[part * 128 + 2 * lane + 1] = a1; }
        __syncthreads();
        if (tid < 64) { const float o0 = (oacc[2 * tid] + oacc[128 + 2 * tid] + oacc[256 + 2 * tid] + oacc[384 + 2 * tid]) * inv, o1 = (oacc[2 * tid + 1] + oacc[128 + 2 * tid + 1] + oacc[256 + 2 * tid + 1] + oacc[384 + 2 * tid + 1]) * inv;
            *(unsigned*)((f16_t*)(p.ws + WS_O) + (size_t)t * 2048 + h * 128 + 2 * tid) = pk_f16(o0, o1); }
        __syncthreads();
    }
}


typedef float f32x16 __attribute__((ext_vector_type(16)));
__device__ __forceinline__ unsigned lds_add(LAS unsigned* p, unsigned v) { return __hip_atomic_fetch_add(p, v, __ATOMIC_RELAXED, __HIP_MEMORY_SCOPE_WORKGROUP); }
__device__ __forceinline__ unsigned lds_or(LAS unsigned* p, unsigned v) { return __hip_atomic_fetch_or(p, v, __ATOMIC_RELAXED, __HIP_MEMORY_SCOPE_WORKGROUP); }
constexpr int IX_CAP = 1024;
template <int PASS>
__device__ __forceinline__ void idx_pass(const f16_t* __restrict__ KI, const f16x8 (&a)[4][4], const float (&w)[4][16], int t0g, int ntiles, int kq, int lane,
                                         LAS unsigned* hist, int qbase, const LAS int* tbv, LAS unsigned* candcnt,
                                         LAS unsigned* bm, LAS unsigned* cand_key, LAS unsigned short* cand_idx, float* __restrict__ SCu, int rowlen) {
    const int n = lane & 31, kh = lane >> 5;
    int tb[4];
    if (PASS == 2) {
#pragma unroll
        for (int pr = 0; pr < 4; ++pr) tb[pr] = tbv[qbase + 2 * pr + kh];
    }
    f16x8 b[4];
    { const f16_t* kb = KI + (size_t)(32 * (kq < ntiles ? kq : 0) + n) * 64 + 32 * kh;
#pragma unroll
        for (int s = 0; s < 4; ++s) b[s] = *(const f16x8*)(kb + 8 * s); }
    for (int kt = kq; kt < ntiles; kt += 4) {
        f16x8 bn[4];
        { const int ktn = (kt + 4 < ntiles) ? kt + 4 : kt; const f16_t* kb = KI + (size_t)(32 * ktn + n) * 64 + 32 * kh;
#pragma unroll
            for (int s = 0; s < 4; ++s) bn[s] = *(const f16x8*)(kb + 8 * s); }
        const int key = 32 * kt + n;
#pragma unroll
        for (int pr = 0; pr < 4; ++pr) {
            f32x16 c;
#pragma unroll
            for (int r = 0; r < 16; ++r) c[r] = 0.f;
#pragma unroll
            for (int s = 0; s < 4; ++s) c = __builtin_amdgcn_mfma_f32_32x32x16_f16(a[pr][s], b[s], c, 0, 0, 0);
            float sc = 0.f;
#pragma unroll
            for (int r = 0; r < 16; ++r) { const float cr_ = c[r]; const int ci_ = __builtin_bit_cast(int, cr_); const float rl = __builtin_bit_cast(float, ci_ > 0 ? ci_ : 0); sc = __builtin_fmaf(w[pr][r], rl, sc); }
            sc += 0.0f;
            const int ql = qbase + 2 * pr + kh;
            const int tq = t0g + 2 * pr + kh;
            const bool valid = key <= tq;
            const unsigned ok = ordkey(sc); const int bin = (int)(ok >> 20);
            if (PASS == 1) { SCu[ql * rowlen + key] = sc; if (valid) lds_add(hist + ql * 2048 + (bin >> 1), (bin & 1) ? 65536u : 1u); }
            else {
                const unsigned long long hm = __ballot(valid && bin > tb[pr]);
                if (n == 0) bm[ql * 256 + kt] = (unsigned)(hm >> (32 * kh));
                if (valid && bin == tb[pr]) { const unsigned slot = lds_add(candcnt + ql, 1u); if (slot < (unsigned)IX_CAP) { cand_key[ql * IX_CAP + slot] = ok; cand_idx[ql * IX_CAP + slot] = (unsigned short)key; } }
            }
        }
#pragma unroll
        for (int s = 0; s < 4; ++s) b[s] = bn[s];
    }
}
template <int STAGES> __device__ __forceinline__ void idx_unit(const P& p, LAS unsigned char* lds, int unit, int tid) {
    const int lane = tid & 63, wave = __builtin_amdgcn_readfirstlane(tid >> 6), group = wave & 1, kq = wave >> 1;
    const int t0 = unit * 16, t0g = t0 + 8 * group, qbase = 8 * group;
    const f16_t* QI = (const f16_t*)(p.ws + WS_QI); const f16_t* KI = (const f16_t*)(p.ws + WS_KI); const float* WI = (const float*)(p.ws + WS_WI);
    LAS unsigned* hist = (LAS unsigned*)lds;
    LAS unsigned* bm = (LAS unsigned*)lds;
    LAS unsigned* cand_key = (LAS unsigned*)(lds + 16384);
    LAS unsigned short* cand_idx = (LAS unsigned short*)(lds + 16384 + 65536);
    LAS int* tbv = (LAS int*)(lds + LDS_MISC + 256);
    LAS unsigned* above = (LAS unsigned*)(lds + LDS_MISC + 320);
    LAS unsigned* candcnt = (LAS unsigned*)(lds + LDS_MISC + 448);
    f16x8 a[4][4]; float w[4][16];
    { const int m = lane & 31, kh = lane >> 5, aa = m >> 3, him = (m >> 2) & 1, bb = m & 3;
#pragma unroll
        for (int pr = 0; pr < 4; ++pr) { const f16_t* qp = QI + (size_t)(t0g + 2 * pr + him) * 1024 + (4 * aa + bb) * 64 + 32 * kh;
#pragma unroll
            for (int s = 0; s < 4; ++s) a[pr][s] = *(const f16x8*)(qp + 8 * s);
            const float* wp = WI + (size_t)(t0g + 2 * pr + kh) * 16;
#pragma unroll
            for (int r4 = 0; r4 < 4; ++r4) { const f32x4 v = *(const f32x4*)(wp + 4 * r4); w[pr][4 * r4] = v.x; w[pr][4 * r4 + 1] = v.y; w[pr][4 * r4 + 2] = v.z; w[pr][4 * r4 + 3] = v.w; } } }
    const int ntiles = (t0 + 16 + 31) >> 5;
    { LAS u32x4* z = (LAS u32x4*)lds;
#pragma unroll
        for (int i = 0; i < 16; ++i) z[tid + 512 * i] = (u32x4){0u, 0u, 0u, 0u}; }
    __syncthreads();
    const int rowlen = ntiles * 32;
    float* SCu = (float*)(p.ws + WS_SC) + (size_t)((unit & 1) ? ((unit >> 1) + 1) * ((unit >> 1) + 1) : (unit >> 1) * ((unit >> 1) + 1)) * 512;
    idx_pass<1>(KI, a, w, t0g, ntiles, kq, lane, hist, qbase, tbv, candcnt, bm, cand_key, cand_idx, SCu, rowlen);
    __syncthreads();
    if (STAGES == 1) return;
#pragma unroll 1
    for (int i = 0; i < 2; ++i) {
        const int q = 2 * wave + i; const LAS unsigned* H = hist + q * 2048;
        unsigned sL = 0u;
#pragma unroll 8
        for (int k = 0; k < 32; ++k) { const unsigned v = H[2047 - 32 * lane - ((k + lane) & 31)]; sL += (v & 0xffffu) + (v >> 16); }
        unsigned Pf = sL;
#pragma unroll
        for (int o = 1; o < 64; o <<= 1) { const unsigned tt = __shfl_up(Pf, o); if (lane >= o) Pf += tt; }
        const unsigned total = __shfl(Pf, 63);
        int tbq = -1; unsigned ab = 0u;
        if (total >= (unsigned)NSEL) {
            const unsigned long long m1 = __ballot(Pf >= (unsigned)NSEL); const int Ls = __builtin_ctzll(m1);
            const unsigned ab0 = __shfl(Pf, Ls) - __shfl(sL, Ls);
            const int bin = 4095 - 64 * Ls - lane; const unsigned wv = H[bin >> 1]; const unsigned c = (bin & 1) ? (wv >> 16) : (wv & 0xffffu);
            unsigned Pc = c;
#pragma unroll
            for (int o = 1; o < 64; o <<= 1) { const unsigned tt = __shfl_up(Pc, o); if (lane >= o) Pc += tt; }
            const unsigned long long m2 = __ballot(ab0 + Pc >= (unsigned)NSEL); const int l2 = __builtin_ctzll(m2);
            tbq = 4095 - 64 * Ls - l2; ab = ab0 + __shfl(Pc, l2) - __shfl(c, l2);
        }
        if (lane == 0) { tbv[q] = tbq; above[q] = ab; candcnt[q] = 0u; }
    }
    __syncthreads();
    {
        const int q0 = 2 * wave; const int tb0 = tbv[q0], tb1 = tbv[q0 + 1];
        const float* row0 = SCu + q0 * rowlen; const float* row1 = row0 + rowlen;
        const int nch = (rowlen + 255) >> 8; unsigned cnt0 = 0u, cnt1 = 0u;
        const unsigned long long ltm = (1ull << lane) - 1ull;
        const int sh4 = 4 * (lane & 7);
#pragma unroll 1
        for (int c0 = 0; c0 < nch; c0 += 16) {
            f32x4 v0[16], v1[16];
#pragma unroll
            for (int j = 0; j < 16; ++j) { const int key = 256 * (c0 + j) + 4 * lane; const int kc = key < rowlen ? key : rowlen - 4; v0[j] = *(const f32x4*)(row0 + kc); v1[j] = *(const f32x4*)(row1 + kc); }
#pragma unroll
            for (int j = 0; j < 16; ++j) {
                if (c0 + j < nch) {
                    const int key = 256 * (c0 + j) + 4 * lane;
#pragma unroll
                    for (int rr = 0; rr < 2; ++rr) {
                        const int tq = t0 + q0 + rr, tb = rr ? tb1 : tb0, q = q0 + rr; const f32x4 vv = rr ? v1[j] : v0[j];
                        unsigned nb = 0u, cadd = 0u;
#pragma unroll
                        for (int e4 = 0; e4 < 4; ++e4) {
                            const float sv = vv[e4]; const unsigned ok = ordkey(sv); const int bin = (int)(ok >> 20); const bool valid = key + e4 <= tq;
                            nb |= (valid && bin > tb) ? (1u << e4) : 0u;
                            const bool cd = valid && bin == tb; const unsigned long long cm = __ballot(cd);
                            if (cd) { const unsigned slot = (rr ? cnt1 : cnt0) + cadd + (unsigned)__popcll(cm & ltm); if (slot < (unsigned)IX_CAP) { cand_key[q * IX_CAP + slot] = ok; cand_idx[q * IX_CAP + slot] = (unsigned short)(key + e4); } }
                            cadd += (unsigned)__popcll(cm);
                        }
                        if (rr) cnt1 += cadd; else cnt0 += cadd;
                        unsigned wd = nb << sh4;
                        wd |= (unsigned)__builtin_amdgcn_update_dpp(0, (int)wd, 0xB1, 0xF, 0xF, true);
                        wd |= (unsigned)__builtin_amdgcn_update_dpp(0, (int)wd, 0x4E, 0xF, 0xF, true);
                        wd |= (unsigned)__builtin_amdgcn_update_dpp(0, (int)wd, 0x141, 0xF, 0xF, true);
                        if ((lane & 7) == 0) bm[q * 256 + 8 * (c0 + j) + (lane >> 3)] = wd;
                    }
                }
            }
        }
        if (lane == 0) { candcnt[q0] = cnt0; candcnt[q0 + 1] = cnt1; }
    }
    __syncthreads();
    if (STAGES == 2) return;
#pragma unroll 1
    for (int i = 0; i < 2; ++i) {
        const int q = 2 * wave + i; const int t = t0 + q;
        const int nc = (int)min(candcnt[q], (unsigned)IX_CAP); const int tbq = tbv[q];
        const int need = (tbq >= 0) ? (NSEL - (int)above[q]) : 0;
        const LAS unsigned* ck = cand_key + q * IX_CAP; const LAS unsigned short* ci = cand_idx + q * IX_CAP;
        if (need > 0) {
            unsigned prefix = 0u; int kk = need;
            for (int bit = 19; bit >= 0; --bit) { const unsigned want = (prefix >> bit) | 1u; int cnt = 0;
                for (int c0 = 0; c0 < nc; c0 += 64) { const int c = c0 + lane; const bool hit = c < nc && (((ck[c] & 0xfffffu) >> bit) == want); cnt += __popcll(__ballot(hit)); }
                if (cnt >= kk) prefix |= (1u << bit); else kk -= cnt; }
            int neq = 0;
            for (int c0 = 0; c0 < nc; c0 += 64) { const int c = c0 + lane; neq += __popcll(__ballot(c < nc && (ck[c] & 0xfffffu) == prefix)); }
            for (int c0 = 0; c0 < nc; c0 += 64) { const int c = c0 + lane; const bool act = c < nc;
                const unsigned mk = act ? (ck[c] & 0xfffffu) : 0u; const unsigned mi = act ? ci[c] : 0u;
                bool take = act && mk > prefix;
                if (neq == kk) take = take || (act && mk == prefix);
                else if (__ballot(act && mk == prefix)) { int rank = 0;
                    for (int j = 0; j < nc; ++j) rank += ((ck[j] & 0xfffffu) == prefix && (unsigned)ci[j] < mi) ? 1 : 0;
                    take = take || (act && mk == prefix && rank < kk); }
                if (take) lds_or(bm + q * 256 + (mi >> 5), 1u << (mi & 31)); }
        }
        asm volatile("s_waitcnt lgkmcnt(0)" ::: "memory");
        unsigned v[4]; int cn = 0;
#pragma unroll
        for (int k = 0; k < 4; ++k) { const int wd = 4 * lane + k; v[k] = (wd < ntiles) ? bm[q * 256 + wd] : 0u; cn += __popc(v[k]); }
        int incl = cn;
#pragma unroll
        for (int o = 1; o < 64; o <<= 1) { const int tt = __shfl_up(incl, o); if (lane >= o) incl += tt; }
        const int total = __shfl(incl, 63); int pos = incl - cn;
        int* sel = (int*)(p.ws + WS_SEL) + (size_t)t * NSEL;
#pragma unroll
        for (int k = 0; k < 4; ++k) { unsigned x = v[k]; while (x) { const int b = __builtin_ctz(x); x &= x - 1u; if (pos < NSEL) sel[pos] = 32 * (4 * lane + k) + b; ++pos; } }
#pragma unroll
        for (int k = 0; k < 4; ++k) { const int ps = lane + 64 * k; if (ps >= total) sel[ps] = -1; }
    }
    __syncthreads();
}
template <int STAGES> __device__ __forceinline__ void phase_idx_topk(const P& p, LAS unsigned char* lds, int cstage) {
    const int tid = otid(), bid = obid();
    const int G8 = (int)gridDim.x * 8, ccount = cstage >= 0 ? conv_count(cstage) : 0, R = (ccount + G8 - 1) / G8;
    int r = 0, slot = 0;
    for (int pi = bid; pi < 256; pi += (int)gridDim.x) {
#pragma unroll 1
        for (int half = 0; half < 2; ++half) {
            idx_unit<STAGES>(p, lds, half ? 511 - pi : pi, tid);
            ++slot; const int rend = (pi + (int)gridDim.x < 256 || half == 0) ? min(R, (R * slot + 1) / 2) : R;
            if (r < rend) {
                const int t2 = otid(), lane = t2 & 63, wave = __builtin_amdgcn_readfirstlane(t2 >> 6);
                for (; r < rend; ++r) { const int j = (r * (int)gridDim.x + bid) * 8 + wave; if (j < ccount) conv_item<true>(p, (LAS float*)(lds + wave * 16384), conv_map(cstage, j), lane); }
                __syncthreads();
            }
        }
    }
}

__device__ __forceinline__ void phase_dsa_attn(const P& p, LAS unsigned char* lds) {
    const int tid = otid(), lane = tid & 63, wave = __builtin_amdgcn_readfirstlane(tid >> 6), bid = obid();
    const int n = lane & 15, kq = lane >> 4;
    LAS unsigned char* Pl = lds + wave * 9216;
    LAS int* sl = (LAS int*)(Pl + 8192);
    const f16_t* Qb = (const f16_t*)(p.ws + WS_Q); const f16_t* Kb = (const f16_t*)(p.ws + WS_K); const f16_t* Vb = (const f16_t*)(p.ws + WS_V);
    const int* SELb = (const int*)(p.ws + WS_SEL); f16_t* Ob = (f16_t*)(p.ws + WS_O);
    const float scale = 0.08838834764831845f;
    for (int t = bid * 8 + wave; t < S_; t += (int)gridDim.x * 8) {
        { const u32x4 v = *(const u32x4*)(SELb + (size_t)t * NSEL + 4 * lane); *(LAS u32x4*)(sl + 4 * lane) = v; }
        f16x8 A[16];
        { const f16_t* qp = Qb + (size_t)t * 2048 + n * 128 + 8 * kq; f16x8 qr[4]; f16x8 zero;
#pragma unroll
            for (int j = 0; j < 8; ++j) zero[j] = (_Float16)0.f;
#pragma unroll
            for (int s4 = 0; s4 < 4; ++s4) qr[s4] = *(const f16x8*)(qp + 32 * s4);
#pragma unroll
            for (int s = 0; s < 16; ++s) A[s] = ((n >> 2) == (s >> 2)) ? qr[s & 3] : zero; }
        asm volatile("s_waitcnt lgkmcnt(0)" ::: "memory");
        f32x4 Sg[16];
#pragma unroll
        for (int tile = 0; tile < 16; ++tile) {
            const int key = sl[16 * tile + n]; const bool valid = key >= 0; const int kc = valid ? key : 0;
            const f16_t* kp = Kb + (size_t)kc * 512 + 8 * kq;
            f32x4 c = {0.f, 0.f, 0.f, 0.f};
#pragma unroll
            for (int s = 0; s < 16; ++s) { const f16x8 b = *(const f16x8*)(kp + 32 * s); c = __builtin_amdgcn_mfma_f32_16x16x32_f16(A[s], b, c, 0, 0, 0); }
#pragma unroll
            for (int i = 0; i < 4; ++i) Sg[tile][i] = valid ? c[i] * scale : -INFINITY;
        }
        float mx[4], lsum[4];
#pragma unroll
        for (int i = 0; i < 4; ++i) { float m = Sg[0][i];
#pragma unroll
            for (int tile = 1; tile < 16; ++tile) m = fmaxf(m, Sg[tile][i]);
            m = fmaxf(m, __shfl_xor(m, 1)); m = fmaxf(m, __shfl_xor(m, 2)); m = fmaxf(m, __shfl_xor(m, 4)); m = fmaxf(m, __shfl_xor(m, 8)); mx[i] = m; lsum[i] = 0.f; }
#pragma unroll
        for (int tile = 0; tile < 16; ++tile) { float pv[4];
#pragma unroll
            for (int i = 0; i < 4; ++i) { pv[i] = __expf(Sg[tile][i] - mx[i]); lsum[i] += pv[i]; }
            u32x2 w; w.x = pk_f16(pv[0], pv[1]); w.y = pk_f16(pv[2], pv[3]);
            *(LAS u32x2*)(Pl + (16 * tile + n) * 32 + kq * 8) = w; }
        float inv[4];
#pragma unroll
        for (int i = 0; i < 4; ++i) { float l = lsum[i]; l += __shfl_xor(l, 1); l += __shfl_xor(l, 2); l += __shfl_xor(l, 4); l += __shfl_xor(l, 8); inv[i] = 1.0f / l; }
        asm volatile("s_waitcnt lgkmcnt(0)" ::: "memory");
        float acc[4][8];
#pragma unroll
        for (int r = 0; r < 4; ++r)
#pragma unroll
            for (int j = 0; j < 8; ++j) acc[r][j] = 0.f;
#pragma unroll 8
        for (int k = 0; k < NSEL; ++k) {
            const int key = __builtin_amdgcn_readfirstlane(sl[k]); const int kc = key < 0 ? 0 : key;
            const f16x8 v = *(const f16x8*)(Vb + (size_t)kc * 512 + 8 * lane);
            const f16x4 pr = *(const LAS f16x4*)(Pl + k * 32 + kq * 8);
#pragma unroll
            for (int r = 0; r < 4; ++r)
#pragma unroll
                for (int j = 0; j < 8; ++j) acc[r][j] = __builtin_fmaf((float)pr[r], (float)v[j], acc[r][j]);
        }
#pragma unroll
        for (int r = 0; r < 4; ++r) { u32x4 o; o.x = pk_f16(acc[r][0] * inv[r], acc[r][1] * inv[r]); o.y = pk_f16(acc[r][2] * inv[r], acc[r][3] * inv[r]);
            o.z = pk_f16(acc[r][4] * inv[r], acc[r][5] * inv[r]); o.w = pk_f16(acc[r][6] * inv[r], acc[r][7] * inv[r]);
            *(u32x4*)(Ob + (size_t)t * 2048 + (4 * kq + r) * 128 + 8 * n) = o; }
        asm volatile("s_waitcnt lgkmcnt(0)" ::: "memory");
    }
}

typedef short s16x4 __attribute__((ext_vector_type(4)));
__device__ __forceinline__ unsigned off_b(unsigned row, unsigned ch) { return 256u * row + 16u * (ch ^ (((row & 3u) << 2) | ((row >> 2) & 3u))); }
__device__ __forceinline__ f16x4 tr16(const LAS unsigned char* p) { return __builtin_bit_cast(f16x4, __builtin_amdgcn_ds_read_tr16_b64_v4i16((LAS s16x4*)p)); }
__device__ __forceinline__ int crow(int i, int h) { return (i & 3) + 8 * (i >> 2) + 4 * h; }
__device__ __forceinline__ void phase_moba_kmean(const P& p) {
    const int tid_ = otid(); const int sub = tid_ >> 7, d = tid_ & 127;
    for (int it = obid() * 4 + sub; it < 512; it += (int)gridDim.x * 4) {
        const int n = it >> 4, h = it & 15; const f16_t* K = (const f16_t*)(p.ws + WS_K) + (size_t)n * 256 * 2048 + h * 128 + d;
        float s = 0.f; for (int i = 0; i < 256; ++i) s += h2f(K[(size_t)i * 2048]);
        s *= (1.0f / 256.0f);
        const _Float16 hi = (_Float16)s; const _Float16 lo = (_Float16)(s - (float)hi);
        ((_Float16*)(p.ws + WS_KMH))[((size_t)h * 32 + n) * 128 + d] = hi; ((_Float16*)(p.ws + WS_KML))[((size_t)h * 32 + n) * 128 + d] = lo; }
}
__device__ __forceinline__ void phase_moba_gate(const P& p, int lb) {
    const int tid = otid(), lane = tid & 63, wave = __builtin_amdgcn_readfirstlane(tid >> 6), bid = obid();
    const int r = lane & 31, hh = lane >> 5;
    const f16_t* Qb = (const f16_t*)(p.ws + WS_Q); const float* KS = (const float*)(p.ws + WS_KSUM) + (size_t)lb * 65536;
    unsigned* SEL3 = (unsigned*)(p.ws + WS_SEL3); unsigned short* LIST = (unsigned short*)(p.ws + WS_LIST); unsigned* CNT = (unsigned*)(p.ws + WS_CTL) + CW_MCNT + lb * 512;
    for (int it = bid * 8 + wave; it < 256 * 16; it += (int)gridDim.x * 8) {
        const int qt = it >> 4, h = it & 15, t = qt * 32 + r, j = t >> 8;
        f32x16 g;
#pragma unroll
        for (int i = 0; i < 16; ++i) g[i] = 0.f;
        const f16_t* qp = Qb + (size_t)t * 2048 + h * 128 + 8 * hh; const float* kp = KS + ((size_t)h * 32 + r) * 128 + 8 * hh;
#pragma unroll
        for (int st = 0; st < 8; ++st) { const f16x8 qf = *(const f16x8*)(qp + 16 * st);
            const f32x4 k0 = *(const f32x4*)(kp + 16 * st) * (1.0f / 256.0f), k1 = *(const f32x4*)(kp + 16 * st + 4) * (1.0f / 256.0f);
            f16x8 kh, kl;
#pragma unroll
            for (int e = 0; e < 4; ++e) { kh[e] = (_Float16)k0[e]; kl[e] = (_Float16)(k0[e] - (float)kh[e]); kh[4 + e] = (_Float16)k1[e]; kl[4 + e] = (_Float16)(k1[e] - (float)kh[4 + e]); }
            g = __builtin_amdgcn_mfma_f32_32x32x16_f16(kh, qf, g, 0, 0, 0);
            g = __builtin_amdgcn_mfma_f32_32x32x16_f16(kl, qf, g, 0, 0, 0); }
        float bv[3] = {-INFINITY, -INFINITY, -INFINITY}; int bi[3] = {255, 255, 255};
#pragma unroll
        for (int i = 0; i < 16; ++i) { const int n = crow(i, hh); const float v = (n < j) ? g[i] : -INFINITY;
            const bool b0 = v > bv[0] || (v == bv[0] && n < bi[0]), b1 = v > bv[1] || (v == bv[1] && n < bi[1]), b2 = v > bv[2] || (v == bv[2] && n < bi[2]);
            if (n < j) {
                if (b0) { bv[2] = bv[1]; bi[2] = bi[1]; bv[1] = bv[0]; bi[1] = bi[0]; bv[0] = v; bi[0] = n; }
                else if (b1) { bv[2] = bv[1]; bi[2] = bi[1]; bv[1] = v; bi[1] = n; }
                else if (b2) { bv[2] = v; bi[2] = n; } } }
        float ov[3]; int oi[3];
#pragma unroll
        for (int k = 0; k < 3; ++k) { ov[k] = __shfl_xor(bv[k], 32); oi[k] = __shfl_xor(bi[k], 32); }
        int sel[3]; { int ia = 0, ib = 0;
#pragma unroll
            for (int k = 0; k < 3; ++k) { const float av = ia == 0 ? bv[0] : (ia == 1 ? bv[1] : bv[2]); const int ai = ia == 0 ? bi[0] : (ia == 1 ? bi[1] : bi[2]);
                const float cv = ib == 0 ? ov[0] : (ib == 1 ? ov[1] : ov[2]); const int ci = ib == 0 ? oi[0] : (ib == 1 ? oi[1] : oi[2]);
                const bool ta = av > cv || (av == cv && ai < ci);
                sel[k] = ta ? ai : ci; if (ta) ++ia; else ++ib; } }
        if (hh == 0) SEL3[(size_t)t * 16 + h] = (unsigned)sel[0] | ((unsigned)sel[1] << 8) | ((unsigned)sel[2] << 16);
#pragma unroll
        for (int k = 0; k < 3; ++k) {
            const int b = sel[k]; int cntv = 0, rank = 0, lead = 0;
            for (int nb = 0; nb < j; ++nb) { const unsigned mm = (unsigned)__ballot(b == nb);
                if (b == nb) { cntv = __popc(mm); rank = __popc(mm & ((1u << r) - 1u)); lead = __builtin_ctz(mm | 0x80000000u); } }
            unsigned base = 0u;
            if (hh == 0 && b != 255 && rank == 0) base = atomicAdd(CNT + h * 32 + b, (unsigned)cntv);
            base = (unsigned)__shfl((int)base, lead);
            if (hh == 0 && b != 255) LIST[((size_t)h * 32 + b) * 8192 + base + rank] = (unsigned short)(t | (k << 13));
        }
    }
}
template <bool CAUSAL>
__device__ __forceinline__ void moba_core(const f16x8 (&qf)[8], const LAS unsigned char* Kimg, const LAS unsigned char* Vimg, int lane, int ntile, int qin, float& m, float& l, f32x16 (&o)[4]) {
    const int r = lane & 31, hh = lane >> 5, blk = (lane >> 4) & 1, q4 = (lane & 15) >> 2, p4 = lane & 3;
    const float scale = 0.08838834764831845f;
    unsigned ka[8], va[4][2][2];
#pragma unroll
    for (int st = 0; st < 8; ++st) ka[st] = off_b(r, 2 * st + hh);
#pragma unroll
    for (int c = 0; c < 4; ++c)
#pragma unroll
        for (int s2 = 0; s2 < 2; ++s2)
#pragma unroll
            for (int t2 = 0; t2 < 2; ++t2) va[c][s2][t2] = off_b(16 * s2 + 8 * t2 + 4 * hh + q4, 4 * c + 2 * blk + (p4 >> 1)) + 8 * (p4 & 1);
    m = -INFINITY; l = 0.f;
#pragma unroll
    for (int c = 0; c < 4; ++c)
#pragma unroll
        for (int i = 0; i < 16; ++i) o[c][i] = 0.f;
    for (int kt = 0; kt < ntile; ++kt) {
        const LAS unsigned char* Kt = Kimg + kt * 8192; const LAS unsigned char* Vt = Vimg + kt * 8192;
        f32x16 sT;
#pragma unroll
        for (int i = 0; i < 16; ++i) sT[i] = 0.f;
#pragma unroll
        for (int st = 0; st < 8; ++st) sT = __builtin_amdgcn_mfma_f32_32x32x16_f16(*(const LAS f16x8*)(Kt + ka[st]), qf[st], sT, 0, 0, 0);
        float tmax = -INFINITY;
#pragma unroll
        for (int i = 0; i < 16; ++i) { float v = sT[i] * scale; if (CAUSAL) { if (32 * kt + crow(i, hh) > qin) v = -INFINITY; } sT[i] = v; tmax = fmaxf(tmax, v); }
        tmax = fmaxf(tmax, __shfl_xor(tmax, 32));
        const float mn = fmaxf(m, tmax);
        const float alpha = __expf(m - mn); m = mn;
        float ps = 0.f; f16x8 pf[2];
#pragma unroll
        for (int i = 0; i < 16; ++i) { const float e = __expf(sT[i] - mn); ps += e; pf[i >> 3][i & 7] = (_Float16)e; }
        l = l * alpha + ps;
#pragma unroll
        for (int c = 0; c < 4; ++c) {
#pragma unroll
            for (int i = 0; i < 16; ++i) o[c][i] *= alpha;
#pragma unroll
            for (int s2 = 0; s2 < 2; ++s2) { const f16x4 v0 = tr16(Vt + va[c][s2][0]), v1 = tr16(Vt + va[c][s2][1]);
                const f16x8 vf = __builtin_shufflevector(v0, v1, 0, 1, 2, 3, 4, 5, 6, 7);
                o[c] = __builtin_amdgcn_mfma_f32_32x32x16_f16(vf, pf[s2], o[c], 0, 0, 0); } }
    }
    l += __shfl_xor(l, 32);
}
__device__ __forceinline__ void moba_load_kv(const P& p, LAS unsigned char* lds, int h, int n, int tid) {
    const f16_t* Kg = (const f16_t*)(p.ws + WS_K) + (size_t)n * 256 * 2048 + h * 128; const f16_t* Vg = (const f16_t*)(p.ws + WS_V) + (size_t)n * 256 * 2048 + h * 128;
    u32x4 kr[8], vr[8];
#pragma unroll
    for (int i = 0; i < 8; ++i) { const int cid = tid + 512 * i, row = cid >> 4, ch = cid & 15;
        kr[i] = *(const u32x4*)(Kg + (size_t)row * 2048 + 8 * ch); vr[i] = *(const u32x4*)(Vg + (size_t)row * 2048 + 8 * ch); }
    __builtin_amdgcn_sched_barrier(0);
#pragma unroll
    for (int i = 0; i < 8; ++i) { const int cid = tid + 512 * i, row = cid >> 4, ch = cid & 15;
        *(LAS u32x4*)(lds + off_b(row, ch)) = kr[i]; *(LAS u32x4*)(lds + 65536 + off_b(row, ch)) = vr[i]; }
}
__device__ __forceinline__ void phase_moba_past(const P& p, LAS unsigned char* lds, int lb) {
    const int tid = otid(), lane = tid & 63, wave = __builtin_amdgcn_readfirstlane(tid >> 6), bid = obid();
    const int r = lane & 31, hh = lane >> 5;
    LAS int* start = (LAS int*)(lds + LDS_MISC + 1024);
    const unsigned* CNT = (const unsigned*)(p.ws + WS_CTL) + CW_MCNT + lb * 512;
    const unsigned short* LIST = (const unsigned short*)(p.ws + WS_LIST); const f16_t* Qb = (const f16_t*)(p.ws + WS_Q);
    f16_t* PO = (f16_t*)(p.ws + WS_PO); float* PML = (float*)(p.ws + WS_PML);
    { const int c = ((int)__hip_atomic_load(CNT + tid, __ATOMIC_RELAXED, __HIP_MEMORY_SCOPE_AGENT) + 255) >> 8; int incl = c;
#pragma unroll
        for (int o = 1; o < 64; o <<= 1) { const int tt = __shfl_up(incl, o); if (lane >= o) incl += tt; }
        LAS int* wsum = (LAS int*)(lds + LDS_MISC + 512);
        if (lane == 63) wsum[wave] = incl;
        __syncthreads();
        int base = 0;
#pragma unroll
        for (int w2 = 0; w2 < 8; ++w2) base += (w2 < wave) ? wsum[w2] : 0;
        start[tid] = base + incl - c; if (tid == 511) start[512] = base + incl;
        __syncthreads(); }
    const int total = start[512];
    const int ipw = (total + (int)gridDim.x - 1) / (int)gridDim.x, it0 = bid * ipw, it1 = (it0 + ipw < total) ? it0 + ipw : total;
    int cur = 0, loaded = -1;
    for (int it = it0; it < it1; ++it) {
        while (start[cur + 1] <= it) ++cur;
        const int h = cur >> 5, n = cur & 31, ck = it - start[cur]; const int cnt = (int)CNT[cur] - 256 * ck;
        const bool reload = cur != loaded;
        if (reload) { __syncthreads();
            moba_load_kv(p, lds, h, n, tid); loaded = cur; }
        const int row0 = 32 * wave; const bool active = row0 < cnt;
        const int ri = (row0 + r < cnt) ? row0 + r : (active ? row0 : 0);
        const unsigned e = LIST[(size_t)cur * 8192 + 256 * ck + ri]; const int t = e & 0x1fff, slot = e >> 13;
        f16x8 qf[8];
        { const f16_t* qp = Qb + (size_t)t * 2048 + h * 128 + 8 * hh;
#pragma unroll
            for (int st = 0; st < 8; ++st) qf[st] = *(const f16x8*)(qp + 16 * st); }
        if (reload) __syncthreads();
        if (active) {
            float m, l; f32x16 o[4];
            moba_core<false>(qf, lds, lds + 65536, lane, 8, 0, m, l, o);
            if (row0 + r < cnt) {
                const float inv = 1.0f / l; const size_t pi = ((size_t)t * 16 + h) * 3 + slot;
                if (hh == 0) { PML[pi * 2] = m; PML[pi * 2 + 1] = l; }
#pragma unroll
                for (int c = 0; c < 4; ++c)
#pragma unroll
                    for (int g4 = 0; g4 < 4; ++g4) { u32x2 w; w.x = pk_f16(o[c][4 * g4] * inv, o[c][4 * g4 + 1] * inv); w.y = pk_f16(o[c][4 * g4 + 2] * inv, o[c][4 * g4 + 3] * inv);
                        *(u32x2*)(PO + pi * 128 + 32 * c + 8 * g4 + 4 * hh) = w; }
            }
        }
    }
}
__device__ __forceinline__ void phase_moba_own(const P& p, LAS unsigned char* lds) {
    const int tid = otid(), lane = tid & 63, wave = __builtin_amdgcn_readfirstlane(tid >> 6), bid = obid();
    const int r = lane & 31, hh = lane >> 5;
    const f16_t* Qb = (const f16_t*)(p.ws + WS_Q); const f16_t* PO = (const f16_t*)(p.ws + WS_PO); const float* PML = (const float*)(p.ws + WS_PML);
    const unsigned* SEL3 = (const unsigned*)(p.ws + WS_SEL3); f16_t* Ob = (f16_t*)(p.ws + WS_O);
    for (int it = bid; it < 512; it += (int)gridDim.x) {
        const int h = it & 15, j = it >> 4;
        __syncthreads();
        moba_load_kv(p, lds, h, j, tid);
        const int qin = 32 * wave + r, t = 256 * j + qin;
        f16x8 qf[8];
        { const f16_t* qp = Qb + (size_t)t * 2048 + h * 128 + 8 * hh;
#pragma unroll
            for (int st = 0; st < 8; ++st) qf[st] = *(const f16x8*)(qp + 16 * st); }
        __syncthreads();
        float m, l; f32x16 o[4];
        moba_core<true>(qf, lds, lds + 65536, lane, wave + 1, qin, m, l, o);
        const unsigned s3 = SEL3[(size_t)t * 16 + h];
        float ms[3], ls[3]; float M = m;
#pragma unroll
        for (int k = 0; k < 3; ++k) { const bool v = ((s3 >> (8 * k)) & 0xffu) != 0xffu; const size_t pi = ((size_t)t * 16 + h) * 3 + k;
            ms[k] = v ? PML[pi * 2] : -INFINITY; ls[k] = v ? PML[pi * 2 + 1] : 0.f; M = fmaxf(M, ms[k]); }
        const float w0 = l * __expf(m - M); float L = w0;
        const float a0 = __expf(m - M);
#pragma unroll
        for (int c = 0; c < 4; ++c)
#pragma unroll
            for (int i = 0; i < 16; ++i) o[c][i] *= a0;
#pragma unroll
        for (int k = 0; k < 3; ++k) { const float wk = ls[k] * __expf(ms[k] - M); L += wk;
            if (wk != 0.f) { const size_t pi = ((size_t)t * 16 + h) * 3 + k;
#pragma unroll
                for (int c = 0; c < 4; ++c)
#pragma unroll
                    for (int g4 = 0; g4 < 4; ++g4) { const u32x2 w = *(const u32x2*)(PO + pi * 128 + 32 * c + 8 * g4 + 4 * hh);
                        const unsigned wx = w.x, wy = w.y; const f16x2 x0 = __builtin_bit_cast(f16x2, wx), x1 = __builtin_bit_cast(f16x2, wy);
                        o[c][4 * g4] += wk * (float)x0[0]; o[c][4 * g4 + 1] += wk * (float)x0[1]; o[c][4 * g4 + 2] += wk * (float)x1[0]; o[c][4 * g4 + 3] += wk * (float)x1[1]; } } }
        const float inv = 1.0f / L;
#pragma unroll
        for (int c = 0; c < 4; ++c)
#pragma unroll
            for (int g4 = 0; g4 < 4; ++g4) { u32x2 w; w.x = pk_f16(o[c][4 * g4] * inv, o[c][4 * g4 + 1] * inv); w.y = pk_f16(o[c][4 * g4 + 2] * inv, o[c][4 * g4 + 3] * inv);
                *(u32x2*)(Ob + (size_t)t * 2048 + h * 128 + 32 * c + 8 * g4 + 4 * hh) = w; }
    }
}

__device__ __forceinline__ void phase_dsa_qk(const P& p, LAS unsigned char* lds, int la) {
    const int tid = otid(), lane = tid & 63, wave = __builtin_amdgcn_readfirstlane(tid >> 6);
    const int n = lane & 15, kq = lane >> 4;
    LAS unsigned char* Ki = lds + wave * 9216;
    LAS int* sl = (LAS int*)(Ki + 8192);
    LAS int* grab = (LAS int*)(lds + 8 * 9216);
    const f16_t* Qb = (const f16_t*)(p.ws + WS_Q); const f16_t* Kb = (const f16_t*)(p.ws + WS_K);
    const int* SELb = (const int*)(p.ws + WS_SEL); f16_t* PG = (f16_t*)(p.ws + WS_PO);
    unsigned* qhead = (unsigned*)(p.ws + WS_CTL) + CW_DSAQ + la * 512;
    const float scale = 0.08838834764831845f;
    const int xcc = (int)xb_xcc_id();
    unsigned wa[8], ra[2][4];
#pragma unroll
    for (int i2 = 0; i2 < 8; ++i2) wa[i2] = off_b(4 * i2 + kq, n);
#pragma unroll
    for (int rb = 0; rb < 2; ++rb)
#pragma unroll
        for (int s4 = 0; s4 < 4; ++s4) ra[rb][s4] = off_b(n + 16 * rb, 4 * s4 + kq);
    for (int gi = 0; gi < 4; ++gi) {
        const int g = (xcc + gi) & 3;
        const f16_t* Kg = Kb + (size_t)g * S_ * 128;
        for (;;) {
            __syncthreads();
            if (tid == 0) grab[0] = (int)atomicAdd(qhead + g * 64, 32u);
            __syncthreads();
            const int t0 = grab[0];
            if (t0 >= S_) break;
#pragma unroll 1
            for (int ti = 0; ti < 4; ++ti) {
            const int t = t0 + 8 * ti + wave;
            { const u32x4 v = __builtin_nontemporal_load((const u32x4*)(SELb + (size_t)t * NSEL + 4 * lane)); *(LAS u32x4*)(sl + 4 * lane) = v; }
            f16x8 A[4];
            { const f16_t* qp = Qb + (size_t)t * 2048 + (4 * g + (n & 3)) * 128 + 8 * kq;
#pragma unroll
                for (int s4 = 0; s4 < 4; ++s4) { const f16x8 qv = __builtin_nontemporal_load((const f16x8*)(qp + 32 * s4));
#pragma unroll
                    for (int j = 0; j < 8; ++j) A[s4][j] = (n < 4) ? qv[j] : (_Float16)0.f; } }
            asm volatile("s_waitcnt lgkmcnt(0)" ::: "memory");
            f32x4 Sg[16]; f16x8 vr[8];
#define QK_GATHER(st) do { _Pragma("unroll") for (int i2 = 0; i2 < 8; ++i2) { const int key_ = sl[32 * (st) + 4 * i2 + kq]; const unsigned kc_ = key_ < 0 ? 0u : (unsigned)key_; \
                vr[i2] = *(const f16x8*)((const char*)Kg + kc_ * 256u + 16u * (unsigned)n); } } while (0)
            QK_GATHER(0);
#pragma unroll
            for (int st = 0; st < 8; ++st) {
#pragma unroll
                for (int i2 = 0; i2 < 8; ++i2) *(LAS f16x8*)(Ki + wa[i2]) = vr[i2];
                __builtin_amdgcn_sched_barrier(0);
                if (st + 1 < 8) QK_GATHER(st + 1);
                __builtin_amdgcn_sched_barrier(0);
#pragma unroll
                for (int rb = 0; rb < 2; ++rb) { f32x4 c = {0.f, 0.f, 0.f, 0.f};
#pragma unroll
                    for (int s4 = 0; s4 < 4; ++s4) c = __builtin_amdgcn_mfma_f32_16x16x32_f16(A[s4], *(const LAS f16x8*)(Ki + ra[rb][s4]), c, 0, 0, 0);
                    const bool valid = sl[32 * st + 16 * rb + n] >= 0;
#pragma unroll
                    for (int i = 0; i < 4; ++i) Sg[2 * st + rb][i] = (valid && kq == 0) ? c[i] * scale : -INFINITY; }
                asm volatile("s_waitcnt lgkmcnt(0)" ::: "memory");
                __builtin_amdgcn_sched_barrier(0);
            }
#undef QK_GATHER
            float mx[4], lsum[4];
#pragma unroll
            for (int i = 0; i < 4; ++i) { float m = Sg[0][i];
#pragma unroll
                for (int tile = 1; tile < 16; ++tile) m = fmaxf(m, Sg[tile][i]);
                mx[i] = wave_max(m); lsum[i] = 0.f; }
#pragma unroll
            for (int tile = 0; tile < 16; ++tile)
#pragma unroll
                for (int i = 0; i < 4; ++i) { Sg[tile][i] = __expf(Sg[tile][i] - mx[i]); lsum[i] += Sg[tile][i]; }
            float inv[4];
#pragma unroll
            for (int i = 0; i < 4; ++i) inv[i] = 1.0f / wave_sum(lsum[i]);
            { _Float16* pg = (_Float16*)PG + ((size_t)t * 4 + g) * 1024 + kq * 256 + n;
#pragma unroll
                for (int tile = 0; tile < 16; ++tile) { const float p0 = __shfl(Sg[tile][0] * inv[0], n), p1 = __shfl(Sg[tile][1] * inv[1], n), p2 = __shfl(Sg[tile][2] * inv[2], n), p3 = __shfl(Sg[tile][3] * inv[3], n);
                    const float pm = kq == 0 ? p0 : (kq == 1 ? p1 : (kq == 2 ? p2 : p3)); pg[16 * tile] = (_Float16)pm; } }
            asm volatile("s_waitcnt lgkmcnt(0)" ::: "memory");
            }
        }
    }
}
__device__ __forceinline__ void phase_dsa_pv(const P& p, LAS unsigned char* lds, int la) {
    const int tid = otid(), lane = tid & 63, wave = __builtin_amdgcn_readfirstlane(tid >> 6);
    const int n = lane & 15, kq = lane >> 4;
    LAS unsigned char* Vi = lds + wave * 10240;
    LAS int* sl = (LAS int*)(Vi + 8192);
    LAS _Float16* ost = (LAS _Float16*)(Vi + 9216);
    LAS int* grab = (LAS int*)(lds + 8 * 10240);
    const f16_t* Vb = (const f16_t*)(p.ws + WS_V); const int* SELb = (const int*)(p.ws + WS_SEL); const f16_t* PG = (const f16_t*)(p.ws + WS_PO); f16_t* Ob = (f16_t*)(p.ws + WS_O);
    unsigned* qhead = (unsigned*)(p.ws + WS_CTL) + CW_DSAQ + la * 512 + 256;
    const int xcc = (int)xb_xcc_id();
    unsigned wa[8], ta[8][2];
#pragma unroll
    for (int i2 = 0; i2 < 8; ++i2) wa[i2] = off_b(4 * i2 + kq, n);
    { const unsigned q4 = (lane & 15) >> 2, p4 = lane & 3;
#pragma unroll
        for (int c = 0; c < 8; ++c)
#pragma unroll
            for (int t2 = 0; t2 < 2; ++t2) ta[c][t2] = off_b(8 * kq + 4 * t2 + q4, 2 * c + (p4 >> 1)) + 8 * (p4 & 1); }
    for (int gi = 0; gi < 4; ++gi) {
        const int g = (xcc + gi) & 3;
        const f16_t* Vg = Vb + (size_t)g * S_ * 128;
        for (;;) {
            __syncthreads();
            if (tid == 0) grab[0] = (int)atomicAdd(qhead + g * 64, 32u);
            __syncthreads();
            const int t0 = grab[0];
            if (t0 >= S_) break;
#pragma unroll 1
            for (int ti = 0; ti < 4; ++ti) {
            const int t = t0 + 8 * ti + wave;
            { const u32x4 v = __builtin_nontemporal_load((const u32x4*)(SELb + (size_t)t * NSEL + 4 * lane)); *(LAS u32x4*)(sl + 4 * lane) = v; }
            f16x8 A[8];
            { const f16_t* pg = PG + ((size_t)t * 4 + g) * 1024 + (n & 3) * 256 + 8 * kq;
#pragma unroll
                for (int st = 0; st < 8; ++st) { const f16x8 pv = __builtin_nontemporal_load((const f16x8*)(pg + 32 * st));
#pragma unroll
                    for (int j = 0; j < 8; ++j) A[st][j] = (n < 4) ? pv[j] : (_Float16)0.f; } }
            asm volatile("s_waitcnt lgkmcnt(0)" ::: "memory");
            f32x4 acc[8];
#pragma unroll
            for (int c = 0; c < 8; ++c) acc[c] = (f32x4){0.f, 0.f, 0.f, 0.f};
            f16x8 vr[8];
#define PV_GATHER(st) do { _Pragma("unroll") for (int i2 = 0; i2 < 8; ++i2) { const int key_ = sl[32 * (st) + 4 * i2 + kq]; const unsigned kc_ = key_ < 0 ? 0u : (unsigned)key_; \
                vr[i2] = *(const f16x8*)((const char*)Vg + kc_ * 256u + 16u * (unsigned)n); } } while (0)
            PV_GATHER(0);
#pragma unroll 1
            for (int st = 0; st < 8; ++st) {
#pragma unroll
                for (int i2 = 0; i2 < 8; ++i2) *(LAS f16x8*)(Vi + wa[i2]) = vr[i2];
                __builtin_amdgcn_sched_barrier(0);
                if (st + 1 < 8) PV_GATHER(st + 1);
                __builtin_amdgcn_sched_barrier(0);
                const f16x8 a = st == 0 ? A[0] : (st == 1 ? A[1] : (st == 2 ? A[2] : (st == 3 ? A[3] : (st == 4 ? A[4] : (st == 5 ? A[5] : (st == 6 ? A[6] : A[7]))))));
#pragma unroll
                for (int c = 0; c < 8; ++c) { const f16x4 v0 = tr16(Vi + ta[c][0]), v1 = tr16(Vi + ta[c][1]);
                    const f16x8 b = __builtin_shufflevector(v0, v1, 0, 1, 2, 3, 4, 5, 6, 7);
                    acc[c] = __builtin_amdgcn_mfma_f32_16x16x32_f16(a, b, acc[c], 0, 0, 0); }
                asm volatile("s_waitcnt lgkmcnt(0)" ::: "memory");
                __builtin_amdgcn_sched_barrier(0);
            }
#undef PV_GATHER
            if (kq == 0) {
#pragma unroll
                for (int c = 0; c < 8; ++c)
#pragma unroll
                    for (int i = 0; i < 4; ++i) ost[i * 128 + 16 * c + n] = (_Float16)acc[c][i]; }
            asm volatile("s_waitcnt lgkmcnt(0)" ::: "memory");
            { const u32x4 o = *(const LAS u32x4*)((const LAS unsigned char*)ost + 16 * lane);
              __builtin_nontemporal_store(o, (u32x4*)(Ob + (size_t)t * 2048 + (4 * g) * 128 + 8 * lane)); }
            asm volatile("s_waitcnt lgkmcnt(0)" ::: "memory");
            }
        }
    }
}

__device__ __forceinline__ void side_gemm_kiwi(const P& p, LAS unsigned char* lds, int li) {
    const int tid = otid(), lane = tid & 63, wave = __builtin_amdgcn_readfirstlane(tid >> 6), bid = obid();
    const int n = lane & 15, kq = lane >> 4;
    const f16_t* H = (const f16_t*)(p.ws + WS_H); const f16_t* Wt = (const f16_t*)(p.ws + WS_WAIN) + (size_t)li * A_INP * D_ + (size_t)4096 * D_;
    const float* rope = (const float*)(p.ws + WS_ROPE); const float* rcI = rope + S_ * 32; const float* rsI = rope + S_ * 40;
    f16_t* KI = (f16_t*)(p.ws + WS_KI); float* WI = (float*)(p.ws + WS_WI);
    LAS float* part = (LAS float*)lds;
    LAS float* fin = (LAS float*)(lds + 81920);
    for (int rb = bid; rb < S_ / 32; rb += (int)gridDim.x) {
        const int row0 = 32 * rb;
        f32x4 c[2][5];
#pragma unroll
        for (int mt = 0; mt < 2; ++mt)
#pragma unroll
            for (int nt = 0; nt < 5; ++nt) c[mt][nt] = (f32x4){0.f, 0.f, 0.f, 0.f};
#pragma unroll 2
        for (int ks = 8 * wave; ks < 8 * wave + 8; ++ks) {
            f16x8 a[2], b[5];
#pragma unroll
            for (int mt = 0; mt < 2; ++mt) a[mt] = *(const f16x8*)(H + (size_t)(row0 + 16 * mt + n) * D_ + 32 * ks + 8 * kq);
#pragma unroll
            for (int nt = 0; nt < 5; ++nt) b[nt] = *(const f16x8*)(Wt + (size_t)(16 * nt + n) * D_ + 32 * ks + 8 * kq);
#pragma unroll
            for (int mt = 0; mt < 2; ++mt)
#pragma unroll
                for (int nt = 0; nt < 5; ++nt) c[mt][nt] = __builtin_amdgcn_mfma_f32_16x16x32_f16(a[mt], b[nt], c[mt][nt], 0, 0, 0);
        }
        __syncthreads();
#pragma unroll
        for (int mt = 0; mt < 2; ++mt)
#pragma unroll
            for (int nt = 0; nt < 5; ++nt)
#pragma unroll
                for (int i = 0; i < 4; ++i) part[(wave * 32 + 16 * mt + 4 * kq + i) * 80 + 16 * nt + n] = c[mt][nt][i];
        __syncthreads();
        for (int idx = tid; idx < 32 * 80; idx += 512) { float sum = 0.f;
#pragma unroll
            for (int w2 = 0; w2 < 8; ++w2) sum += part[w2 * 2560 + idx];
            fin[idx] = sum; }
        __syncthreads();
        for (int idx = tid; idx < 32 * 80; idx += 512) { const int r = idx / 80, col = idx - 80 * r, t = row0 + r; const float v = fin[idx];
            if (col < 64) { float o = v;
                if (col < 16) { const float pv = fin[r * 80 + (col ^ 8)], cc = rcI[(size_t)t * 8 + (col & 7)], ss = rsI[(size_t)t * 8 + (col & 7)]; o = (col < 8) ? v * cc - pv * ss : v * cc + pv * ss; }
                ((_Float16*)KI)[(size_t)t * 64 + col] = (_Float16)o; }
            else WI[(size_t)t * 16 + (col - 64)] = v * 0.03125f; }
    }
}

__device__ __forceinline__ void phase_dsa_attn3(const P& p, LAS unsigned char* lds, int la) {
    const int tid = otid(), lane = tid & 63, wave = __builtin_amdgcn_readfirstlane(tid >> 6);
    const int n = lane & 15, kq = lane >> 4;
    LAS unsigned char* Im = lds + wave * 16384;
    LAS int* sl = (LAS int*)(Im + 8192);
    LAS _Float16* Pl = (LAS _Float16*)(Im + 9216);
    LAS _Float16* ost = (LAS _Float16*)(Im + 11264);
    LAS int* grab = (LAS int*)(lds + 8 * 16384);
    unsigned* cq = (unsigned*)(p.ws + WS_CTL) + CW_CONVQ + la * 64; const int cstage = 1 + la, ccount = conv_count(cstage); bool cmore = (MK_CONV_HOST == 0);
    const f16_t* Qb = (const f16_t*)(p.ws + WS_Q); const f16_t* Kb = (const f16_t*)(p.ws + WS_K); const f16_t* Vb = (const f16_t*)(p.ws + WS_V);
    const int* SELb = (const int*)(p.ws + WS_SEL); f16_t* Ob = (f16_t*)(p.ws + WS_O);
    unsigned* qhead = (unsigned*)(p.ws + WS_CTL) + CW_DSAQ + la * 512;
    const float scale = 0.08838834764831845f;
    const int xcc = (int)xb_xcc_id();
    unsigned wa[8], ra[2][4], ta[8][2];
#pragma unroll
    for (int i2 = 0; i2 < 8; ++i2) wa[i2] = off_b(4 * i2 + kq, n);
#pragma unroll
    for (int rb = 0; rb < 2; ++rb)
#pragma unroll
        for (int s4 = 0; s4 < 4; ++s4) ra[rb][s4] = off_b(n + 16 * rb, 4 * s4 + kq);
    { const unsigned q4 = (lane & 15) >> 2, p4 = lane & 3;
#pragma unroll
        for (int c = 0; c < 8; ++c)
#pragma unroll
            for (int t2 = 0; t2 < 2; ++t2) ta[c][t2] = off_b(8 * kq + 4 * t2 + q4, 2 * c + (p4 >> 1)) + 8 * (p4 & 1); }
    for (int gi = 0; gi < 4; ++gi) {
        const int g = (xcc + gi) & 3;
        const f16_t* Kg = Kb + (size_t)g * S_ * 128; const f16_t* Vg = Vb + (size_t)g * S_ * 128;
        __syncthreads();
        if (tid == 0) grab[0] = (int)atomicAdd(qhead + g * 64, (unsigned)(8 * AT_NI));
        __syncthreads();
        int t0 = grab[0];
        while (t0 < S_) {
            int nxt = 0; if (tid == 0) nxt = (int)atomicAdd(qhead + g * 64, (unsigned)(8 * AT_NI));
#pragma unroll 1
            for (int ti = 0; ti < AT_NI; ++ti) {
            const int t = t0 + 8 * ti + wave;
            { const u32x4 v = __builtin_nontemporal_load((const u32x4*)(SELb + (size_t)t * NSEL + 4 * lane)); *(LAS u32x4*)(sl + 4 * lane) = v; }
            f16x8 A[4];
            { const f16_t* qp = Qb + (size_t)t * 2048 + (4 * g + (n & 3)) * 128 + 8 * kq;
#pragma unroll
                for (int s4 = 0; s4 < 4; ++s4) { const f16x8 qv = __builtin_nontemporal_load((const f16x8*)(qp + 32 * s4));
#pragma unroll
                    for (int j = 0; j < 8; ++j) A[s4][j] = (n < 4) ? qv[j] : (_Float16)0.f; } }
            asm volatile("s_waitcnt lgkmcnt(0)" ::: "memory");
            f16x8 vr[8];
#define AT_GATHER(base, st) do { _Pragma("unroll") for (int i2 = 0; i2 < 8; ++i2) { const int key_ = sl[32 * (st) + 4 * i2 + kq]; const unsigned kc_ = key_ < 0 ? 0u : (unsigned)key_; \
                vr[i2] = *(const f16x8*)((const char*)(base) + kc_ * 256u + 16u * (unsigned)n); } } while (0)
            f32x4 Sg[16];
            AT_GATHER(Kg, 0);
#pragma unroll
            for (int st = 0; st < 8; ++st) {
#pragma unroll
                for (int i2 = 0; i2 < 8; ++i2) *(LAS f16x8*)(Im + wa[i2]) = vr[i2];
                __builtin_amdgcn_sched_barrier(0);
                if (st + 1 < 8) AT_GATHER(Kg, st + 1); else AT_GATHER(Vg, 0);
                __builtin_amdgcn_sched_barrier(0);
#pragma unroll
                for (int rb = 0; rb < 2; ++rb) { f32x4 c = {0.f, 0.f, 0.f, 0.f};
#pragma unroll
                    for (int s4 = 0; s4 < 4; ++s4) c = __builtin_amdgcn_mfma_f32_16x16x32_f16(A[s4], *(const LAS f16x8*)(Im + ra[rb][s4]), c, 0, 0, 0);
                    const bool valid = sl[32 * st + 16 * rb + n] >= 0;
#pragma unroll
                    for (int i = 0; i < 4; ++i) Sg[2 * st + rb][i] = (valid && kq == 0) ? c[i] * scale : -INFINITY; }
                asm volatile("s_waitcnt lgkmcnt(0)" ::: "memory");
                __builtin_amdgcn_sched_barrier(0);
            }
            float mx[4], lsum[4];
#pragma unroll
            for (int i = 0; i < 4; ++i) { float m = Sg[0][i];
#pragma unroll
                for (int tile = 1; tile < 16; ++tile) m = fmaxf(m, Sg[tile][i]);
                mx[i] = wave_max(m); lsum[i] = 0.f; }
#pragma unroll
            for (int tile = 0; tile < 16; ++tile)
#pragma unroll
                for (int i = 0; i < 4; ++i) { Sg[tile][i] = __expf(Sg[tile][i] - mx[i]); lsum[i] += Sg[tile][i]; }
            float inv[4];
#pragma unroll
            for (int i = 0; i < 4; ++i) inv[i] = 1.0f / wave_sum(lsum[i]);
            if (kq == 0) {
#pragma unroll
                for (int tile = 0; tile < 16; ++tile)
#pragma unroll
                    for (int i = 0; i < 4; ++i) Pl[i * 256 + 16 * tile + n] = (_Float16)(Sg[tile][i] * inv[i]); }
            asm volatile("s_waitcnt lgkmcnt(0)" ::: "memory");
            f32x4 acc[8];
#pragma unroll
            for (int c = 0; c < 8; ++c) acc[c] = (f32x4){0.f, 0.f, 0.f, 0.f};
#pragma unroll 1
            for (int st = 0; st < 8; ++st) {
#pragma unroll
                for (int i2 = 0; i2 < 8; ++i2) *(LAS f16x8*)(Im + wa[i2]) = vr[i2];
                __builtin_amdgcn_sched_barrier(0);
                if (st + 1 < 8) AT_GATHER(Vg, st + 1);
                __builtin_amdgcn_sched_barrier(0);
                f16x8 a = *(const LAS f16x8*)(Pl + (n & 3) * 256 + 32 * st + 8 * kq);
#pragma unroll
                for (int j = 0; j < 8; ++j) a[j] = (n < 4) ? a[j] : (_Float16)0.f;
#pragma unroll
                for (int c = 0; c < 8; ++c) { const f16x4 v0 = tr16(Im + ta[c][0]), v1 = tr16(Im + ta[c][1]);
                    const f16x8 b = __builtin_shufflevector(v0, v1, 0, 1, 2, 3, 4, 5, 6, 7);
                    acc[c] = __builtin_amdgcn_mfma_f32_16x16x32_f16(a, b, acc[c], 0, 0, 0); }
                asm volatile("s_waitcnt lgkmcnt(0)" ::: "memory");
                __builtin_amdgcn_sched_barrier(0);
            }
#undef AT_GATHER
            if (kq == 0) {
#pragma unroll
                for (int c = 0; c < 8; ++c)
#pragma unroll
                    for (int i = 0; i < 4; ++i) ost[i * 128 + 16 * c + n] = (_Float16)acc[c][i]; }
            asm volatile("s_waitcnt lgkmcnt(0)" ::: "memory");
            { const u32x4 o = *(const LAS u32x4*)((const LAS unsigned char*)ost + 16 * lane);
              __builtin_nontemporal_store(o, (u32x4*)(Ob + (size_t)t * 2048 + (4 * g) * 128 + 8 * lane)); }
            asm volatile("s_waitcnt lgkmcnt(0)" ::: "memory");
            if (cmore) { int j = 0; if (lane == 0) j = (int)atomicAdd(cq, 1u); j = __builtin_amdgcn_readfirstlane(j);
                if (j < ccount) conv_item<true>(p, (LAS float*)Im, conv_map(cstage, j), lane); else cmore = false; }
            }
            __syncthreads(); if (tid == 0) grab[0] = nxt; __syncthreads(); t0 = grab[0];
        }
    }
    while (cmore) { int j = 0; if (lane == 0) j = (int)atomicAdd(cq, 1u); j = __builtin_amdgcn_readfirstlane(j);
        if (j < ccount) conv_item<true>(p, (LAS float*)Im, conv_map(cstage, j), lane); else cmore = false; }
}

#ifndef MK_DUP
#define MK_DUP 0
#endif
#ifndef MK_SPLIT
#define MK_SPLIT 0
#endif
struct Args { P p; int ph_lo, ph_hi; };
__global__ void __launch_bounds__(512, 2) fwd(Args a) {
    extern __shared__ __attribute__((aligned(16))) unsigned char lds_raw[];
    LAS unsigned char* lds = (LAS unsigned char*)lds_raw;
    const P& p = a.p;
    volatile LAS unsigned* MISC = (volatile LAS unsigned*)(lds + LDS_MISC);
    for (int u = threadIdx.x; u < (LDS_BYTES - LDS_MISC) / 4; u += 512) MISC[u] = 0u;
    __syncthreads();
    unsigned* barw = (unsigned*)(p.ws + WS_CTL) + 4096;
    XcdBarrier bar; bar.bar = barw; bar.x = 0; bar.st = nullptr;
    if (!MK_SPLIT) bar = xcd_barrier_post(barw, MISC + 8);
    int ph = 0;
#define RUN(...) do { if (a.ph_lo <= ph && ph < a.ph_hi) { __VA_ARGS__; if (!MK_SPLIT && ph + 1 < a.ph_hi) xcd_barrier(bar); } ++ph; } while (0)
    const float* rope = (const float*)(p.ws + WS_ROPE);
    unsigned char* ws = p.ws;
    RUN({ phase_prologue(p, lds); if (MK_DUP & 32) { __syncthreads(); phase_prologue(p, lds); } });
    RUN(phase_mod_reduce(p));
    RUN({ phase_norm(p, 0, 0); if (MK_DUP & 64) { __syncthreads(); phase_norm(p, 0, 0); } });
    for (int l = 0; l < 4; ++l) {
        const int li = l >> 1;
        if ((l & 1) == 0) {
            RUN({ pg8::Gemm g{(const f16_t*)(ws + WS_H), (const f16_t*)(ws + WS_WAIN) + (size_t)li * A_INP * D_, S_, 4096, D_, 0};
                  pg8::EpiIn<0> E{(f16_t*)(ws + WS_Q), (f16_t*)(ws + WS_K), (f16_t*)(ws + WS_V), (f16_t*)(ws + WS_QI), (f16_t*)(ws + WS_KI), (float*)(ws + WS_WI), nullptr, rope, rope + S_ * 16, rope + S_ * 32, rope + S_ * 40};
                  pg8::StaticOrder S; S.init(S_, 4096, (int)gridDim.x, obid());
                  pg8::gemm_phase<pg8::EpiIn<0>, pg8::StaticOrder, true>(lds, g, S, E);
                  side_gemm_kiwi(p, lds, li); });
            RUN({ if (MK_DUP & 128) { phase_idx_topk<1>(p, lds, -1); __syncthreads(); } if (MK_DUP & 256) { phase_idx_topk<2>(p, lds, -1); __syncthreads(); } phase_idx_topk<3>(p, lds, MK_CONV_HOST == 1 ? 1 + li : -1); if (MK_DUP & 1) { __syncthreads(); phase_idx_topk<3>(p, lds, -1); } });
            RUN(phase_dsa_attn3(p, lds, li));
            RUN({ pg8::Gemm g{(const f16_t*)(ws + WS_O), (const f16_t*)(ws + WS_WAO) + (size_t)li * D_ * D_, S_, D_, D_, 0};
                  pg8::EpiF16 E{(f16_t*)(ws + WS_Y), D_, 0};
                  pg8::StaticOrder S; S.init(S_, D_, (int)gridDim.x, obid());
                  pg8::gemm_phase<pg8::EpiF16, pg8::StaticOrder, false>(lds, g, S, E); });
        } else {
            RUN({ pg8::Gemm g{(const f16_t*)(ws + WS_H), (const f16_t*)(ws + WS_WBIN) + (size_t)li * B_IN * D_, S_, B_IN, D_, 0};
                  pg8::EpiIn<1> E{(f16_t*)(ws + WS_Q), (f16_t*)(ws + WS_K), (f16_t*)(ws + WS_V), nullptr, nullptr, nullptr, (float*)(ws + WS_KSUM) + (size_t)li * 65536, rope, rope + S_ * 16, rope + S_ * 32, rope + S_ * 40};
                  pg8::StaticOrder S; S.init(S_, B_IN, (int)gridDim.x, obid());
                  pg8::gemm_phase<pg8::EpiIn<1>, pg8::StaticOrder, true>(lds, g, S, E); });
            RUN(phase_moba_gate(p, li));
            RUN({ phase_moba_past(p, lds, li); if (MK_DUP & 8) { __syncthreads(); phase_moba_past(p, lds, li); } });
            RUN({ phase_moba_own(p, lds); if (MK_DUP & 16) { __syncthreads(); phase_moba_own(p, lds); } });
            RUN({ pg8::Gemm g{(const f16_t*)(ws + WS_O), (const f16_t*)(ws + WS_WBO) + (size_t)li * D_ * D_, S_, D_, D_, 0};
                  pg8::EpiF16 E{(f16_t*)(ws + WS_Y), D_, 0};
                  pg8::StaticOrder S; S.init(S_, D_, (int)gridDim.x, obid());
                  pg8::gemm_phase<pg8::EpiF16, pg8::StaticOrder, false>(lds, g, S, E); });
        }
        RUN(phase_norm(p, 1, l));
        RUN({ pg8::Gemm g{(const f16_t*)(ws + WS_H), (const f16_t*)(ws + WS_WF1) + (size_t)l * 2 * DFF * D_, S_, 2 * DFF, D_, 0};
              pg8::EpiSwiglu E{(f16_t*)(ws + WS_ACT), DFF, 0};
              pg8::SplitTailOrder S; S.init(S_, 2 * DFF, (int)gridDim.x, obid(), (float*)(ws + WS_PB), (unsigned*)(ws + WS_CTL) + CW_SPLIT + l * 128);
              pg8::gemm_phase<pg8::EpiSwiglu, pg8::SplitTailOrder, true>(lds, g, S, E); });
        RUN({ pg8::Gemm g{(const f16_t*)(ws + WS_ACT), (const f16_t*)(ws + WS_WF2) + (size_t)l * D_ * DFF, S_, D_, DFF, 0};
              pg8::EpiF16 E{(f16_t*)(ws + WS_Y), D_, 0};
              pg8::StaticOrder S; S.init(S_, D_, (int)gridDim.x, obid());
              pg8::gemm_phase<pg8::EpiF16, pg8::StaticOrder, false>(lds, g, S, E);
              if (MK_DUP & 2048) { __syncthreads(); pg8::gemm_phase<pg8::EpiF16, pg8::StaticOrder, false>(lds, g, S, E); } });
        RUN(phase_norm(p, 2, l));
    }
#undef RUN
}
constexpr int N_PHASES = 3 + 2 * 8 + 2 * 9;

extern "C" void kernel_launch(void* const* d_in, const int* in_sizes, int n_in, void* d_out, int out_size, void* d_ws, size_t ws_size, hipStream_t stream) {
    if (n_in != 12 || ws_size < WS_END) { fprintf(stderr, "kernel_launch: unexpected inputs (n_in %d, ws %zu < %zu)\n", n_in, ws_size, (size_t)WS_END); return; }
    static int grid = 0;
    if (!grid) { int dev = 0, cus = 0, per_cu = 0; (void)hipGetDevice(&dev); (void)hipDeviceGetAttribute(&cus, hipDeviceAttributeMultiprocessorCount, dev);
        if (hipFuncSetAttribute((const void*)fwd, hipFuncAttributeMaxDynamicSharedMemorySize, LDS_BYTES) != hipSuccess) { fprintf(stderr, "kernel_launch: hipFuncSetAttribute failed\n"); grid = -1; return; }
        if (hipOccupancyMaxActiveBlocksPerMultiprocessor(&per_cu, (const void*)fwd, 512, LDS_BYTES) != hipSuccess || per_cu < 1) fprintf(stderr, "kernel_launch: note: occupancy query reports %d workgroups per CU\n", per_cu);
        (void)hipGetLastError();
        grid = cus > 0 ? cus : 256; }
    if (grid < 0) return;
    (void)hipMemsetAsync((char*)d_ws + WS_CTL, 0, 1 * MiB, stream);
    Args a{}; a.p.x = (const float*)d_in[0]; a.p.c = (const float*)d_in[1]; a.p.pos = (const int*)d_in[2]; a.p.a_w_in = (const float*)d_in[3]; a.p.a_w_o = (const float*)d_in[4];
    a.p.b_w_in = (const float*)d_in[5]; a.p.b_w_o = (const float*)d_in[6]; a.p.ada_w = (const float*)d_in[7]; a.p.ada_b = (const float*)d_in[8]; a.p.norm_g = (const float*)d_in[9];
    a.p.ffn_w_in = (const float*)d_in[10]; a.p.ffn_w_out = (const float*)d_in[11]; a.p.out = (float*)d_out; a.p.ws = (unsigned char*)d_ws;
    if (MK_SPLIT) { for (int ph = 0; ph < N_PHASES; ++ph) { a.ph_lo = ph; a.ph_hi = ph + 1; hipLaunchKernelGGL(fwd, dim3(grid), dim3(512), LDS_BYTES, stream, a); } }
    else { a.ph_lo = 0; a.ph_hi = N_PHASES; hipLaunchKernelGGL(fwd, dim3(grid), dim3(512), LDS_BYTES, stream, a); }
}
```

```cpp
#include <hip/hip_runtime.h>
#include <cstdio>
#include <cstdint>

#define LAS __attribute__((address_space(3)))
typedef unsigned short f16_t;
typedef _Float16 f16x8 __attribute__((ext_vector_type(8)));
typedef _Float16 f16x4 __attribute__((ext_vector_type(4)));
typedef _Float16 f16x2 __attribute__((ext_vector_type(2)));
typedef float f32x2 __attribute__((ext_vector_type(2)));
typedef float f32x4 __attribute__((ext_vector_type(4)));
typedef unsigned u32x4 __attribute__((ext_vector_type(4)));
typedef unsigned u32x2 __attribute__((ext_vector_type(2)));

constexpr int S_ = 8192, D_ = 2048, NH = 16, HD = 128, DFF = 5632;
constexpr int A_IN = 4176, A_INP = 4352, B_IN = 6144;
constexpr int NSEL = 256;
constexpr float EPS = 1e-6f;

__device__ __forceinline__ unsigned pk_f16(float lo, float hi) { f16x2 r = __builtin_convertvector((f32x2){lo, hi}, f16x2); return __builtin_bit_cast(unsigned, r); }
__device__ __forceinline__ float h2f(f16_t v) { return (float)__builtin_bit_cast(_Float16, v); }
__device__ __forceinline__ float wave_sum(float v) {
#pragma unroll
    for (int o = 1; o < 64; o <<= 1) v += __shfl_xor(v, o);
    return v;
}
__device__ __forceinline__ float wave_max(float v) {
#pragma unroll
    for (int o = 1; o < 64; o <<= 1) v = fmaxf(v, __shfl_xor(v, o));
    return v;
}

__device__ __forceinline__ int otid() { int t = (int)threadIdx.x; asm volatile("" : "+v"(t)); return t; }
__device__ __forceinline__ int obid() { int b = (int)blockIdx.x; asm volatile("" : "+s"(b)); return b; }

#ifndef MK_CONV_HOST
#define MK_CONV_HOST 1
#endif
namespace pg8 {
constexpr int BM = 256, BK = 64, HALF = 128, HTB = HALF * BK * 2, STAGE_BYTES = 8 * HTB, NXCD = 8, WGM = 8;
__host__ __device__ __forceinline__ int lds_byte(int r, int c) { const int st = (r >> 4) * 2 + (c >> 5), rr = r & 15, cc = c & 31, ob = rr * 64 + cc * 2; return st * 1024 + (ob ^ (((ob >> 9) & 1) << 5)); }
__host__ __device__ __forceinline__ void stage_rc(int b, int& R, int& C) { const int st = b / 1024, sb = b % 1024, swz = sb ^ (((sb >> 9) & 1) << 5); R = (st >> 1) * 16 + swz / 64; C = (st & 1) * 32 + (swz % 64) / 2; }
__host__ __device__ __forceinline__ int perm32(int rho) { const int n = rho >> 4, i = rho & 15; return 8 * (i >> 2) + 4 * n + (i & 3); }
struct Unit { int pm, pn, ks; };
struct Gemm { const f16_t* A; const f16_t* Bt; int M, N, K, pad; };
struct StaticOrder {
    int nM, nN, nwg, G, c;
    __host__ __device__ void init(int M, int N, int G_, int c_) { nM = M / BM; nN = N / BM; nwg = nM * nN; G = G_; c = c_; }
    static constexpr bool SPLIT = false;
    __host__ __device__ bool next(int i, Unit& u) const { return map((long)i * G + c, u); }
    __host__ __device__ bool map(long L, Unit& u) const {
        u.ks = -1; if (L >= nwg) return false;
        int wgid = (int)L; { const int q = nwg / NXCD, r = nwg % NXCD, xcd = wgid % NXCD, off = wgid / NXCD; wgid = (xcd < r ? xcd * (q + 1) : r * (q + 1) + (xcd - r) * q) + off; }
        const int nig = WGM * nN, gid = wgid / nig, fm = gid * WGM, gsz = (nM - fm) < WGM ? (nM - fm) : WGM;
        u.pm = fm + ((wgid % nig) % gsz); u.pn = (wgid % nig) / gsz; return true;
    }
    __device__ __forceinline__ void a_ready(const Unit&) const {}
    __device__ __forceinline__ void done(const Unit&) const {}
};

struct SplitTailOrder {
    static constexpr bool SPLIT = true;
    StaticOrder s; int nfull, en; float* pb; unsigned* fl;
    __device__ void init(int M, int N, int G_, int c_, float* pb_, unsigned* fl_) { s.init(M, N, G_, c_); nfull = s.nwg / G_; const int tail = s.nwg - nfull * G_; en = ((G_ & 1) == 0 && tail > 0 && tail <= G_ / 2) ? 1 : 0; pb = pb_; fl = fl_; }
    __device__ bool next(int i, Unit& u) const {
        if (!en || i < nfull) return s.next(i, u);
        if (i > nfull) return false;
        const int half = s.G / 2, j = s.c % half;
        if (!s.map((long)nfull * s.G + j, u)) return false;
        u.ks = s.c / half; return true;
    }
    __device__ int slot() const { return s.c % (s.G / 2); }
    __device__ __forceinline__ void a_ready(const Unit&) const {}
    __device__ __forceinline__ void done(const Unit&) const {}
};

struct EpiF32 {
    static constexpr bool PERM = false, AFTER_DRAIN = false;
    float* C; int ldc, pad;
    __device__ __forceinline__ void operator()(const f32x4 (&acc)[2][2][4][2], const Unit& u, int wr, int wc, int fr, int fq) const {
        const int row0 = u.pm * BM + wr * 64 + fr, col0 = u.pn * BM + wc * 32 + 4 * fq;
#pragma unroll
        for (int ai = 0; ai < 2; ++ai)
#pragma unroll
            for (int m = 0; m < 4; ++m) { float* rowp = C + (size_t)(row0 + ai * HALF + m * 16) * ldc + col0;
#pragma unroll
                for (int bj = 0; bj < 2; ++bj)
#pragma unroll
                    for (int n = 0; n < 2; ++n) *(f32x4*)(rowp + bj * HALF + n * 16) = acc[ai][bj][m][n]; }
    }
};
struct EpiF16 {
    static constexpr bool PERM = true, AFTER_DRAIN = false;
    f16_t* C; int ldc, pad;
    __device__ __forceinline__ void operator()(const f32x4 (&acc)[2][2][4][2], const Unit& u, int wr, int wc, int fr, int fq) const {
        const int row0 = u.pm * BM + wr * 64 + fr, col0 = u.pn * BM + wc * 32 + 8 * fq;
#pragma unroll
        for (int ai = 0; ai < 2; ++ai)
#pragma unroll
            for (int m = 0; m < 4; ++m) { f16_t* rowp = C + (size_t)(row0 + ai * HALF + m * 16) * ldc + col0;
#pragma unroll
                for (int bj = 0; bj < 2; ++bj) { const f32x4 v0 = acc[ai][bj][m][0], v1 = acc[ai][bj][m][1];
                    u32x4 w; w.x = pk_f16(v0[0], v0[1]); w.y = pk_f16(v0[2], v0[3]); w.z = pk_f16(v1[0], v1[1]); w.w = pk_f16(v1[2], v1[3]);
                    *(u32x4*)(rowp + bj * HALF) = w; } }
    }
};
struct EpiSwiglu {
    static constexpr bool PERM = true, AFTER_DRAIN = false;
    f16_t* O; int ldc, pad;
    __device__ __forceinline__ void operator()(const f32x4 (&acc)[2][2][4][2], const Unit& u, int wr, int wc, int fr, int fq) const {
        const int row0 = u.pm * BM + wr * 64 + fr, col0 = u.pn * HALF + wc * 32 + 8 * fq;
#pragma unroll
        for (int ai = 0; ai < 2; ++ai)
#pragma unroll
            for (int m = 0; m < 4; ++m) { f16_t* rowp = O + (size_t)(row0 + ai * HALF + m * 16) * ldc + col0;
                float o[8];
#pragma unroll
                for (int n = 0; n < 2; ++n)
#pragma unroll
                    for (int j = 0; j < 4; ++j) { const float uu = acc[ai][0][m][n][j], g = acc[ai][1][m][n][j]; o[4 * n + j] = uu * g * __builtin_amdgcn_rcpf(1.0f + __expf(-g)); }
                u32x4 w; w.x = pk_f16(o[0], o[1]); w.y = pk_f16(o[2], o[3]); w.z = pk_f16(o[4], o[5]); w.w = pk_f16(o[6], o[7]);
                *(u32x4*)rowp = w; }
    }
};
__device__ __forceinline__ void rope8(f32x4& v0, f32x4& v1, const f32x4 c0, const f32x4 c1, const f32x4 s0, const f32x4 s1, float sgn, int xm, bool apply) {
#pragma unroll
    for (int j = 0; j < 4; ++j) {
        const float o0 = __shfl_xor(v0[j], xm), o1 = __shfl_xor(v1[j], xm);
        if (apply) { v0[j] = v0[j] * c0[j] + sgn * o0 * s0[j]; v1[j] = v1[j] * c1[j] + sgn * o1 * s1[j]; }
    }
}
template <int MODE> struct EpiIn {
    static constexpr bool PERM = true, AFTER_DRAIN = false;
    f16_t *Q, *K, *V, *QI, *KI; float* WI; float* KS;
    const float *rcA, *rsA, *rcI, *rsI;
    __device__ __forceinline__ void operator()(const f32x4 (&acc)[2][2][4][2], const Unit& u, int wr, int wc, int fr, int fq) const {
        const int row0 = u.pm * BM + wr * 64 + fr; const int pn = u.pn;
        constexpr int NQ = 8, NK = (MODE == 0) ? 2 : 8, NV = (MODE == 0) ? 2 : 8;
        if (pn < NQ + NK + NV) {
            f16_t* base; int ldc, colt; bool rope;
            if (pn < NQ) { base = Q; ldc = 2048; colt = pn * BM; rope = true; }
            else if (pn < NQ + NK) { base = K; ldc = NK * BM; colt = (pn - NQ) * BM; rope = true; }
            else { base = V; ldc = NV * BM; colt = (pn - NQ - NK) * BM; rope = false; }
            size_t hstride = HALF;
            if (MODE == 0 && pn >= NQ) { base += (size_t)(colt >> 7) * S_ * 128; colt = 0; ldc = 128; hstride = (size_t)S_ * 128; }
            const int col0 = colt + wc * 32 + 8 * fq; const bool dorope = rope && (wc == 0);
            const float sgn = (fq < 2) ? -1.f : 1.f;
            const bool ksum = (MODE == 1) && pn >= NQ && pn < NQ + NK;
            float cs[2][8];
#pragma unroll
            for (int bj = 0; bj < 2; ++bj)
#pragma unroll
                for (int e = 0; e < 8; ++e) cs[bj][e] = 0.f;
#pragma unroll
            for (int ai = 0; ai < 2; ++ai)
#pragma unroll
                for (int m = 0; m < 4; ++m) { const int row = row0 + ai * HALF + m * 16; f16_t* rowp = base + (size_t)row * ldc + col0;
                    f32x4 c0, c1, s0, s1;
                    if (dorope) { const float* cp = rcA + (size_t)row * 16 + 8 * (fq & 1); const float* sp = rsA + (size_t)row * 16 + 8 * (fq & 1);
                        c0 = *(const f32x4*)cp; c1 = *(const f32x4*)(cp + 4); s0 = *(const f32x4*)sp; s1 = *(const f32x4*)(sp + 4); }
#pragma unroll
                    for (int bj = 0; bj < 2; ++bj) { f32x4 v0 = acc[ai][bj][m][0], v1 = acc[ai][bj][m][1];
                        if (dorope) rope8(v0, v1, c0, c1, s0, s1, sgn, 32, true);
                        if (ksum) {
#pragma unroll
                            for (int e = 0; e < 4; ++e) { cs[bj][e] += v0[e]; cs[bj][4 + e] += v1[e]; } }
                        u32x4 w; w.x = pk_f16(v0[0], v0[1]); w.y = pk_f16(v0[2], v0[3]); w.z = pk_f16(v1[0], v1[1]); w.w = pk_f16(v1[2], v1[3]);
                        *(u32x4*)(rowp + bj * hstride) = w; } }
            if (ksum) {
#pragma unroll
                for (int bj = 0; bj < 2; ++bj)
#pragma unroll
                    for (int e = 0; e < 8; ++e) { float v = cs[bj][e]; v += __shfl_xor(v, 1); v += __shfl_xor(v, 2); v += __shfl_xor(v, 4); v += __shfl_xor(v, 8);
                        if (fr == 0) atomicAdd(KS + ((size_t)(2 * (pn - NQ) + bj) * 32 + u.pm) * 128 + wc * 32 + 8 * fq + e, v); } }
        } else if (MODE == 0 && pn < 16) {
            const int col0 = (pn - 12) * BM + wc * 32 + 8 * fq; const bool ropew = ((wc & 1) == 0); const bool app = fq < 2; const float sgn = (fq == 0) ? -1.f : 1.f;
#pragma unroll
            for (int ai = 0; ai < 2; ++ai)
#pragma unroll
                for (int m = 0; m < 4; ++m) { const int row = row0 + ai * HALF + m * 16; f16_t* rowp = QI + (size_t)row * 1024 + col0;
                    f32x4 c0, c1, s0, s1;
                    if (ropew) { const float* cp = rcI + (size_t)row * 8; const float* sp = rsI + (size_t)row * 8; c0 = *(const f32x4*)cp; c1 = *(const f32x4*)(cp + 4); s0 = *(const f32x4*)sp; s1 = *(const f32x4*)(sp + 4); }
#pragma unroll
                    for (int bj = 0; bj < 2; ++bj) { f32x4 v0 = acc[ai][bj][m][0], v1 = acc[ai][bj][m][1];
                        if (ropew) rope8(v0, v1, c0, c1, s0, s1, sgn, 16, app);
                        u32x4 w; w.x = pk_f16(v0[0], v0[1]); w.y = pk_f16(v0[2], v0[3]); w.z = pk_f16(v1[0], v1[1]); w.w = pk_f16(v1[2], v1[3]);
                        *(u32x4*)(rowp + bj * HALF) = w; } }
        } else if (MODE == 0) {
            const bool ropew = (wc == 0); const bool app = fq < 2; const float sgn = (fq == 0) ? -1.f : 1.f;
#pragma unroll
            for (int ai = 0; ai < 2; ++ai)
#pragma unroll
                for (int m = 0; m < 4; ++m) { const int row = row0 + ai * HALF + m * 16;
                    f32x4 v0 = acc[ai][0][m][0], v1 = acc[ai][0][m][1];
                    if (ropew) { const float* cp = rcI + (size_t)row * 8; const float* sp = rsI + (size_t)row * 8;
                        const f32x4 c0 = *(const f32x4*)cp, c1 = *(const f32x4*)(cp + 4), s0 = *(const f32x4*)sp, s1 = *(const f32x4*)(sp + 4);
                        rope8(v0, v1, c0, c1, s0, s1, sgn, 16, app); }
                    if (wc < 2) { u32x4 w; w.x = pk_f16(v0[0], v0[1]); w.y = pk_f16(v0[2], v0[3]); w.z = pk_f16(v1[0], v1[1]); w.w = pk_f16(v1[2], v1[3]);
                        *(u32x4*)(KI + (size_t)row * 64 + wc * 32 + 8 * fq) = w; }
                    else if (wc == 2 && fq < 2) { float* wp = WI + (size_t)row * 16 + 8 * fq; *(f32x4*)wp = v0 * 0.03125f; *(f32x4*)(wp + 4) = v1 * 0.03125f; } }
        }
    }
};

template <class Epi, class Sched, bool ALIGN_EPI>
__device__ __forceinline__ void gemm_phase(LAS unsigned char* lds, const Gemm g, const Sched& S, const Epi& E) {
    const int tid = otid(), wid = __builtin_amdgcn_readfirstlane(tid >> 6), lane = tid & 63, wr = wid >> 2, wc = wid & 3, fr = lane & 15, fq = lane >> 4;
    const int K = g.K, nt = K / BK;
    unsigned voffA[2], voffB[2];
#pragma unroll
    for (int i = 0; i < 2; ++i) { int R, C; stage_rc(tid * 16 + i * 8192, R, C); const int Rb = Epi::PERM ? ((R & ~31) + perm32(R & 31)) : R;
        voffA[i] = (unsigned)(R * K + C) * 2u; voffB[i] = (unsigned)(Rb * K + C) * 2u; }
    const size_t kstep = (size_t)(BK * 2);
    const size_t hstep = (size_t)HALF * K * 2;
    const size_t tstep = 2 * hstep;
    const unsigned ldsw = (unsigned)wid * 1024u;
    const int aoff = lds_byte(wr * 64 + fr, fq * 8), boff = lds_byte(wc * 32 + fr, fq * 8);
#define PG8_SA(b, h) (((b) * 2 + (h)) * HTB)
#define PG8_SB(b, h) ((4 + (b) * 2 + (h)) * HTB)
#define PG8_STAGE(bufoff, gbase, voff) do { _Pragma("unroll") for (int _i = 0; _i < 2; ++_i) \
        __builtin_amdgcn_global_load_lds((const unsigned*)((const char*)(gbase) + (voff)[_i]), (LAS unsigned*)(lds + (bufoff) + ldsw + _i * 8192), 16, 0, 0); } while (0)
#define PG8_LDA(dst, b, h) do { _Pragma("unroll") for (int m = 0; m < 4; ++m) _Pragma("unroll") for (int k = 0; k < 2; ++k) dst[m][k] = *(const LAS f16x8*)(lds + PG8_SA(b, h) + aoff + m * 2048 + k * 1024); } while (0)
#define PG8_LDB(dst, b, h) do { _Pragma("unroll") for (int n = 0; n < 2; ++n) _Pragma("unroll") for (int k = 0; k < 2; ++k) dst[n][k] = *(const LAS f16x8*)(lds + PG8_SB(b, h) + boff + n * 2048 + k * 1024); } while (0)
#define PG8_MMA(ai, bj, At, Bt) do { __builtin_amdgcn_s_setprio(1); _Pragma("unroll") for (int m = 0; m < 4; ++m) _Pragma("unroll") for (int n = 0; n < 2; ++n) _Pragma("unroll") for (int k = 0; k < 2; ++k) \
        acc[ai][bj][m][n] = __builtin_amdgcn_mfma_f32_16x16x32_f16(Bt[n][k], At[m][k], acc[ai][bj][m][n], 0, 0, 0); __builtin_amdgcn_s_setprio(0); } while (0)
#define PG8_WAIT_V(n) asm volatile("s_waitcnt vmcnt(" #n ")" ::: "memory")
#define PG8_WAIT_L(n) asm volatile("s_waitcnt lgkmcnt(" #n ")" ::: "memory")
#define PG8_BAR __builtin_amdgcn_s_barrier()
#define PG8_SCHED __builtin_amdgcn_sched_barrier(0)
    Unit cur, nxt; int ui = 0;
    if (!S.next(0, cur)) return;
    f32x4 acc[2][2][4][2];
#pragma unroll
    for (int a = 0; a < 2; ++a)
#pragma unroll
        for (int b = 0; b < 2; ++b)
#pragma unroll
            for (int m = 0; m < 4; ++m)
#pragma unroll
                for (int n = 0; n < 2; ++n) acc[a][b][m][n] = (f32x4){0.f, 0.f, 0.f, 0.f};
    f16x8 At[4][2], B0[2][2], B1[2][2];
    static_assert(ALIGN_EPI || !Sched::SPLIT, "the split hand-over needs the wave halves aligned");
    const char* cA = (const char*)g.A + (size_t)cur.pm * tstep; const char* cB = (const char*)g.Bt + (size_t)cur.pn * tstep;
    if constexpr (Sched::SPLIT) { if (cur.ks > 0) { cA += K; cB += K; } }
    S.a_ready(cur);
    PG8_STAGE(PG8_SB(0, 0), cB, voffB); PG8_STAGE(PG8_SB(0, 1), cB + hstep, voffB); PG8_STAGE(PG8_SA(0, 0), cA, voffA); PG8_STAGE(PG8_SA(0, 1), cA + hstep, voffA);
    if (wr == 1) PG8_BAR;
    PG8_WAIT_V(2); PG8_BAR;
    PG8_STAGE(PG8_SB(1, 0), cB + kstep, voffB); PG8_STAGE(PG8_SA(1, 0), cA + kstep, voffA); PG8_STAGE(PG8_SB(1, 1), cB + hstep + kstep, voffB);
    PG8_WAIT_V(6); PG8_BAR;
    for (;;) {
        const bool has_next = S.next(ui + 1, nxt);
        const char* nA = has_next ? (const char*)g.A + (size_t)nxt.pm * tstep : cA; const char* nB = has_next ? (const char*)g.Bt + (size_t)nxt.pn * tstep : cB;
        int ntu = nt;
        if constexpr (Sched::SPLIT) { if (has_next && nxt.ks > 0) { nA += K; nB += K; } if (cur.ks >= 0) ntu = nt >> 1; }
        for (int t = 0; t < ntu; t += 2) {
            const bool last = (t == ntu - 2);
            const char* a1 = cA + (size_t)(t + 1) * kstep;
            const char* a2 = last ? nA : cA + (size_t)(t + 2) * kstep; const char* b2 = last ? nB : cB + (size_t)(t + 2) * kstep;
            const char* a3 = a2 + kstep; const char* b3 = b2 + kstep;
            if (last && has_next) S.a_ready(nxt);
            PG8_LDB(B0, 0, 0); PG8_LDB(B1, 0, 1); PG8_SCHED; PG8_LDA(At, 0, 0); PG8_STAGE(PG8_SA(1, 1), a1 + hstep, voffA);
            PG8_WAIT_V(8); PG8_WAIT_L(0); PG8_BAR; PG8_MMA(0, 0, At, B0); PG8_MMA(0, 1, At, B1); PG8_BAR; PG8_SCHED;
            PG8_LDA(At, 0, 1); PG8_STAGE(PG8_SB(0, 0), b2, voffB); PG8_STAGE(PG8_SB(0, 1), b2 + hstep, voffB); PG8_STAGE(PG8_SA(0, 0), a2, voffA);
            PG8_WAIT_V(8); PG8_WAIT_L(0); PG8_BAR; PG8_MMA(1, 0, At, B0); PG8_MMA(1, 1, At, B1); PG8_BAR; PG8_SCHED;
            PG8_LDB(B0, 1, 0); PG8_LDB(B1, 1, 1); PG8_SCHED; PG8_LDA(At, 1, 0); PG8_STAGE(PG8_SA(0, 1), a2 + hstep, voffA);
            PG8_WAIT_V(8); PG8_WAIT_L(0); PG8_BAR; PG8_MMA(0, 0, At, B0); PG8_MMA(0, 1, At, B1); PG8_BAR; PG8_SCHED;
            PG8_LDA(At, 1, 1); PG8_STAGE(PG8_SB(1, 0), b3, voffB); PG8_STAGE(PG8_SB(1, 1), b3 + hstep, voffB); PG8_STAGE(PG8_SA(1, 0), a3, voffA);
            PG8_WAIT_V(8); PG8_WAIT_L(0); PG8_BAR; PG8_MMA(1, 0, At, B0); PG8_MMA(1, 1, At, B1); PG8_BAR; PG8_SCHED;
        }
        if constexpr (ALIGN_EPI) { if (wr == 0) PG8_BAR; }
        bool epi = true;
        if constexpr (Sched::SPLIT) {
            if (cur.ks == 1) {
                char* pbb = (char*)S.pb + (size_t)S.slot() * 262144; unsigned po = (unsigned)tid * 16u; asm volatile("" : "+v"(po));
#pragma unroll
                for (int i = 0; i < 32; ++i) *(f32x4*)(pbb + (po + (unsigned)i * 8192u)) = acc[i >> 4][(i >> 3) & 1][(i >> 1) & 3][i & 1];
                asm volatile("s_waitcnt vmcnt(0)" ::: "memory"); PG8_BAR;
                if (tid == 0) { __builtin_amdgcn_fence(__ATOMIC_RELEASE, "agent"); __hip_atomic_store(S.fl + S.slot(), 1u, __ATOMIC_RELAXED, __HIP_MEMORY_SCOPE_AGENT); }
                epi = false;
            } else if (cur.ks == 0) {
                if (tid == 0) { unsigned sp = 0u; while (__hip_atomic_load(S.fl + S.slot(), __ATOMIC_RELAXED, __HIP_MEMORY_SCOPE_AGENT) == 0u && ++sp < (1u << 24)) __builtin_amdgcn_s_sleep(1);
                                __builtin_amdgcn_fence(__ATOMIC_ACQUIRE, "agent"); }
                PG8_BAR; asm volatile("" ::: "memory");
                const char* pbb = (const char*)S.pb + (size_t)S.slot() * 262144; unsigned po = (unsigned)tid * 16u; asm volatile("" : "+v"(po));
#pragma unroll
                for (int i0 = 0; i0 < 32; i0 += 4) { f32x4 t8[4];
#pragma unroll
                    for (int i = 0; i < 4; ++i) t8[i] = *(const f32x4*)(pbb + (po + (unsigned)(i0 + i) * 8192u));
#pragma unroll
                    for (int i = 0; i < 4; ++i) { const int ii = i0 + i; acc[ii >> 4][(ii >> 3) & 1][(ii >> 1) & 3][ii & 1] += t8[i]; } }
            }
        }
        if (epi) E(acc, cur, wr, wc, fr, fq);
        S.done(cur);
        if (!has_next) break;
#pragma unroll
        for (int a = 0; a < 2; ++a)
#pragma unroll
            for (int b = 0; b < 2; ++b)
#pragma unroll
                for (int m = 0; m < 4; ++m)
#pragma unroll
                    for (int n = 0; n < 2; ++n) acc[a][b][m][n] = (f32x4){0.f, 0.f, 0.f, 0.f};
        cur = nxt; cA = nA; cB = nB; ++ui;
        if constexpr (ALIGN_EPI) { if (wr == 1) PG8_BAR; }
    }
    PG8_WAIT_V(0);
    if constexpr (!ALIGN_EPI) { if (wr == 0) PG8_BAR; }
    PG8_BAR;
#undef PG8_SA
#undef PG8_SB
#undef PG8_STAGE
#undef PG8_LDA
#undef PG8_LDB
#undef PG8_MMA
#undef PG8_WAIT_V
#undef PG8_WAIT_L
#undef PG8_BAR
#undef PG8_SCHED
}
}

constexpr size_t MiB = 1u << 20;
constexpr size_t WS_CTL = 0;
constexpr size_t WS_MOD = 1 * MiB;
constexpr size_t WS_MODP_OLD = 2 * MiB;
constexpr size_t WS_ROPE = 6 * MiB;
constexpr size_t WS_KMEAN = 8 * MiB;
constexpr size_t WS_WAIN = 16 * MiB;
constexpr size_t WS_WAO = WS_WAIN + 2 * (size_t)A_INP * D_ * 2;
constexpr size_t WS_WBIN = WS_WAO + 2 * (size_t)D_ * D_ * 2;
constexpr size_t WS_WBO = WS_WBIN + 2 * (size_t)B_IN * D_ * 2;
constexpr size_t WS_WF1 = WS_WBO + 2 * (size_t)D_ * D_ * 2;
constexpr size_t WS_WF2 = WS_WF1 + 4 * (size_t)2 * DFF * D_ * 2;
constexpr size_t WS_H = WS_WF2 + 4 * (size_t)D_ * DFF * 2;
constexpr size_t WS_Q = WS_H + (size_t)S_ * D_ * 2;
constexpr size_t WS_K = WS_Q + (size_t)S_ * D_ * 2;
constexpr size_t WS_V = WS_K + (size_t)S_ * D_ * 2;
constexpr size_t WS_QI = WS_V + (size_t)S_ * D_ * 2;
constexpr size_t WS_KI = WS_QI + (size_t)S_ * 1024 * 2;
constexpr size_t WS_WI = WS_KI + (size_t)S_ * 64 * 2;
constexpr size_t WS_SEL = WS_WI + (size_t)S_ * 16 * 4;
constexpr size_t WS_O = WS_SEL + (size_t)S_ * NSEL * 4;
constexpr size_t WS_Y = WS_O + (size_t)S_ * D_ * 2;
constexpr size_t WS_ACT = WS_Y + (size_t)S_ * D_ * 4;
constexpr size_t WS_LIST = WS_ACT + (size_t)S_ * DFF * 2;
constexpr size_t WS_PO = WS_LIST + (size_t)16 * 32 * 8192 * 2;
constexpr size_t WS_PML = WS_PO + (size_t)S_ * 16 * 3 * 128 * 2;
constexpr size_t WS_SC = WS_PML + (size_t)S_ * 16 * 3 * 2 * 4;
constexpr size_t WS_PB = WS_SC + (size_t)65792 * 2048;
constexpr size_t WS_END = WS_PB + (size_t)128 * 65536 * 4;
constexpr size_t WS_MODP = WS_PB;
constexpr int CW_CONVQ = 17408;
constexpr int CW_SPLIT = 16384;
constexpr size_t WS_KMH = 9 * MiB, WS_KML = 10 * MiB;
constexpr size_t WS_SEL3 = 11 * MiB;
constexpr int CW_DSAQ = 12288;
constexpr size_t WS_KSUM = 512 * 1024;
constexpr int CW_MCNT = 8192;

struct P {
    const float *x, *c; const int* pos; const float *a_w_in, *a_w_o, *b_w_in, *b_w_o, *ada_w, *ada_b, *norm_g, *ffn_w_in, *ffn_w_out;
    float* out; unsigned char* ws;
};

template <int MAP> __device__ __forceinline__ void transpose_item(const float* W, int K, int N, f16_t* WT, LAS float* scr, int item, int nblk, int lane) {
    const int kb = item / nblk, nb = item % nblk, k0 = 64 * kb, n0 = 32 * nb;
    const int ncol = n0 + (lane & 31); const bool ok = ncol < N;
#pragma unroll 8
    for (int i = 0; i < 32; ++i) { const int kk = 2 * i + (lane >> 5); scr[kk * 33 + (lane & 31)] = ok ? W[(size_t)(k0 + kk) * N + ncol] : 0.f; }
    asm volatile("s_waitcnt lgkmcnt(0)" ::: "memory");
    const int c = lane & 7;
#pragma unroll
    for (int j = 0; j < 4; ++j) { const int n = (lane >> 3) + 8 * j; const LAS float* s = scr + (8 * c) * 33 + n;
        u32x4 o; o.x = pk_f16(s[0 * 33], s[1 * 33]); o.y = pk_f16(s[2 * 33], s[3 * 33]); o.z = pk_f16(s[4 * 33], s[5 * 33]); o.w = pk_f16(s[6 * 33], s[7 * 33]);
        int nn = n0 + n, row;
        if (MAP == 1) { const int isg = nn >= DFF ? 1 : 0, cc = nn - isg * DFF; row = (cc >> 7) * 256 + isg * 128 + (cc & 127); } else row = nn;
        *(u32x4*)(WT + (size_t)row * K + k0 + 8 * c) = o; }
    asm volatile("s_waitcnt lgkmcnt(0)" ::: "memory");
}


#define XB_TMO      128
#define XB_XCNT(j)  (256  + 64 * (j))
#define XB_XSUB(j)  (1280 + 64 * (j))
#define XB_XGEN(j)  (2304 + 64 * (j))
#define XB_TOP      3328
#define XB_TOPGEN   3392
#define XCD_BAR_WORDS 3456
#define XB_SPIN_CAP (1u << 22)
__device__ __forceinline__ unsigned xb_ld(unsigned* p)              { return __hip_atomic_load(p, __ATOMIC_RELAXED, __HIP_MEMORY_SCOPE_AGENT); }
__device__ __forceinline__ unsigned xb_add(unsigned* p, unsigned v) { return __hip_atomic_fetch_add(p, v, __ATOMIC_RELAXED, __HIP_MEMORY_SCOPE_AGENT); }
__device__ __forceinline__ unsigned xb_xcc_id() { return (unsigned)__builtin_amdgcn_s_getreg((3 << 11) | 20) & 0xFu; }
#define XB_SPIN(cond, bar) do { unsigned _sp = 0; while (cond) { __builtin_amdgcn_s_sleep(1); \
    if ((++_sp & 255u) == 0u) { if (xb_ld(&(bar)[XB_TMO])) break; if (_sp > XB_SPIN_CAP) { atomicAdd(&(bar)[XB_TMO], 1u); break; } } } } while (0)
struct XcdBarrier { unsigned* bar; unsigned x; volatile LAS unsigned* st; };
__device__ __forceinline__ XcdBarrier xcd_barrier_post(unsigned* bar, volatile LAS unsigned* st) {
    XcdBarrier b; b.bar = bar; b.x = xb_xcc_id(); b.st = st;
    if (threadIdx.x == 0) (void)xb_add(&bar[XB_XCNT(b.x)], 1u);
    return b;
}
__device__ __forceinline__ void xcd_barrier_complete(unsigned* bar, unsigned x, unsigned& nloc, unsigned& nx) {
    const unsigned G = gridDim.x * gridDim.y * gridDim.z;
    unsigned sum, cnt, mine, sp = 0u;
    for (;;) {
        sum = 0u; cnt = 0u; mine = 0u;
#pragma unroll
        for (unsigned j = 0; j < 16; ++j) { const unsigned c = xb_ld(&bar[XB_XCNT(j)]); sum += c; cnt += (c > 0u) ? 1u : 0u; mine = (j == x) ? c : mine; }
        if (sum == G) break;
        __builtin_amdgcn_s_sleep(1);
        if ((++sp & 255u) == 0u) { if (xb_ld(&bar[XB_TMO])) break; if (sp > XB_SPIN_CAP) { atomicAdd(&bar[XB_TMO], 1u); break; } }
    }
    nloc = mine > 0u ? mine : 1u; nx = cnt > 0u ? cnt : 1u;
}
__device__ __forceinline__ void xcd_barrier(const XcdBarrier& b) {
    asm volatile("s_waitcnt vmcnt(0)" ::: "memory");
    __syncthreads();
    if (threadIdx.x == 0) {
        unsigned* bar = b.bar;
        __builtin_amdgcn_s_waitcnt(0);
        unsigned nloc = b.st[0], nx = b.st[1];
        if (nloc == 0u) { xcd_barrier_complete(bar, b.x, nloc, nx); b.st[0] = nloc; b.st[1] = nx; }
        const unsigned old = xb_add(&bar[XB_XSUB(b.x)], 1u);
        const unsigned gen = old / nloc;
        if (old + 1u == (gen + 1u) * nloc) {
            __builtin_amdgcn_fence(__ATOMIC_RELEASE, "agent");
            asm volatile("s_waitcnt vmcnt(0)" ::: "memory");
            const unsigned og = xb_add(&bar[XB_TOP], 1u);
            const unsigned tg = og / nx;
            if (og + 1u == (tg + 1u) * nx) xb_add(&bar[XB_TOPGEN], 1u);
            else XB_SPIN(xb_ld(&bar[XB_TOPGEN]) == tg, bar);
            __builtin_amdgcn_fence(__ATOMIC_ACQUIRE, "agent");
            xb_add(&bar[XB_XGEN(b.x)], 1u);
            asm volatile("s_waitcnt vmcnt(0)" ::: "memory");
        } else {
            XB_SPIN(xb_ld(&bar[XB_XGEN(b.x)]) == gen, bar);
            __builtin_amdgcn_fence(__ATOMIC_ACQUIRE, "agent");
            asm volatile("s_waitcnt vmcnt(0)" ::: "memory");
        }
    }
    __syncthreads();
}

constexpr int LDS_RING = 131072, LDS_MISC = LDS_RING, LDS_BYTES = 147456;
template <int MAP, bool NT> __device__ __forceinline__ void transpose_item64(const float* W, int K, int N, f16_t* WT, LAS float* scr, int item, int nblk, int lane) {
    const int kb = item / nblk, nb = item % nblk, k0 = 64 * kb, n0 = 64 * nb;
    const int r4 = lane >> 4, c4 = lane & 15, ncol = n0 + 4 * c4; const bool ok = ncol < N;
    f32x4 v[16];
#pragma unroll
    for (int i = 0; i < 16; ++i) { const f32x4* wp = (const f32x4*)(W + (size_t)(k0 + 4 * i + r4) * N + ncol); v[i] = ok ? (NT ? __builtin_nontemporal_load(wp) : *wp) : (f32x4){0.f, 0.f, 0.f, 0.f}; }
    __builtin_amdgcn_sched_barrier(0);
#pragma unroll
    for (int i = 0; i < 16; ++i) { const int kk = 4 * i + r4; *(LAS f32x4*)(scr + kk * 64 + ((4 * c4) ^ (8 * (kk >> 3)))) = v[i]; }
    asm volatile("s_waitcnt lgkmcnt(0)" ::: "memory");
    const int c = lane & 7;
#pragma unroll
    for (int j = 0; j < 8; ++j) { const int n = (lane >> 3) + 8 * j; const LAS float* s = scr + (8 * c) * 64 + (n ^ (8 * c));
        u32x4 o; o.x = pk_f16(s[0 * 64], s[1 * 64]); o.y = pk_f16(s[2 * 64], s[3 * 64]); o.z = pk_f16(s[4 * 64], s[5 * 64]); o.w = pk_f16(s[6 * 64], s[7 * 64]);
        int nn = n0 + n, row;
        if (MAP == 1) { const int isg = nn >= DFF ? 1 : 0, cc = nn - isg * DFF; row = (cc >> 7) * 256 + isg * 128 + (cc & 127); } else row = nn;
        if (NT) __builtin_nontemporal_store(o, (u32x4*)(WT + (size_t)row * K + k0 + 8 * c)); else *(u32x4*)(WT + (size_t)row * K + k0 + 8 * c) = o; }
    asm volatile("s_waitcnt lgkmcnt(0)" ::: "memory");
}

namespace cv {
constexpr int NB_A = A_INP / 64, I_A = (D_ / 64) * NB_A;
constexpr int NB_O = D_ / 64, I_O = (D_ / 64) * NB_O;
constexpr int NB_B = B_IN / 64, I_B = (D_ / 64) * NB_B;
constexpr int NB_1 = 2 * DFF / 64, I_1 = (D_ / 64) * NB_1;
constexpr int NB_2 = D_ / 64, I_2 = (DFF / 64) * NB_2;
constexpr int O_A = 0, O_AO = O_A + 2 * I_A, O_B = O_AO + 2 * I_O, O_BO = O_B + 2 * I_B, O_1 = O_BO + 2 * I_O, O_2 = O_1 + 4 * I_1, TOT = O_2 + 4 * I_2;
constexpr int N_LA = I_A + I_O + I_1 + I_2, N_LB = I_B + I_O + I_1 + I_2;
}
__device__ __forceinline__ int conv_map_a(int j, int la, int l) { using namespace cv;
    if (j < I_A) return O_A + la * I_A + j; j -= I_A; if (j < I_O) return O_AO + la * I_O + j; j -= I_O; if (j < I_1) return O_1 + l * I_1 + j; j -= I_1; return O_2 + l * I_2 + j; }
__device__ __forceinline__ int conv_map_b(int j, int lb, int l) { using namespace cv;
    if (j < I_B) return O_B + lb * I_B + j; j -= I_B; if (j < I_O) return O_BO + lb * I_O + j; j -= I_O; if (j < I_1) return O_1 + l * I_1 + j; j -= I_1; return O_2 + l * I_2 + j; }
__device__ __forceinline__ int conv_count(int stage) { return stage == 0 ? cv::N_LA : stage == 1 ? cv::N_LB + cv::N_LA : cv::N_LB; }
__device__ __forceinline__ int conv_map(int stage, int j) {
    if (stage == 0) return conv_map_a(j, 0, 0);
    if (stage == 1) return j < cv::N_LB ? conv_map_b(j, 0, 1) : conv_map_a(j - cv::N_LB, 1, 2);
    return conv_map_b(j, 1, 3);
}
template <bool NT> __device__ __forceinline__ void conv_item(const P& p, LAS float* scr, int it, int lane) {
    using namespace cv; unsigned char* ws = p.ws; int r = it;
    if (r < 2 * I_A) { const int l = r / I_A; transpose_item64<0, NT>(p.a_w_in + (size_t)l * D_ * A_IN, D_, A_IN, (f16_t*)(ws + WS_WAIN) + (size_t)l * A_INP * D_, scr, r % I_A, NB_A, lane); return; } r -= 2 * I_A;
    if (r < 2 * I_O) { const int l = r / I_O; transpose_item64<0, NT>(p.a_w_o + (size_t)l * D_ * D_, D_, D_, (f16_t*)(ws + WS_WAO) + (size_t)l * D_ * D_, scr, r % I_O, NB_O, lane); return; } r -= 2 * I_O;
    if (r < 2 * I_B) { const int l = r / I_B; transpose_item64<0, NT>(p.b_w_in + (size_t)l * D_ * B_IN, D_, B_IN, (f16_t*)(ws + WS_WBIN) + (size_t)l * B_IN * D_, scr, r % I_B, NB_B, lane); return; } r -= 2 * I_B;
    if (r < 2 * I_O) { const int l = r / I_O; transpose_item64<0, NT>(p.b_w_o + (size_t)l * D_ * D_, D_, D_, (f16_t*)(ws + WS_WBO) + (size_t)l * D_ * D_, scr, r % I_O, NB_O, lane); return; } r -= 2 * I_O;
    if (r < 4 * I_1) { const int l = r / I_1; transpose_item64<1, NT>(p.ffn_w_in + (size_t)l * D_ * 2 * DFF, D_, 2 * DFF, (f16_t*)(ws + WS_WF1) + (size_t)l * 2 * DFF * D_, scr, r % I_1, NB_1, lane); return; } r -= 4 * I_1;
    { const int l = r / I_2; transpose_item64<0, NT>(p.ffn_w_out + (size_t)l * DFF * D_, DFF, D_, (f16_t*)(ws + WS_WF2) + (size_t)l * D_ * DFF, scr, r % I_2, NB_2, lane); }
}

__device__ __forceinline__ void phase_prologue(const P& p, LAS unsigned char* lds) {
    const int tid = otid(), lane = tid & 63, wave = tid >> 6; const int bid = obid();
    LAS float* scr = (LAS float*)(lds + wave * 16384);
    const int gw = bid * 8 + wave, NGW = gridDim.x * 8;
    unsigned char* ws = p.ws;
    { const int n0 = conv_count(0);
        for (int j = gw; j < n0; j += NGW) conv_item<false>(p, scr, conv_map(0, j), lane); }
    {
        float* part = (float*)(ws + WS_MODP);
        for (int it = gw; it < 4 * 32 * 48; it += NGW) {
            const int l = it / 1536, kc = (it % 1536) / 48, nc = it % 48;
            const float* W = p.ada_w + ((size_t)l * D_ + kc * 64) * 12288 + nc * 256 + 4 * lane;
            f32x4 a = {0.f, 0.f, 0.f, 0.f};
#pragma unroll 8
            for (int k = 0; k < 64; ++k) { const float cv = p.c[kc * 64 + k]; const float sv = cv / (1.0f + __expf(-cv)); a += sv * *(const f32x4*)(W + (size_t)k * 12288); }
            *(f32x4*)(part + ((size_t)(l * 32 + kc)) * 12288 + nc * 256 + 4 * lane) = a;
        }
    }
    {
        float* rcA = (float*)(ws + WS_ROPE); float* rsA = rcA + S_ * 16; float* rcI = rsA + S_ * 16; float* rsI = rcI + S_ * 8;
        for (int i = bid * 512 + tid; i < S_ * 24; i += gridDim.x * 512) {
            const int t = i / 24, j = i % 24; const double pos = (double)p.pos[t];
            if (j < 16) { const double ang = pos * pow(500000.0, -(double)j / 16.0); rcA[t * 16 + j] = (float)cos(ang); rsA[t * 16 + j] = (float)sin(ang); }
            else { const int jj = j - 16; const double ang = pos * pow(500000.0, -(double)jj / 8.0); rcI[t * 8 + jj] = (float)cos(ang); rsI[t * 8 + jj] = (float)sin(ang); }
        }
    }
}
__device__ __forceinline__ void phase_mod_reduce(const P& p) {
    const float* part = (const float*)(p.ws + WS_MODP);
    for (int i = obid() * 512 + otid(); i < 4 * 12288; i += gridDim.x * 512) {
        const int l = i / 12288, n = i % 12288; float s = p.ada_b[i];
#pragma unroll
        for (int kc = 0; kc < 32; ++kc) s += part[(size_t)(l * 32 + kc) * 12288 + n];
        ((float*)(p.ws + WS_MOD))[i] = s; }
}

__device__ __forceinline__ void nr_unpack8(const u32x4 w, f32x4& a, f32x4& b) {
    const unsigned w0 = w.x, w1 = w.y, w2 = w.z, w3 = w.w;
    const f16x2 h0 = __builtin_bit_cast(f16x2, w0), h1 = __builtin_bit_cast(f16x2, w1), h2 = __builtin_bit_cast(f16x2, w2), h3 = __builtin_bit_cast(f16x2, w3);
    a = (f32x4){(float)h0[0], (float)h0[1], (float)h1[0], (float)h1[1]}; b = (f32x4){(float)h2[0], (float)h2[1], (float)h3[0], (float)h3[1]};
}
template <bool HAS_Y, bool HAS_H, bool XI16, bool XO16>
__device__ __forceinline__ void norm_rows(const void* xin_, const f16_t* y, const float* gate, const float* gamY, void* xout_,
                                          const float* gamH, const float* sc, const float* sh, f16_t* hout) {
    const int tid_ = otid(); const int lane = tid_ & 63, gw = obid() * 8 + (tid_ >> 6), NGW = (int)gridDim.x * 8;
    f32x4 cA[8], cB[8], cC[8];
#pragma unroll
    for (int j = 0; j < 8; ++j) { const int o = 8 * lane + 512 * (j >> 1) + 4 * (j & 1);
        if (HAS_Y) cA[j] = *(const f32x4*)(gate + o) * *(const f32x4*)(gamY + o);
        if (HAS_H) { cB[j] = *(const f32x4*)(gamH + o) * (1.0f + *(const f32x4*)(sc + o)); cC[j] = *(const f32x4*)(sh + o); } }
    f32x4 xv[8], yv[8];
    for (int r = gw; r < S_; r += NGW) {
        const size_t o = (size_t)r * D_ + 8 * lane;
#pragma unroll
        for (int jj = 0; jj < 4; ++jj) {
            if (XI16) { const u32x4 xw = *(const u32x4*)((const f16_t*)xin_ + o + 512 * jj); nr_unpack8(xw, xv[2 * jj], xv[2 * jj + 1]); }
            else { xv[2 * jj] = *(const f32x4*)((const float*)xin_ + o + 512 * jj); xv[2 * jj + 1] = *(const f32x4*)((const float*)xin_ + o + 512 * jj + 4); }
            if (HAS_Y) { const u32x4 yw = *(const u32x4*)(y + o + 512 * jj); nr_unpack8(yw, yv[2 * jj], yv[2 * jj + 1]); } }
        __builtin_amdgcn_sched_barrier(0);
        if (HAS_Y) {
            float ss = 0.f;
#pragma unroll
            for (int j = 0; j < 8; ++j) ss += (yv[j].x * yv[j].x + yv[j].y * yv[j].y) + (yv[j].z * yv[j].z + yv[j].w * yv[j].w);
            const float rstd = 1.0f / sqrtf(wave_sum(ss) * (1.0f / D_) + EPS);
#pragma unroll
            for (int j = 0; j < 8; ++j) xv[j] = xv[j] + cA[j] * (yv[j] * rstd);
#pragma unroll
            for (int jj = 0; jj < 4; ++jj) {
                if (XO16) { u32x4 w; w.x = pk_f16(xv[2 * jj].x, xv[2 * jj].y); w.y = pk_f16(xv[2 * jj].z, xv[2 * jj].w); w.z = pk_f16(xv[2 * jj + 1].x, xv[2 * jj + 1].y); w.w = pk_f16(xv[2 * jj + 1].z, xv[2 * jj + 1].w);
                    *(u32x4*)((f16_t*)xout_ + o + 512 * jj) = w; nr_unpack8(w, xv[2 * jj], xv[2 * jj + 1]); }
                else { *(f32x4*)((float*)xout_ + o + 512 * jj) = xv[2 * jj]; *(f32x4*)((float*)xout_ + o + 512 * jj + 4) = xv[2 * jj + 1]; } }
        }
        if (HAS_H) {
            float ss = 0.f;
#pragma unroll
            for (int j = 0; j < 8; ++j) ss += (xv[j].x * xv[j].x + xv[j].y * xv[j].y) + (xv[j].z * xv[j].z + xv[j].w * xv[j].w);
            const float rstd = 1.0f / sqrtf(wave_sum(ss) * (1.0f / D_) + EPS);
#pragma unroll
            for (int jj = 0; jj < 4; ++jj) { const f32x4 h0 = (xv[2 * jj] * rstd) * cB[2 * jj] + cC[2 * jj], h1 = (xv[2 * jj + 1] * rstd) * cB[2 * jj + 1] + cC[2 * jj + 1];
                u32x4 w; w.x = pk_f16(h0.x, h0.y); w.y = pk_f16(h0.z, h0.w); w.z = pk_f16(h1.x, h1.y); w.w = pk_f16(h1.z, h1.w); *(u32x4*)(hout + o + 512 * jj) = w; }
        }
        __builtin_amdgcn_sched_barrier(0);
    }
}
__device__ __forceinline__ void phase_norm(const P& p, int mode, int l) {
    const float* mod = (const float*)(p.ws + WS_MOD) + (size_t)l * 12288; const float* ng = p.norm_g + (size_t)l * 4 * D_;
    const f16_t* y = (const f16_t*)(p.ws + WS_Y); f16_t* H = (f16_t*)(p.ws + WS_H);
    f16_t* X16 = (f16_t*)(p.ws + WS_Y + (size_t)S_ * D_ * 2);
    if (mode == 0) norm_rows<false, true, false, false>(p.x, nullptr, nullptr, nullptr, nullptr, ng, mod + 1 * D_, mod + 0 * D_, H);
    else if (mode == 1) { if (l == 0) norm_rows<true, true, false, true>(p.x, y, mod + 2 * D_, ng + D_, X16, ng + 2 * D_, mod + 4 * D_, mod + 3 * D_, H);
                          else norm_rows<true, true, true, true>(X16, y, mod + 2 * D_, ng + D_, X16, ng + 2 * D_, mod + 4 * D_, mod + 3 * D_, H); }
    else { const float* modn = mod + 12288; const float* ngn = ng + 4 * D_;
        if (l < 3) norm_rows<true, true, true, true>(X16, y, mod + 5 * D_, ng + 3 * D_, X16, ngn, modn + 1 * D_, modn + 0 * D_, H);
        else norm_rows<true, false, true, false>(X16, y, mod + 5 * D_, ng + 3 * D_, p.out, nullptr, nullptr, nullptr, nullptr); }
}

__device__ __forceinline__ unsigned ordkey(float f) { const unsigned u = __float_as_uint(f); return (u & 0x80000000u) ? ~u : (u | 0x80000000u); }
__device__ __forceinline__ void phase_naive_topk(const P& p, LAS unsigned char* lds) {
    const int tid_ = otid(); const int half = tid_ >> 8, tid = tid_ & 255, lane = tid & 63, wave = tid >> 6; const int bid = obid();
    LAS float* qi = (LAS float*)(lds + half * 40960); LAS float* wv = qi + 1024; LAS unsigned* keys = (LAS unsigned*)(wv + 16); LAS unsigned* red = keys + S_;
    const f16_t* KI = (const f16_t*)(p.ws + WS_KI);
    for (int t0 = bid * 2; t0 < S_; t0 += gridDim.x * 2) {
        const int t = t0 + half;
        const f16_t* QI = (const f16_t*)(p.ws + WS_QI) + (size_t)t * 1024; const float* WI = (const float*)(p.ws + WS_WI) + (size_t)t * 16;
        int* sel = (int*)(p.ws + WS_SEL) + (size_t)t * NSEL;
        for (int i = tid; i < 1024; i += 256) qi[i] = h2f(QI[i]);
        if (tid < 16) wv[tid] = WI[tid];
        __syncthreads();
        const int n = t + 1; const bool small = n <= NSEL;
        if (!small) for (int s = tid; s < n; s += 256) {
            float kk[64];
            const u32x4* kp = (const u32x4*)(KI + (size_t)s * 64);
#pragma unroll
            for (int c = 0; c < 8; ++c) { const u32x4 w = kp[c];
#pragma unroll
                for (int e = 0; e < 4; ++e) { kk[8 * c + 2 * e] = h2f((f16_t)(w[e] & 0xffff)); kk[8 * c + 2 * e + 1] = h2f((f16_t)(w[e] >> 16)); } }
            float sc = 0.f;
            for (int h = 0; h < 16; ++h) { float d = 0.f;
#pragma unroll
                for (int e = 0; e < 64; ++e) d = fmaf(qi[h * 64 + e], kk[e], d);
                sc = fmaf(wv[h], fmaxf(d, 0.f), sc); }
            keys[s] = ordkey(sc + 0.0f);
        }
        __syncthreads();
        unsigned prefix = 0u; int k = NSEL;
        for (int bit = 31; bit >= 0; --bit) {
            const unsigned want = (prefix >> bit) | 1u; int cnt = 0;
            if (!small) for (int s = tid; s < n; s += 256) cnt += ((keys[s] >> bit) == want) ? 1 : 0;
#pragma unroll
            for (int o = 1; o < 64; o <<= 1) cnt += __shfl_xor(cnt, o);
            if (lane == 0) red[wave] = (unsigned)cnt;
            __syncthreads();
            const int tot = (int)(red[0] + red[1] + red[2] + red[3]);
            __syncthreads();
            if (tot >= k) prefix |= (1u << bit); else k -= tot;
        }
        if (small) sel[tid] = tid < n ? tid : -1;
        else if (wave == 0) {
            int outc = 0, eqc = 0;
            for (int s0 = 0; s0 < n; s0 += 64) { const int s = s0 + lane; const unsigned key = s < n ? keys[s] : 0u; const bool gt = s < n && key > prefix, eq = s < n && key == prefix;
                const unsigned long long beq = __ballot(eq); const unsigned long long lt = (1ull << lane) - 1ull;
                const bool take = gt || (eq && (eqc + __popcll(beq & lt)) < k);
                const unsigned long long bt = __ballot(take);
                if (take) { const int pos = outc + __popcll(bt & lt); if (pos < NSEL) sel[pos] = s; }
                outc += __popcll(bt); eqc += __popcll(beq); }
        }
        __syncthreads();
    }
}
__device__ __forceinline__ void phase_naive_dsa_attn(const P& p, LAS unsigned char* lds) {
    const int tid_ = otid(); const int half = tid_ >> 8, tid = tid_ & 255, lane = tid & 63, wave = tid >> 6; const int bid = obid();
    LAS float* q = (LAS float*)(lds + half * 32768); LAS float* Sm = q + 2048; LAS int* sl = (LAS int*)(Sm + 16 * NSEL);
    const f16_t* K = (const f16_t*)(p.ws + WS_K); const f16_t* V = (const f16_t*)(p.ws + WS_V);
    for (int t0 = bid * 2; t0 < S_; t0 += gridDim.x * 2) {
        const int t = t0 + half;
        const f16_t* Q = (const f16_t*)(p.ws + WS_Q) + (size_t)t * 2048; const int* sel = (const int*)(p.ws + WS_SEL) + (size_t)t * NSEL;
        for (int i = tid; i < 2048; i += 256) q[i] = h2f(Q[i]);
        sl[tid] = sel[tid];
        __syncthreads();
        { const int key = sl[tid]; const bool valid = key >= 0 && key <= t; const float scale = 0.08838834764831845f;
            for (int g = 0; g < 4; ++g) { float kk[128];
                if (valid) { const u32x4* kp = (const u32x4*)(K + (size_t)key * 512 + g * 128);
#pragma unroll
                    for (int c = 0; c < 16; ++c) { const u32x4 w = kp[c];
#pragma unroll
                        for (int e = 0; e < 4; ++e) { kk[8 * c + 2 * e] = h2f((f16_t)(w[e] & 0xffff)); kk[8 * c + 2 * e + 1] = h2f((f16_t)(w[e] >> 16)); } } }
                for (int r = 0; r < 4; ++r) { const int h = 4 * g + r; float d = 0.f;
                    if (valid) {
#pragma unroll
                        for (int e = 0; e < 128; ++e) d = fmaf(q[h * 128 + e], kk[e], d); }
                    Sm[h * NSEL + tid] = valid ? d * scale : -INFINITY; } } }
        __syncthreads();
        for (int r = 0; r < 4; ++r) { const int h = 4 * wave + r; float v[4]; float mx = -INFINITY;
#pragma unroll
            for (int i = 0; i < 4; ++i) { v[i] = Sm[h * NSEL + lane + 64 * i]; mx = fmaxf(mx, v[i]); }
            mx = wave_max(mx); float sum = 0.f;
#pragma unroll
            for (int i = 0; i < 4; ++i) { v[i] = __expf(v[i] - mx); sum += v[i]; }
            sum = wave_sum(sum); const float inv = 1.0f / sum;
#pragma unroll
            for (int i = 0; i < 4; ++i) Sm[h * NSEL + lane + 64 * i] = v[i] * inv; }
        __syncthreads();
        { const int h = tid >> 4, dc = tid & 15, g = h >> 2; float acc[8];
#pragma unroll
            for (int e = 0; e < 8; ++e) acc[e] = 0.f;
            for (int k = 0; k < NSEL; ++k) { const float pr = Sm[h * NSEL + k]; if (pr == 0.f) continue; const int key = sl[k];
                const u32x4 w = *(const u32x4*)(V + (size_t)key * 512 + g * 128 + 8 * dc);
#pragma unroll
                for (int e = 0; e < 4; ++e) { acc[2 * e] = fmaf(pr, h2f((f16_t)(w[e] & 0xffff)), acc[2 * e]); acc[2 * e + 1] = fmaf(pr, h2f((f16_t)(w[e] >> 16)), acc[2 * e + 1]); } }
            u32x4 o; o.x = pk_f16(acc[0], acc[1]); o.y = pk_f16(acc[2], acc[3]); o.z = pk_f16(acc[4], acc[5]); o.w = pk_f16(acc[6], acc[7]);
            *(u32x4*)((f16_t*)(p.ws + WS_O) + (size_t)t * 2048 + h * 128 + 8 * dc) = o; }
        __syncthreads();
    }
}
__device__ __forceinline__ void phase_naive_moba_kmean(const P& p) {
    const int tid_ = otid(); const int sub = tid_ >> 7, d = tid_ & 127;
    for (int it = obid() * 4 + sub; it < 512; it += gridDim.x * 4) {
        const int n = it >> 4, h = it & 15; const f16_t* K = (const f16_t*)(p.ws + WS_K) + (size_t)n * 256 * 2048 + h * 128 + d;
        float s = 0.f; for (int i = 0; i < 256; ++i) s += h2f(K[(size_t)i * 2048]);
        ((float*)(p.ws + WS_KMEAN))[(size_t)it * 128 + d] = s * (1.0f / 256.0f); }
}
__device__ __forceinline__ void phase_naive_moba_attn(const P& p, LAS unsigned char* lds) {
    const int tid_ = otid(); const int half = tid_ >> 8, tid = tid_ & 255, lane = tid & 63, wave = tid >> 6; const int bid = obid();
    LAS float* q = (LAS float*)(lds + half * 8192); LAS float* gate = q + 128; LAS int* sb = (LAS int*)(gate + 32); LAS float* Sm = (LAS float*)(sb + 4); LAS float* red = Sm + 1024; LAS float* oacc = red + 8;
    const float* km = (const float*)(p.ws + WS_KMEAN);
    for (int it0 = bid * 2; it0 < S_ * 16; it0 += gridDim.x * 2) {
        const int it = it0 + half, t = it >> 4, h = it & 15, j = t >> 8;
        const f16_t* Q = (const f16_t*)(p.ws + WS_Q) + (size_t)t * 2048 + h * 128; const f16_t* K = (const f16_t*)(p.ws + WS_K) + h * 128; const f16_t* V = (const f16_t*)(p.ws + WS_V) + h * 128;
        if (tid < 128) q[tid] = h2f(Q[tid]);
        __syncthreads();
        if (tid < 32) { float g = -INFINITY; if (tid < j) { g = 0.f; const float* kp = km + ((size_t)tid * 16 + h) * 128; for (int d = 0; d < 128; ++d) g = fmaf(q[d], kp[d], g); } gate[tid] = g; }
        __syncthreads();
        if (tid == 0) { unsigned used = 0u;
            for (int s = 0; s < 3; ++s) { int best = -1; float bv = -INFINITY; for (int n = 0; n < 32; ++n) if (!((used >> n) & 1u) && n < j && (best < 0 || gate[n] > bv)) { best = n; bv = gate[n]; }
                sb[s] = best; if (best >= 0) used |= 1u << best; } }
        __syncthreads();
        const float scale = 0.08838834764831845f;
        for (int slot = 0; slot < 4; ++slot) { const int i = slot * 256 + tid; int key; bool valid;
            if (slot < 3) { valid = sb[slot] >= 0; key = (valid ? sb[slot] : 0) * 256 + tid; } else { key = j * 256 + tid; valid = key <= t; }
            float d = -INFINITY;
            if (valid) { d = 0.f; const u32x4* kp = (const u32x4*)(K + (size_t)key * 2048);
#pragma unroll
                for (int c = 0; c < 16; ++c) { const u32x4 w = kp[c];
#pragma unroll
                    for (int e = 0; e < 4; ++e) { d = fmaf(q[8 * c + 2 * e], h2f((f16_t)(w[e] & 0xffff)), d); d = fmaf(q[8 * c + 2 * e + 1], h2f((f16_t)(w[e] >> 16)), d); } }
                d *= scale; }
            Sm[i] = d; }
        __syncthreads();
        float mx = -INFINITY;
#pragma unroll
        for (int i = 0; i < 4; ++i) mx = fmaxf(mx, Sm[tid + 256 * i]);
        mx = wave_max(mx); if (lane == 0) red[wave] = mx; __syncthreads();
        mx = fmaxf(fmaxf(red[0], red[1]), fmaxf(red[2], red[3])); __syncthreads();
        float sum = 0.f;
#pragma unroll
        for (int i = 0; i < 4; ++i) { const float e = __expf(Sm[tid + 256 * i] - mx); Sm[tid + 256 * i] = e; sum += e; }
        sum = wave_sum(sum); if (lane == 0) red[wave] = sum; __syncthreads();
        const float inv = 1.0f / (red[0] + red[1] + red[2] + red[3]);
        { const int part = tid >> 6; float a0 = 0.f, a1 = 0.f;
            int blk; if (part < 3) blk = sb[part]; else blk = j;
            if (blk >= 0) for (int i = 0; i < 256; ++i) { const float pr = Sm[part * 256 + i]; if (pr == 0.f) continue; const int key = blk * 256 + i;
                const unsigned w = *(const unsigned*)(V + (size_t)key * 2048 + 2 * lane); a0 = fmaf(pr, h2f((f16_t)(w & 0xffff)), a0); a1 = fmaf(pr, h2f((f16_t)(w >> 16)), a1); }
            oacc[part * 128 + 2 * lane] = a0; oacc[part * 128 + 2 * lane + 1] = a1; }
        __syncthreads();
        if (tid < 64) { const float o0 = (oacc[2 * tid] + oacc[128 + 2 * tid] + oacc[256 + 2 * tid] + oacc[384 + 2 * tid]) * inv, o1 = (oacc[2 * tid + 1] + oacc[128 + 2 * tid + 1] + oacc[256 + 2 * tid + 1] + oacc[384 + 2 * tid + 1]) * inv;
            *(unsigned*)((f16_t*)(p.ws + WS_O) + (size_t)t * 2048 + h * 128 + 2 * tid) = pk_f16(o0, o1); }
        __syncthreads();
    }
}


typedef float f32x16 __attribute__((ext_vector_type(16)));
__device__ __forceinline__ unsigned lds_add(LAS unsigned* p, unsigned v) { return __hip_atomic_fetch_add(p, v, __ATOMIC_RELAXED, __HIP_MEMORY_SCOPE_WORKGROUP); }
__device__ __forceinline__ unsigned lds_or(LAS unsigned* p, unsigned v) { return __hip_atomic_fetch_or(p, v, __ATOMIC_RELAXED, __HIP_MEMORY_SCOPE_WORKGROUP); }
constexpr int IX_CAP = 1024;
template <int PASS>
__device__ __forceinline__ void idx_pass(const f16_t* __restrict__ KI, const f16x8 (&a)[4][4], const float (&w)[4][16], int t0g, int ntiles, int kq, int lane,
                                         LAS unsigned* hist, int qbase, const LAS int* tbv, LAS unsigned* candcnt,
                                         LAS unsigned* bm, LAS unsigned* cand_key, LAS unsigned short* cand_idx, float* __restrict__ SCu, int rowlen) {
    const int n = lane & 31, kh = lane >> 5;
    int tb[4];
    if (PASS == 2) {
#pragma unroll
        for (int pr = 0; pr < 4; ++pr) tb[pr] = tbv[qbase + 2 * pr + kh];
    }
    f16x8 b[4];
    { const f16_t* kb = KI + (size_t)(32 * (kq < ntiles ? kq : 0) + n) * 64 + 32 * kh;
#pragma unroll
        for (int s = 0; s < 4; ++s) b[s] = *(const f16x8*)(kb + 8 * s); }
    for (int kt = kq; kt < ntiles; kt += 4) {
        f16x8 bn[4];
        { const int ktn = (kt + 4 < ntiles) ? kt + 4 : kt; const f16_t* kb = KI + (size_t)(32 * ktn + n) * 64 + 32 * kh;
#pragma unroll
            for (int s = 0; s < 4; ++s) bn[s] = *(const f16x8*)(kb + 8 * s); }
        const int key = 32 * kt + n;
#pragma unroll
        for (int pr = 0; pr < 4; ++pr) {
            f32x16 c;
#pragma unroll
            for (int r = 0; r < 16; ++r) c[r] = 0.f;
#pragma unroll
            for (int s = 0; s < 4; ++s) c = __builtin_amdgcn_mfma_f32_32x32x16_f16(a[pr][s], b[s], c, 0, 0, 0);
            float sc = 0.f;
#pragma unroll
            for (int r = 0; r < 16; ++r) { const float cr_ = c[r]; const int ci_ = __builtin_bit_cast(int, cr_); const float rl = __builtin_bit_cast(float, ci_ > 0 ? ci_ : 0); sc = __builtin_fmaf(w[pr][r], rl, sc); }
            sc += 0.0f;
            const int ql = qbase + 2 * pr + kh;
            const int tq = t0g + 2 * pr + kh;
            const bool valid = key <= tq;
            const unsigned ok = ordkey(sc); const int bin = (int)(ok >> 20);
            if (PASS == 1) { SCu[ql * rowlen + key] = sc; if (valid) lds_add(hist + ql * 2048 + (bin >> 1), (bin & 1) ? 65536u : 1u); }
            else {
                const unsigned long long hm = __ballot(valid && bin > tb[pr]);
                if (n == 0) bm[ql * 256 + kt] = (unsigned)(hm >> (32 * kh));
                if (valid && bin == tb[pr]) { const unsigned slot = lds_add(candcnt + ql, 1u); if (slot < (unsigned)IX_CAP) { cand_key[ql * IX_CAP + slot] = ok; cand_idx[ql * IX_CAP + slot] = (unsigned short)key; } }
            }
        }
#pragma unroll
        for (int s = 0; s < 4; ++s) b[s] = bn[s];
    }
}
template <int STAGES> __device__ __forceinline__ void idx_unit(const P& p, LAS unsigned char* lds, int unit, int tid) {
    const int lane = tid & 63, wave = __builtin_amdgcn_readfirstlane(tid >> 6), group = wave & 1, kq = wave >> 1;
    const int t0 = unit * 16, t0g = t0 + 8 * group, qbase = 8 * group;
    const f16_t* QI = (const f16_t*)(p.ws + WS_QI); const f16_t* KI = (const f16_t*)(p.ws + WS_KI); const float* WI = (const float*)(p.ws + WS_WI);
    LAS unsigned* hist = (LAS unsigned*)lds;
    LAS unsigned* bm = (LAS unsigned*)lds;
    LAS unsigned* cand_key = (LAS unsigned*)(lds + 16384);
    LAS unsigned short* cand_idx = (LAS unsigned short*)(lds + 16384 + 65536);
    LAS int* tbv = (LAS int*)(lds + LDS_MISC + 256);
    LAS unsigned* above = (LAS unsigned*)(lds + LDS_MISC + 320);
    LAS unsigned* candcnt = (LAS unsigned*)(lds + LDS_MISC + 448);
    f16x8 a[4][4]; float w[4][16];
    { const int m = lane & 31, kh = lane >> 5, aa = m >> 3, him = (m >> 2) & 1, bb = m & 3;
#pragma unroll
        for (int pr = 0; pr < 4; ++pr) { const f16_t* qp = QI + (size_t)(t0g + 2 * pr + him) * 1024 + (4 * aa + bb) * 64 + 32 * kh;
#pragma unroll
            for (int s = 0; s < 4; ++s) a[pr][s] = *(const f16x8*)(qp + 8 * s);
            const float* wp = WI + (size_t)(t0g + 2 * pr + kh) * 16;
#pragma unroll
            for (int r4 = 0; r4 < 4; ++r4) { const f32x4 v = *(const f32x4*)(wp + 4 * r4); w[pr][4 * r4] = v.x; w[pr][4 * r4 + 1] = v.y; w[pr][4 * r4 + 2] = v.z; w[pr][4 * r4 + 3] = v.w; } } }
    const int ntiles = (t0 + 16 + 31) >> 5;
    { LAS u32x4* z = (LAS u32x4*)lds;
#pragma unroll
        for (int i = 0; i < 16; ++i) z[tid + 512 * i] = (u32x4){0u, 0u, 0u, 0u}; }
    __syncthreads();
    const int rowlen = ntiles * 32;
    float* SCu = (float*)(p.ws + WS_SC) + (size_t)((unit & 1) ? ((unit >> 1) + 1) * ((unit >> 1) + 1) : (unit >> 1) * ((unit >> 1) + 1)) * 512;
    idx_pass<1>(KI, a, w, t0g, ntiles, kq, lane, hist, qbase, tbv, candcnt, bm, cand_key, cand_idx, SCu, rowlen);
    __syncthreads();
    if (STAGES == 1) return;
#pragma unroll 1
    for (int i = 0; i < 2; ++i) {
        const int q = 2 * wave + i; const LAS unsigned* H = hist + q * 2048;
        unsigned sL = 0u;
#pragma unroll 8
        for (int k = 0; k < 32; ++k) { const unsigned v = H[2047 - 32 * lane - ((k + lane) & 31)]; sL += (v & 0xffffu) + (v >> 16); }
        unsigned Pf = sL;
#pragma unroll
        for (int o = 1; o < 64; o <<= 1) { const unsigned tt = __shfl_up(Pf, o); if (lane >= o) Pf += tt; }
        const unsigned total = __shfl(Pf, 63);
        int tbq = -1; unsigned ab = 0u;
        if (total >= (unsigned)NSEL) {
            const unsigned long long m1 = __ballot(Pf >= (unsigned)NSEL); const int Ls = __builtin_ctzll(m1);
            const unsigned ab0 = __shfl(Pf, Ls) - __shfl(sL, Ls);
            const int bin = 4095 - 64 * Ls - lane; const unsigned wv = H[bin >> 1]; const unsigned c = (bin & 1) ? (wv >> 16) : (wv & 0xffffu);
            unsigned Pc = c;
#pragma unroll
            for (int o = 1; o < 64; o <<= 1) { const unsigned tt = __shfl_up(Pc, o); if (lane >= o) Pc += tt; }
            const unsigned long long m2 = __ballot(ab0 + Pc >= (unsigned)NSEL); const int l2 = __builtin_ctzll(m2);
            tbq = 4095 - 64 * Ls - l2; ab = ab0 + __shfl(Pc, l2) - __shfl(c, l2);
        }
        if (lane == 0) { tbv[q] = tbq; above[q] = ab; candcnt[q] = 0u; }
    }
    __syncthreads();
    {
        const int q0 = 2 * wave; const int tb0 = tbv[q0], tb1 = tbv[q0 + 1];
        const float* row0 = SCu + q0 * rowlen; const float* row1 = row0 + rowlen;
        const int nch = (rowlen + 255) >> 8; unsigned cnt0 = 0u, cnt1 = 0u;
        const unsigned long long ltm = (1ull << lane) - 1ull;
        const int sh4 = 4 * (lane & 7);
#pragma unroll 1
        for (int c0 = 0; c0 < nch; c0 += 16) {
            f32x4 v0[16], v1[16];
#pragma unroll
            for (int j = 0; j < 16; ++j) { const int key = 256 * (c0 + j) + 4 * lane; const int kc = key < rowlen ? key : rowlen - 4; v0[j] = *(const f32x4*)(row0 + kc); v1[j] = *(const f32x4*)(row1 + kc); }
#pragma unroll
            for (int j = 0; j < 16; ++j) {
                if (c0 + j < nch) {
                    const int key = 256 * (c0 + j) + 4 * lane;
#pragma unroll
                    for (int rr = 0; rr < 2; ++rr) {
                        const int tq = t0 + q0 + rr, tb = rr ? tb1 : tb0, q = q0 + rr; const f32x4 vv = rr ? v1[j] : v0[j];
                        unsigned nb = 0u, cadd = 0u;
#pragma unroll
                        for (int e4 = 0; e4 < 4; ++e4) {
                            const float sv = vv[e4]; const unsigned ok = ordkey(sv); const int bin = (int)(ok >> 20); const bool valid = key + e4 <= tq;
                            nb |= (valid && bin > tb) ? (1u << e4) : 0u;
                            const bool cd = valid && bin == tb; const unsigned long long cm = __ballot(cd);
                            if (cd) { const unsigned slot = (rr ? cnt1 : cnt0) + cadd + (unsigned)__popcll(cm & ltm); if (slot < (unsigned)IX_CAP) { cand_key[q * IX_CAP + slot] = ok; cand_idx[q * IX_CAP + slot] = (unsigned short)(key + e4); } }
                            cadd += (unsigned)__popcll(cm);
                        }
                        if (rr) cnt1 += cadd; else cnt0 += cadd;
                        unsigned wd = nb << sh4;
                        wd |= (unsigned)__builtin_amdgcn_update_dpp(0, (int)wd, 0xB1, 0xF, 0xF, true);
                        wd |= (unsigned)__builtin_amdgcn_update_dpp(0, (int)wd, 0x4E, 0xF, 0xF, true);
                        wd |= (unsigned)__builtin_amdgcn_update_dpp(0, (int)wd, 0x141, 0xF, 0xF, true);
                        if ((lane & 7) == 0) bm[q * 256 + 8 * (c0 + j) + (lane >> 3)] = wd;
                    }
                }
            }
        }
        if (lane == 0) { candcnt[q0] = cnt0; candcnt[q0 + 1] = cnt1; }
    }
    __syncthreads();
    if (STAGES == 2) return;
#pragma unroll 1
    for (int i = 0; i < 2; ++i) {
        const int q = 2 * wave + i; const int t = t0 + q;
        const int nc = (int)min(candcnt[q], (unsigned)IX_CAP); const int tbq = tbv[q];
        const int need = (tbq >= 0) ? (NSEL - (int)above[q]) : 0;
        const LAS unsigned* ck = cand_key + q * IX_CAP; const LAS unsigned short* ci = cand_idx + q * IX_CAP;
        if (need > 0) {
            unsigned prefix = 0u; int kk = need;
            for (int bit = 19; bit >= 0; --bit) { const unsigned want = (prefix >> bit) | 1u; int cnt = 0;
                for (int c0 = 0; c0 < nc; c0 += 64) { const int c = c0 + lane; const bool hit = c < nc && (((ck[c] & 0xfffffu) >> bit) == want); cnt += __popcll(__ballot(hit)); }
                if (cnt >= kk) prefix |= (1u << bit); else kk -= cnt; }
            int neq = 0;
            for (int c0 = 0; c0 < nc; c0 += 64) { const int c = c0 + lane; neq += __popcll(__ballot(c < nc && (ck[c] & 0xfffffu) == prefix)); }
            for (int c0 = 0; c0 < nc; c0 += 64) { const int c = c0 + lane; const bool act = c < nc;
                const unsigned mk = act ? (ck[c] & 0xfffffu) : 0u; const unsigned mi = act ? ci[c] : 0u;
                bool take = act && mk > prefix;
                if (neq == kk) take = take || (act && mk == prefix);
                else if (__ballot(act && mk == prefix)) { int rank = 0;
                    for (int j = 0; j < nc; ++j) rank += ((ck[j] & 0xfffffu) == prefix && (unsigned)ci[j] < mi) ? 1 : 0;
                    take = take || (act && mk == prefix && rank < kk); }
                if (take) lds_or(bm + q * 256 + (mi >> 5), 1u << (mi & 31)); }
        }
        asm volatile("s_waitcnt lgkmcnt(0)" ::: "memory");
        unsigned v[4]; int cn = 0;
#pragma unroll
        for (int k = 0; k < 4; ++k) { const int wd = 4 * lane + k; v[k] = (wd < ntiles) ? bm[q * 256 + wd] : 0u; cn += __popc(v[k]); }
        int incl = cn;
#pragma unroll
        for (int o = 1; o < 64; o <<= 1) { const int tt = __shfl_up(incl, o); if (lane >= o) incl += tt; }
        const int total = __shfl(incl, 63); int pos = incl - cn;
        int* sel = (int*)(p.ws + WS_SEL) + (size_t)t * NSEL;
#pragma unroll
        for (int k = 0; k < 4; ++k) { unsigned x = v[k]; while (x) { const int b = __builtin_ctz(x); x &= x - 1u; if (pos < NSEL) sel[pos] = 32 * (4 * lane + k) + b; ++pos; } }
#pragma unroll
        for (int k = 0; k < 4; ++k) { const int ps = lane + 64 * k; if (ps >= total) sel[ps] = -1; }
    }
    __syncthreads();
}
template <int STAGES> __device__ __forceinline__ void phase_idx_topk(const P& p, LAS unsigned char* lds, int cstage) {
    const int tid = otid(), bid = obid();
    const int G8 = (int)gridDim.x * 8, ccount = cstage >= 0 ? conv_count(cstage) : 0, R = (ccount + G8 - 1) / G8;
    int r = 0, slot = 0;
    for (int pi = bid; pi < 256; pi += (int)gridDim.x) {
#pragma unroll 1
        for (int half = 0; half < 2; ++half) {
            idx_unit<STAGES>(p, lds, half ? 511 - pi : pi, tid);
            ++slot; const int rend = (pi + (int)gridDim.x < 256 || half == 0) ? min(R, (R * slot + 1) / 2) : R;
            if (r < rend) {
                const int t2 = otid(), lane = t2 & 63, wave = __builtin_amdgcn_readfirstlane(t2 >> 6);
                for (; r < rend; ++r) { const int j = (r * (int)gridDim.x + bid) * 8 + wave; if (j < ccount) conv_item<true>(p, (LAS float*)(lds + wave * 16384), conv_map(cstage, j), lane); }
                __syncthreads();
            }
        }
    }
}

__device__ __forceinline__ void phase_dsa_attn(const P& p, LAS unsigned char* lds) {
    const int tid = otid(), lane = tid & 63, wave = __builtin_amdgcn_readfirstlane(tid >> 6), bid = obid();
    const int n = lane & 15, kq = lane >> 4;
    LAS unsigned char* Pl = lds + wave * 9216;
    LAS int* sl = (LAS int*)(Pl + 8192);
    const f16_t* Qb = (const f16_t*)(p.ws + WS_Q); const f16_t* Kb = (const f16_t*)(p.ws + WS_K); const f16_t* Vb = (const f16_t*)(p.ws + WS_V);
    const int* SELb = (const int*)(p.ws + WS_SEL); f16_t* Ob = (f16_t*)(p.ws + WS_O);
    const float scale = 0.08838834764831845f;
    for (int t = bid * 8 + wave; t < S_; t += (int)gridDim.x * 8) {
        { const u32x4 v = *(const u32x4*)(SELb + (size_t)t * NSEL + 4 * lane); *(LAS u32x4*)(sl + 4 * lane) = v; }
        f16x8 A[16];
        { const f16_t* qp = Qb + (size_t)t * 2048 + n * 128 + 8 * kq; f16x8 qr[4]; f16x8 zero;
#pragma unroll
            for (int j = 0; j < 8; ++j) zero[j] = (_Float16)0.f;
#pragma unroll
            for (int s4 = 0; s4 < 4; ++s4) qr[s4] = *(const f16x8*)(qp + 32 * s4);
#pragma unroll
            for (int s = 0; s < 16; ++s) A[s] = ((n >> 2) == (s >> 2)) ? qr[s & 3] : zero; }
        asm volatile("s_waitcnt lgkmcnt(0)" ::: "memory");
        f32x4 Sg[16];
#pragma unroll
        for (int tile = 0; tile < 16; ++tile) {
            const int key = sl[16 * tile + n]; const bool valid = key >= 0; const int kc = valid ? key : 0;
            const f16_t* kp = Kb + (size_t)kc * 512 + 8 * kq;
            f32x4 c = {0.f, 0.f, 0.f, 0.f};
#pragma unroll
            for (int s = 0; s < 16; ++s) { const f16x8 b = *(const f16x8*)(kp + 32 * s); c = __builtin_amdgcn_mfma_f32_16x16x32_f16(A[s], b, c, 0, 0, 0); }
#pragma unroll
            for (int i = 0; i < 4; ++i) Sg[tile][i] = valid ? c[i] * scale : -INFINITY;
        }
        float mx[4], lsum[4];
#pragma unroll
        for (int i = 0; i < 4; ++i) { float m = Sg[0][i];
#pragma unroll
            for (int tile = 1; tile < 16; ++tile) m = fmaxf(m, Sg[tile][i]);
            m = fmaxf(m, __shfl_xor(m, 1)); m = fmaxf(m, __shfl_xor(m, 2)); m = fmaxf(m, __shfl_xor(m, 4)); m = fmaxf(m, __shfl_xor(m, 8)); mx[i] = m; lsum[i] = 0.f; }
#pragma unroll
        for (int tile = 0; tile < 16; ++tile) { float pv[4];
#pragma unroll
            for (int i = 0; i < 4; ++i) { pv[i] = __expf(Sg[tile][i] - mx[i]); lsum[i] += pv[i]; }
            u32x2 w; w.x = pk_f16(pv[0], pv[1]); w.y = pk_f16(pv[2], pv[3]);
            *(LAS u32x2*)(Pl + (16 * tile + n) * 32 + kq * 8) = w; }
        float inv[4];
#pragma unroll
        for (int i = 0; i < 4; ++i) { float l = lsum[i]; l += __shfl_xor(l, 1); l += __shfl_xor(l, 2); l += __shfl_xor(l, 4); l += __shfl_xor(l, 8); inv[i] = 1.0f / l; }
        asm volatile("s_waitcnt lgkmcnt(0)" ::: "memory");
        float acc[4][8];
#pragma unroll
        for (int r = 0; r < 4; ++r)
#pragma unroll
            for (int j = 0; j < 8; ++j) acc[r][j] = 0.f;
#pragma unroll 8
        for (int k = 0; k < NSEL; ++k) {
            const int key = __builtin_amdgcn_readfirstlane(sl[k]); const int kc = key < 0 ? 0 : key;
            const f16x8 v = *(const f16x8*)(Vb + (size_t)kc * 512 + 8 * lane);
            const f16x4 pr = *(const LAS f16x4*)(Pl + k * 32 + kq * 8);
#pragma unroll
            for (int r = 0; r < 4; ++r)
#pragma unroll
                for (int j = 0; j < 8; ++j) acc[r][j] = __builtin_fmaf((float)pr[r], (float)v[j], acc[r][j]);
        }
#pragma unroll
        for (int r = 0; r < 4; ++r) { u32x4 o; o.x = pk_f16(acc[r][0] * inv[r], acc[r][1] * inv[r]); o.y = pk_f16(acc[r][2] * inv[r], acc[r][3] * inv[r]);
            o.z = pk_f16(acc[r][4] * inv[r], acc[r][5] * inv[r]); o.w = pk_f16(acc[r][6] * inv[r], acc[r][7] * inv[r]);
            *(u32x4*)(Ob + (size_t)t * 2048 + (4 * kq + r) * 128 + 8 * n) = o; }
        asm volatile("s_waitcnt lgkmcnt(0)" ::: "memory");
    }
}

typedef short s16x4 __attribute__((ext_vector_type(4)));
__device__ __forceinline__ unsigned off_b(unsigned row, unsigned ch) { return 256u * row + 16u * (ch ^ (((row & 3u) << 2) | ((row >> 2) & 3u))); }
__device__ __forceinline__ f16x4 tr16(const LAS unsigned char* p) { return __builtin_bit_cast(f16x4, __builtin_amdgcn_ds_read_tr16_b64_v4i16((LAS s16x4*)p)); }
__device__ __forceinline__ int crow(int i, int h) { return (i & 3) + 8 * (i >> 2) + 4 * h; }
__device__ __forceinline__ void phase_moba_kmean(const P& p) {
    const int tid_ = otid(); const int sub = tid_ >> 7, d = tid_ & 127;
    for (int it = obid() * 4 + sub; it < 512; it += (int)gridDim.x * 4) {
        const int n = it >> 4, h = it & 15; const f16_t* K = (const f16_t*)(p.ws + WS_K) + (size_t)n * 256 * 2048 + h * 128 + d;
        float s = 0.f; for (int i = 0; i < 256; ++i) s += h2f(K[(size_t)i * 2048]);
        s *= (1.0f / 256.0f);
        const _Float16 hi = (_Float16)s; const _Float16 lo = (_Float16)(s - (float)hi);
        ((_Float16*)(p.ws + WS_KMH))[((size_t)h * 32 + n) * 128 + d] = hi; ((_Float16*)(p.ws + WS_KML))[((size_t)h * 32 + n) * 128 + d] = lo; }
}
__device__ __forceinline__ void phase_moba_gate(const P& p, int lb) {
    const int tid = otid(), lane = tid & 63, wave = __builtin_amdgcn_readfirstlane(tid >> 6), bid = obid();
    const int r = lane & 31, hh = lane >> 5;
    const f16_t* Qb = (const f16_t*)(p.ws + WS_Q); const float* KS = (const float*)(p.ws + WS_KSUM) + (size_t)lb * 65536;
    unsigned* SEL3 = (unsigned*)(p.ws + WS_SEL3); unsigned short* LIST = (unsigned short*)(p.ws + WS_LIST); unsigned* CNT = (unsigned*)(p.ws + WS_CTL) + CW_MCNT + lb * 512;
    for (int it = bid * 8 + wave; it < 256 * 16; it += (int)gridDim.x * 8) {
        const int qt = it >> 4, h = it & 15, t = qt * 32 + r, j = t >> 8;
        f32x16 g;
#pragma unroll
        for (int i = 0; i < 16; ++i) g[i] = 0.f;
        const f16_t* qp = Qb + (size_t)t * 2048 + h * 128 + 8 * hh; const float* kp = KS + ((size_t)h * 32 + r) * 128 + 8 * hh;
#pragma unroll
        for (int st = 0; st < 8; ++st) { const f16x8 qf = *(const f16x8*)(qp + 16 * st);
            const f32x4 k0 = *(const f32x4*)(kp + 16 * st) * (1.0f / 256.0f), k1 = *(const f32x4*)(kp + 16 * st + 4) * (1.0f / 256.0f);
            f16x8 kh, kl;
#pragma unroll
            for (int e = 0; e < 4; ++e) { kh[e] = (_Float16)k0[e]; kl[e] = (_Float16)(k0[e] - (float)kh[e]); kh[4 + e] = (_Float16)k1[e]; kl[4 + e] = (_Float16)(k1[e] - (float)kh[4 + e]); }
            g = __builtin_amdgcn_mfma_f32_32x32x16_f16(kh, qf, g, 0, 0, 0);
            g = __builtin_amdgcn_mfma_f32_32x32x16_f16(kl, qf, g, 0, 0, 0); }
        float bv[3] = {-INFINITY, -INFINITY, -INFINITY}; int bi[3] = {255, 255, 255};
#pragma unroll
        for (int i = 0; i < 16; ++i) { const int n = crow(i, hh); const float v = (n < j) ? g[i] : -INFINITY;
            const bool b0 = v > bv[0] || (v == bv[0] && n < bi[0]), b1 = v > bv[1] || (v == bv[1] && n < bi[1]), b2 = v > bv[2] || (v == bv[2] && n < bi[2]);
            if (n < j) {
                if (b0) { bv[2] = bv[1]; bi[2] = bi[1]; bv[1] = bv[0]; bi[1] = bi[0]; bv[0] = v; bi[0] = n; }
                else if (b1) { bv[2] = bv[1]; bi[2] = bi[1]; bv[1] = v; bi[1] = n; }
                else if (b2) { bv[2] = v; bi[2] = n; } } }
        float ov[3]; int oi[3];
#pragma unroll
        for (int k = 0; k < 3; ++k) { ov[k] = __shfl_xor(bv[k], 32); oi[k] = __shfl_xor(bi[k], 32); }
        int sel[3]; { int ia = 0, ib = 0;
#pragma unroll
            for (int k = 0; k < 3; ++k) { const float av = ia == 0 ? bv[0] : (ia == 1 ? bv[1] : bv[2]); const int ai = ia == 0 ? bi[0] : (ia == 1 ? bi[1] : bi[2]);
                const float cv = ib == 0 ? ov[0] : (ib == 1 ? ov[1] : ov[2]); const int ci = ib == 0 ? oi[0] : (ib == 1 ? oi[1] : oi[2]);
                const bool ta = av > cv || (av == cv && ai < ci);
                sel[k] = ta ? ai : ci; if (ta) ++ia; else ++ib; } }
        if (hh == 0) SEL3[(size_t)t * 16 + h] = (unsigned)sel[0] | ((unsigned)sel[1] << 8) | ((unsigned)sel[2] << 16);
        {
            int off0 = 0, off1 = 0, off2 = 0; unsigned mytot = 0u; const unsigned ltm = (1u << r) - 1u;
            for (int nb = 0; nb < j; ++nb) {
                const unsigned m0 = (unsigned)__ballot(sel[0] == nb), m1 = (unsigned)__ballot(sel[1] == nb), m2 = (unsigned)__ballot(sel[2] == nb);
                const int c0 = __popc(m0), c1 = __popc(m1), c2 = __popc(m2);
                if (sel[0] == nb) off0 = __popc(m0 & ltm);
                if (sel[1] == nb) off1 = c0 + __popc(m1 & ltm);
                if (sel[2] == nb) off2 = c0 + c1 + __popc(m2 & ltm);
                if (r == nb) mytot = (unsigned)(c0 + c1 + c2);
            }
            unsigned base = 0u;
            if (hh == 0 && mytot != 0u) base = atomicAdd(CNT + h * 32 + r, mytot);
#pragma unroll
            for (int k = 0; k < 3; ++k) { const int b = sel[k]; const unsigned bb = (unsigned)__shfl((int)base, b & 31); const int off = k == 0 ? off0 : (k == 1 ? off1 : off2);
                if (hh == 0 && b != 255) LIST[((size_t)h * 32 + b) * 8192 + bb + off] = (unsigned short)(t | (k << 13)); }
        }
    }
}
template <bool CAUSAL>
__device__ __forceinline__ void moba_core(const f16x8 (&qf)[8], const LAS unsigned char* Kimg, const LAS unsigned char* Vimg, int lane, int ntile, int qin, float& m, float& l, f32x16 (&o)[4]) {
    const int r = lane & 31, hh = lane >> 5, blk = (lane >> 4) & 1, q4 = (lane & 15) >> 2, p4 = lane & 3;
    const float scale = 0.08838834764831845f;
    unsigned ka[8], va[4][2][2];
#pragma unroll
    for (int st = 0; st < 8; ++st) ka[st] = off_b(r, 2 * st + hh);
#pragma unroll
    for (int c = 0; c < 4; ++c)
#pragma unroll
        for (int s2 = 0; s2 < 2; ++s2)
#pragma unroll
            for (int t2 = 0; t2 < 2; ++t2) va[c][s2][t2] = off_b(16 * s2 + 8 * t2 + 4 * hh + q4, 4 * c + 2 * blk + (p4 >> 1)) + 8 * (p4 & 1);
    m = -INFINITY; l = 0.f;
#pragma unroll
    for (int c = 0; c < 4; ++c)
#pragma unroll
        for (int i = 0; i < 16; ++i) o[c][i] = 0.f;
    for (int kt = 0; kt < ntile; ++kt) {
        const LAS unsigned char* Kt = Kimg + kt * 8192; const LAS unsigned char* Vt = Vimg + kt * 8192;
        f32x16 sT;
#pragma unroll
        for (int i = 0; i < 16; ++i) sT[i] = 0.f;
#pragma unroll
        for (int st = 0; st < 8; ++st) sT = __builtin_amdgcn_mfma_f32_32x32x16_f16(*(const LAS f16x8*)(Kt + ka[st]), qf[st], sT, 0, 0, 0);
        float tmax = -INFINITY;
#pragma unroll
        for (int i = 0; i < 16; ++i) { float v = sT[i] * scale; if (CAUSAL) { if (32 * kt + crow(i, hh) > qin) v = -INFINITY; } sT[i] = v; tmax = fmaxf(tmax, v); }
        tmax = fmaxf(tmax, __shfl_xor(tmax, 32));
        const float mn = fmaxf(m, tmax);
        const float alpha = __expf(m - mn); m = mn;
        float ps = 0.f; f16x8 pf[2];
#pragma unroll
        for (int i = 0; i < 16; ++i) { const float e = __expf(sT[i] - mn); ps += e; pf[i >> 3][i & 7] = (_Float16)e; }
        l = l * alpha + ps;
#pragma unroll
        for (int c = 0; c < 4; ++c) {
#pragma unroll
            for (int i = 0; i < 16; ++i) o[c][i] *= alpha;
#pragma unroll
            for (int s2 = 0; s2 < 2; ++s2) { const f16x4 v0 = tr16(Vt + va[c][s2][0]), v1 = tr16(Vt + va[c][s2][1]);
                const f16x8 vf = __builtin_shufflevector(v0, v1, 0, 1, 2, 3, 4, 5, 6, 7);
                o[c] = __builtin_amdgcn_mfma_f32_32x32x16_f16(vf, pf[s2], o[c], 0, 0, 0); } }
    }
    l += __shfl_xor(l, 32);
}
__device__ __forceinline__ void moba_load_kv(const P& p, LAS unsigned char* lds, int h, int n, int tid) {
    const f16_t* Kg = (const f16_t*)(p.ws + WS_K) + (size_t)n * 256 * 2048 + h * 128; const f16_t* Vg = (const f16_t*)(p.ws + WS_V) + (size_t)n * 256 * 2048 + h * 128;
    u32x4 kr[8], vr[8];
#pragma unroll
    for (int i = 0; i < 8; ++i) { const int cid = tid + 512 * i, row = cid >> 4, ch = cid & 15;
        kr[i] = *(const u32x4*)(Kg + (size_t)row * 2048 + 8 * ch); vr[i] = *(const u32x4*)(Vg + (size_t)row * 2048 + 8 * ch); }
    __builtin_amdgcn_sched_barrier(0);
#pragma unroll
    for (int i = 0; i < 8; ++i) { const int cid = tid + 512 * i, row = cid >> 4, ch = cid & 15;
        *(LAS u32x4*)(lds + off_b(row, ch)) = kr[i]; *(LAS u32x4*)(lds + 65536 + off_b(row, ch)) = vr[i]; }
}
__device__ __forceinline__ void phase_moba_past(const P& p, LAS unsigned char* lds, int lb) {
    const int tid = otid(), lane = tid & 63, wave = __builtin_amdgcn_readfirstlane(tid >> 6), bid = obid();
    const int r = lane & 31, hh = lane >> 5;
    LAS int* start = (LAS int*)(lds + LDS_MISC + 1024);
    const unsigned* CNT = (const unsigned*)(p.ws + WS_CTL) + CW_MCNT + lb * 512;
    const unsigned short* LIST = (const unsigned short*)(p.ws + WS_LIST); const f16_t* Qb = (const f16_t*)(p.ws + WS_Q);
    f16_t* PO = (f16_t*)(p.ws + WS_PO); float* PML = (float*)(p.ws + WS_PML);
    { const int c = ((int)__hip_atomic_load(CNT + tid, __ATOMIC_RELAXED, __HIP_MEMORY_SCOPE_AGENT) + 255) >> 8; int incl = c;
#pragma unroll
        for (int o = 1; o < 64; o <<= 1) { const int tt = __shfl_up(incl, o); if (lane >= o) incl += tt; }
        LAS int* wsum = (LAS int*)(lds + LDS_MISC + 512);
        if (lane == 63) wsum[wave] = incl;
        __syncthreads();
        int base = 0;
#pragma unroll
        for (int w2 = 0; w2 < 8; ++w2) base += (w2 < wave) ? wsum[w2] : 0;
        start[tid] = base + incl - c; if (tid == 511) start[512] = base + incl;
        __syncthreads(); }
    const int total = start[512];
    const int ipw = (total + (int)gridDim.x - 1) / (int)gridDim.x, it0 = bid * ipw, it1 = (it0 + ipw < total) ? it0 + ipw : total;
    int cur = 0, loaded = -1;
    for (int it = it0; it < it1; ++it) {
        while (start[cur + 1] <= it) ++cur;
        const int h = cur >> 5, n = cur & 31, ck = it - start[cur]; const int cnt = (int)CNT[cur] - 256 * ck;
        const bool reload = cur != loaded;
        if (reload) { __syncthreads();
            moba_load_kv(p, lds, h, n, tid); loaded = cur; }
        const int row0 = 32 * wave; const bool active = row0 < cnt;
        const int ri = (row0 + r < cnt) ? row0 + r : (active ? row0 : 0);
        const unsigned e = LIST[(size_t)cur * 8192 + 256 * ck + ri]; const int t = e & 0x1fff, slot = e >> 13;
        f16x8 qf[8];
        { const f16_t* qp = Qb + (size_t)t * 2048 + h * 128 + 8 * hh;
#pragma unroll
            for (int st = 0; st < 8; ++st) qf[st] = *(const f16x8*)(qp + 16 * st); }
        if (reload) __syncthreads();
        if (active) {
            float m, l; f32x16 o[4];
            moba_core<false>(qf, lds, lds + 65536, lane, 8, 0, m, l, o);
            if (row0 + r < cnt) {
                const float inv = 1.0f / l; const size_t pi = ((size_t)t * 16 + h) * 3 + slot;
                if (hh == 0) { PML[pi * 2] = m; PML[pi * 2 + 1] = l; }
#pragma unroll
                for (int c = 0; c < 4; ++c)
#pragma unroll
                    for (int g4 = 0; g4 < 4; ++g4) { u32x2 w; w.x = pk_f16(o[c][4 * g4] * inv, o[c][4 * g4 + 1] * inv); w.y = pk_f16(o[c][4 * g4 + 2] * inv, o[c][4 * g4 + 3] * inv);
                        *(u32x2*)(PO + pi * 128 + 32 * c + 8 * g4 + 4 * hh) = w; }
            }
        }
    }
}
__device__ __forceinline__ void phase_moba_own(const P& p, LAS unsigned char* lds) {
    const int tid = otid(), lane = tid & 63, wave = __builtin_amdgcn_readfirstlane(tid >> 6), bid = obid();
    const int r = lane & 31, hh = lane >> 5;
    const f16_t* Qb = (const f16_t*)(p.ws + WS_Q); const f16_t* PO = (const f16_t*)(p.ws + WS_PO); const float* PML = (const float*)(p.ws + WS_PML);
    const unsigned* SEL3 = (const unsigned*)(p.ws + WS_SEL3); f16_t* Ob = (f16_t*)(p.ws + WS_O);
    for (int it = bid; it < 512; it += (int)gridDim.x) {
        const int h = it & 15, j = it >> 4;
        __syncthreads();
        moba_load_kv(p, lds, h, j, tid);
        const int qin = 32 * wave + r, t = 256 * j + qin;
        f16x8 qf[8];
        { const f16_t* qp = Qb + (size_t)t * 2048 + h * 128 + 8 * hh;
#pragma unroll
            for (int st = 0; st < 8; ++st) qf[st] = *(const f16x8*)(qp + 16 * st); }
        __syncthreads();
        float m, l; f32x16 o[4];
        moba_core<true>(qf, lds, lds + 65536, lane, wave + 1, qin, m, l, o);
        const unsigned s3 = SEL3[(size_t)t * 16 + h];
        float ms[3], ls[3]; float M = m;
#pragma unroll
        for (int k = 0; k < 3; ++k) { const bool v = ((s3 >> (8 * k)) & 0xffu) != 0xffu; const size_t pi = ((size_t)t * 16 + h) * 3 + k;
            ms[k] = v ? PML[pi * 2] : -INFINITY; ls[k] = v ? PML[pi * 2 + 1] : 0.f; M = fmaxf(M, ms[k]); }
        const float w0 = l * __expf(m - M); float L = w0;
        const float a0 = __expf(m - M);
#pragma unroll
        for (int c = 0; c < 4; ++c)
#pragma unroll
            for (int i = 0; i < 16; ++i) o[c][i] *= a0;
#pragma unroll
        for (int k = 0; k < 3; ++k) { const float wk = ls[k] * __expf(ms[k] - M); L += wk;
            if (wk != 0.f) { const size_t pi = ((size_t)t * 16 + h) * 3 + k;
#pragma unroll
                for (int c = 0; c < 4; ++c)
#pragma unroll
                    for (int g4 = 0; g4 < 4; ++g4) { const u32x2 w = *(const u32x2*)(PO + pi * 128 + 32 * c + 8 * g4 + 4 * hh);
                        const unsigned wx = w.x, wy = w.y; const f16x2 x0 = __builtin_bit_cast(f16x2, wx), x1 = __builtin_bit_cast(f16x2, wy);
                        o[c][4 * g4] += wk * (float)x0[0]; o[c][4 * g4 + 1] += wk * (float)x0[1]; o[c][4 * g4 + 2] += wk * (float)x1[0]; o[c][4 * g4 + 3] += wk * (float)x1[1]; } } }
        const float inv = 1.0f / L;
#pragma unroll
        for (int c = 0; c < 4; ++c)
#pragma unroll
            for (int g4 = 0; g4 < 4; ++g4) { u32x2 w; w.x = pk_f16(o[c][4 * g4] * inv, o[c][4 * g4 + 1] * inv); w.y = pk_f16(o[c][4 * g4 + 2] * inv, o[c][4 * g4 + 3] * inv);
                *(u32x2*)(Ob + (size_t)t * 2048 + h * 128 + 32 * c + 8 * g4 + 4 * hh) = w; }
    }
}

__device__ __forceinline__ void phase_dsa_qk(const P& p, LAS unsigned char* lds, int la) {
    const int tid = otid(), lane = tid & 63, wave = __builtin_amdgcn_readfirstlane(tid >> 6);
    const int n = lane & 15, kq = lane >> 4;
    LAS unsigned char* Ki = lds + wave * 9216;
    LAS int* sl = (LAS int*)(Ki + 8192);
    LAS int* grab = (LAS int*)(lds + 8 * 9216);
    const f16_t* Qb = (const f16_t*)(p.ws + WS_Q); const f16_t* Kb = (const f16_t*)(p.ws + WS_K);
    const int* SELb = (const int*)(p.ws + WS_SEL); f16_t* PG = (f16_t*)(p.ws + WS_PO);
    unsigned* qhead = (unsigned*)(p.ws + WS_CTL) + CW_DSAQ + la * 512;
    const float scale = 0.08838834764831845f;
    const int xcc = (int)xb_xcc_id();
    unsigned wa[8], ra[2][4];
#pragma unroll
    for (int i2 = 0; i2 < 8; ++i2) wa[i2] = off_b(4 * i2 + kq, n);
#pragma unroll
    for (int rb = 0; rb < 2; ++rb)
#pragma unroll
        for (int s4 = 0; s4 < 4; ++s4) ra[rb][s4] = off_b(n + 16 * rb, 4 * s4 + kq);
    for (int gi = 0; gi < 4; ++gi) {
        const int g = (xcc + gi) & 3;
        const f16_t* Kg = Kb + (size_t)g * S_ * 128;
        for (;;) {
            __syncthreads();
            if (tid == 0) grab[0] = (int)atomicAdd(qhead + g * 64, 32u);
            __syncthreads();
            const int t0 = grab[0];
            if (t0 >= S_) break;
#pragma unroll 1
            for (int ti = 0; ti < 4; ++ti) {
            const int t = t0 + 8 * ti + wave;
            { const u32x4 v = __builtin_nontemporal_load((const u32x4*)(SELb + (size_t)t * NSEL + 4 * lane)); *(LAS u32x4*)(sl + 4 * lane) = v; }
            f16x8 A[4];
            { const f16_t* qp = Qb + (size_t)t * 2048 + (4 * g + (n & 3)) * 128 + 8 * kq;
#pragma unroll
                for (int s4 = 0; s4 < 4; ++s4) { const f16x8 qv = __builtin_nontemporal_load((const f16x8*)(qp + 32 * s4));
#pragma unroll
                    for (int j = 0; j < 8; ++j) A[s4][j] = (n < 4) ? qv[j] : (_Float16)0.f; } }
            asm volatile("s_waitcnt lgkmcnt(0)" ::: "memory");
            f32x4 Sg[16]; f16x8 vr[8];
#define QK_GATHER(st) do { _Pragma("unroll") for (int i2 = 0; i2 < 8; ++i2) { const int key_ = sl[32 * (st) + 4 * i2 + kq]; const unsigned kc_ = key_ < 0 ? 0u : (unsigned)key_; \
                vr[i2] = *(const f16x8*)((const char*)Kg + kc_ * 256u + 16u * (unsigned)n); } } while (0)
            QK_GATHER(0);
#pragma unroll
            for (int st = 0; st < 8; ++st) {
#pragma unroll
                for (int i2 = 0; i2 < 8; ++i2) *(LAS f16x8*)(Ki + wa[i2]) = vr[i2];
                __builtin_amdgcn_sched_barrier(0);
                if (st + 1 < 8) QK_GATHER(st + 1);
                __builtin_amdgcn_sched_barrier(0);
#pragma unroll
                for (int rb = 0; rb < 2; ++rb) { f32x4 c = {0.f, 0.f, 0.f, 0.f};
#pragma unroll
                    for (int s4 = 0; s4 < 4; ++s4) c = __builtin_amdgcn_mfma_f32_16x16x32_f16(A[s4], *(const LAS f16x8*)(Ki + ra[rb][s4]), c, 0, 0, 0);
                    const bool valid = sl[32 * st + 16 * rb + n] >= 0;
#pragma unroll
                    for (int i = 0; i < 4; ++i) Sg[2 * st + rb][i] = (valid && kq == 0) ? c[i] * scale : -INFINITY; }
                asm volatile("s_waitcnt lgkmcnt(0)" ::: "memory");
                __builtin_amdgcn_sched_barrier(0);
            }
#undef QK_GATHER
            float mx[4], lsum[4];
#pragma unroll
            for (int i = 0; i < 4; ++i) { float m = Sg[0][i];
#pragma unroll
                for (int tile = 1; tile < 16; ++tile) m = fmaxf(m, Sg[tile][i]);
                mx[i] = wave_max(m); lsum[i] = 0.f; }
#pragma unroll
            for (int tile = 0; tile < 16; ++tile)
#pragma unroll
                for (int i = 0; i < 4; ++i) { Sg[tile][i] = __expf(Sg[tile][i] - mx[i]); lsum[i] += Sg[tile][i]; }
            float inv[4];
#pragma unroll
            for (int i = 0; i < 4; ++i) inv[i] = 1.0f / wave_sum(lsum[i]);
            { _Float16* pg = (_Float16*)PG + ((size_t)t * 4 + g) * 1024 + kq * 256 + n;
#pragma unroll
                for (int tile = 0; tile < 16; ++tile) { const float p0 = __shfl(Sg[tile][0] * inv[0], n), p1 = __shfl(Sg[tile][1] * inv[1], n), p2 = __shfl(Sg[tile][2] * inv[2], n), p3 = __shfl(Sg[tile][3] * inv[3], n);
                    const float pm = kq == 0 ? p0 : (kq == 1 ? p1 : (kq == 2 ? p2 : p3)); pg[16 * tile] = (_Float16)pm; } }
            asm volatile("s_waitcnt lgkmcnt(0)" ::: "memory");
            }
        }
    }
}
__device__ __forceinline__ void phase_dsa_pv(const P& p, LAS unsigned char* lds, int la) {
    const int tid = otid(), lane = tid & 63, wave = __builtin_amdgcn_readfirstlane(tid >> 6);
    const int n = lane & 15, kq = lane >> 4;
    LAS unsigned char* Vi = lds + wave * 10240;
    LAS int* sl = (LAS int*)(Vi + 8192);
    LAS _Float16* ost = (LAS _Float16*)(Vi + 9216);
    LAS int* grab = (LAS int*)(lds + 8 * 10240);
    const f16_t* Vb = (const f16_t*)(p.ws + WS_V); const int* SELb = (const int*)(p.ws + WS_SEL); const f16_t* PG = (const f16_t*)(p.ws + WS_PO); f16_t* Ob = (f16_t*)(p.ws + WS_O);
    unsigned* qhead = (unsigned*)(p.ws + WS_CTL) + CW_DSAQ + la * 512 + 256;
    const int xcc = (int)xb_xcc_id();
    unsigned wa[8], ta[8][2];
#pragma unroll
    for (int i2 = 0; i2 < 8; ++i2) wa[i2] = off_b(4 * i2 + kq, n);
    { const unsigned q4 = (lane & 15) >> 2, p4 = lane & 3;
#pragma unroll
        for (int c = 0; c < 8; ++c)
#pragma unroll
            for (int t2 = 0; t2 < 2; ++t2) ta[c][t2] = off_b(8 * kq + 4 * t2 + q4, 2 * c + (p4 >> 1)) + 8 * (p4 & 1); }
    for (int gi = 0; gi < 4; ++gi) {
        const int g = (xcc + gi) & 3;
        const f16_t* Vg = Vb + (size_t)g * S_ * 128;
        for (;;) {
            __syncthreads();
            if (tid == 0) grab[0] = (int)atomicAdd(qhead + g * 64, 32u);
            __syncthreads();
            const int t0 = grab[0];
            if (t0 >= S_) break;
#pragma unroll 1
            for (int ti = 0; ti < 4; ++ti) {
            const int t = t0 + 8 * ti + wave;
            { const u32x4 v = __builtin_nontemporal_load((const u32x4*)(SELb + (size_t)t * NSEL + 4 * lane)); *(LAS u32x4*)(sl + 4 * lane) = v; }
            f16x8 A[8];
            { const f16_t* pg = PG + ((size_t)t * 4 + g) * 1024 + (n & 3) * 256 + 8 * kq;
#pragma unroll
                for (int st = 0; st < 8; ++st) { const f16x8 pv = __builtin_nontemporal_load((const f16x8*)(pg + 32 * st));
#pragma unroll
                    for (int j = 0; j < 8; ++j) A[st][j] = (n < 4) ? pv[j] : (_Float16)0.f; } }
            asm volatile("s_waitcnt lgkmcnt(0)" ::: "memory");
            f32x4 acc[8];
#pragma unroll
            for (int c = 0; c < 8; ++c) acc[c] = (f32x4){0.f, 0.f, 0.f, 0.f};
            f16x8 vr[8];
#define PV_GATHER(st) do { _Pragma("unroll") for (int i2 = 0; i2 < 8; ++i2) { const int key_ = sl[32 * (st) + 4 * i2 + kq]; const unsigned kc_ = key_ < 0 ? 0u : (unsigned)key_; \
                vr[i2] = *(const f16x8*)((const char*)Vg + kc_ * 256u + 16u * (unsigned)n); } } while (0)
            PV_GATHER(0);
#pragma unroll 1
            for (int st = 0; st < 8; ++st) {
#pragma unroll
                for (int i2 = 0; i2 < 8; ++i2) *(LAS f16x8*)(Vi + wa[i2]) = vr[i2];
                __builtin_amdgcn_sched_barrier(0);
                if (st + 1 < 8) PV_GATHER(st + 1);
                __builtin_amdgcn_sched_barrier(0);
                const f16x8 a = st == 0 ? A[0] : (st == 1 ? A[1] : (st == 2 ? A[2] : (st == 3 ? A[3] : (st == 4 ? A[4] : (st == 5 ? A[5] : (st == 6 ? A[6] : A[7]))))));
#pragma unroll
                for (int c = 0; c < 8; ++c) { const f16x4 v0 = tr16(Vi + ta[c][0]), v1 = tr16(Vi + ta[c][1]);
                    const f16x8 b = __builtin_shufflevector(v0, v1, 0, 1, 2, 3, 4, 5, 6, 7);
                    acc[c] = __builtin_amdgcn_mfma_f32_16x16x32_f16(a, b, acc[c], 0, 0, 0); }
                asm volatile("s_waitcnt lgkmcnt(0)" ::: "memory");
                __builtin_amdgcn_sched_barrier(0);
            }
#undef PV_GATHER
            if (kq == 0) {
#pragma unroll
                for (int c = 0; c < 8; ++c)
#pragma unroll
                    for (int i = 0; i < 4; ++i) ost[i * 128 + 16 * c + n] = (_Float16)acc[c][i]; }
            asm volatile("s_waitcnt lgkmcnt(0)" ::: "memory");
            { const u32x4 o = *(const LAS u32x4*)((const LAS unsigned char*)ost + 16 * lane);
              __builtin_nontemporal_store(o, (u32x4*)(Ob + (size_t)t * 2048 + (4 * g) * 128 + 8 * lane)); }
            asm volatile("s_waitcnt lgkmcnt(0)" ::: "memory");
            }
        }
    }
}

__device__ __forceinline__ void side_gemm_kiwi(const P& p, LAS unsigned char* lds, int li) {
    const int tid = otid(), lane = tid & 63, wave = __builtin_amdgcn_readfirstlane(tid >> 6), bid = obid();
    const int n = lane & 15, kq = lane >> 4;
    const f16_t* H = (const f16_t*)(p.ws + WS_H); const f16_t* Wt = (const f16_t*)(p.ws + WS_WAIN) + (size_t)li * A_INP * D_ + (size_t)4096 * D_;
    const float* rope = (const float*)(p.ws + WS_ROPE); const float* rcI = rope + S_ * 32; const float* rsI = rope + S_ * 40;
    f16_t* KI = (f16_t*)(p.ws + WS_KI); float* WI = (float*)(p.ws + WS_WI);
    LAS float* part = (LAS float*)lds;
    LAS float* fin = (LAS float*)(lds + 81920);
    for (int rb = bid; rb < S_ / 32; rb += (int)gridDim.x) {
        const int row0 = 32 * rb;
        f32x4 c[2][5];
#pragma unroll
        for (int mt = 0; mt < 2; ++mt)
#pragma unroll
            for (int nt = 0; nt < 5; ++nt) c[mt][nt] = (f32x4){0.f, 0.f, 0.f, 0.f};
#pragma unroll 2
        for (int ks = 8 * wave; ks < 8 * wave + 8; ++ks) {
            f16x8 a[2], b[5];
#pragma unroll
            for (int mt = 0; mt < 2; ++mt) a[mt] = *(const f16x8*)(H + (size_t)(row0 + 16 * mt + n) * D_ + 32 * ks + 8 * kq);
#pragma unroll
            for (int nt = 0; nt < 5; ++nt) b[nt] = *(const f16x8*)(Wt + (size_t)(16 * nt + n) * D_ + 32 * ks + 8 * kq);
#pragma unroll
            for (int mt = 0; mt < 2; ++mt)
#pragma unroll
                for (int nt = 0; nt < 5; ++nt) c[mt][nt] = __builtin_amdgcn_mfma_f32_16x16x32_f16(a[mt], b[nt], c[mt][nt], 0, 0, 0);
        }
        __syncthreads();
#pragma unroll
        for (int mt = 0; mt < 2; ++mt)
#pragma unroll
            for (int nt = 0; nt < 5; ++nt)
#pragma unroll
                for (int i = 0; i < 4; ++i) part[(wave * 32 + 16 * mt + 4 * kq + i) * 80 + 16 * nt + n] = c[mt][nt][i];
        __syncthreads();
        for (int idx = tid; idx < 32 * 80; idx += 512) { float sum = 0.f;
#pragma unroll
            for (int w2 = 0; w2 < 8; ++w2) sum += part[w2 * 2560 + idx];
            fin[idx] = sum; }
        __syncthreads();
        for (int idx = tid; idx < 32 * 80; idx += 512) { const int r = idx / 80, col = idx - 80 * r, t = row0 + r; const float v = fin[idx];
            if (col < 64) { float o = v;
                if (col < 16) { const float pv = fin[r * 80 + (col ^ 8)], cc = rcI[(size_t)t * 8 + (col & 7)], ss = rsI[(size_t)t * 8 + (col & 7)]; o = (col < 8) ? v * cc - pv * ss : v * cc + pv * ss; }
                ((_Float16*)KI)[(size_t)t * 64 + col] = (_Float16)o; }
            else WI[(size_t)t * 16 + (col - 64)] = v * 0.03125f; }
    }
}

__device__ __forceinline__ void phase_dsa_attn3(const P& p, LAS unsigned char* lds, int la) {
    const int tid = otid(), lane = tid & 63, wave = __builtin_amdgcn_readfirstlane(tid >> 6);
    const int n = lane & 15, kq = lane >> 4;
    LAS unsigned char* Im = lds + wave * 16384;
    LAS int* sl = (LAS int*)(Im + 8192);
    LAS _Float16* Pl = (LAS _Float16*)(Im + 9216);
    LAS _Float16* ost = (LAS _Float16*)(Im + 11264);
    LAS int* grab = (LAS int*)(lds + 8 * 16384);
    unsigned* cq = (unsigned*)(p.ws + WS_CTL) + CW_CONVQ + la * 64; const int cstage = 1 + la, ccount = conv_count(cstage); bool cmore = (MK_CONV_HOST == 0);
    const f16_t* Qb = (const f16_t*)(p.ws + WS_Q); const f16_t* Kb = (const f16_t*)(p.ws + WS_K); const f16_t* Vb = (const f16_t*)(p.ws + WS_V);
    const int* SELb = (const int*)(p.ws + WS_SEL); f16_t* Ob = (f16_t*)(p.ws + WS_O);
    unsigned* qhead = (unsigned*)(p.ws + WS_CTL) + CW_DSAQ + la * 512;
    const float scale = 0.08838834764831845f;
    const int xcc = (int)xb_xcc_id();
    unsigned wa[8], ra[2][4], ta[8][2];
#pragma unroll
    for (int i2 = 0; i2 < 8; ++i2) wa[i2] = off_b(4 * i2 + kq, n);
#pragma unroll
    for (int rb = 0; rb < 2; ++rb)
#pragma unroll
        for (int s4 = 0; s4 < 4; ++s4) ra[rb][s4] = off_b(n + 16 * rb, 4 * s4 + kq);
    { const unsigned q4 = (lane & 15) >> 2, p4 = lane & 3;
#pragma unroll
        for (int c = 0; c < 8; ++c)
#pragma unroll
            for (int t2 = 0; t2 < 2; ++t2) ta[c][t2] = off_b(8 * kq + 4 * t2 + q4, 2 * c + (p4 >> 1)) + 8 * (p4 & 1); }
    for (int gi = 0; gi < 4; ++gi) {
        const int g = (xcc + gi) & 3;
        const f16_t* Kg = Kb + (size_t)g * S_ * 128; const f16_t* Vg = Vb + (size_t)g * S_ * 128;
        for (;;) {
            __syncthreads();
            if (tid == 0) grab[0] = (int)atomicAdd(qhead + g * 64, 32u);
            __syncthreads();
            const int t0 = grab[0];
            if (t0 >= S_) break;
#pragma unroll 1
            for (int ti = 0; ti < 4; ++ti) {
            const int t = t0 + 8 * ti + wave;
            { const u32x4 v = __builtin_nontemporal_load((const u32x4*)(SELb + (size_t)t * NSEL + 4 * lane)); *(LAS u32x4*)(sl + 4 * lane) = v; }
            f16x8 A[4];
            { const f16_t* qp = Qb + (size_t)t * 2048 + (4 * g + (n & 3)) * 128 + 8 * kq;
#pragma unroll
                for (int s4 = 0; s4 < 4; ++s4) { const f16x8 qv = __builtin_nontemporal_load((const f16x8*)(qp + 32 * s4));
#pragma unroll
                    for (int j = 0; j < 8; ++j) A[s4][j] = (n < 4) ? qv[j] : (_Float16)0.f; } }
            asm volatile("s_waitcnt lgkmcnt(0)" ::: "memory");
            f16x8 vr[8];
#define AT_GATHER(base, st) do { _Pragma("unroll") for (int i2 = 0; i2 < 8; ++i2) { const int key_ = sl[32 * (st) + 4 * i2 + kq]; const unsigned kc_ = key_ < 0 ? 0u : (unsigned)key_; \
                vr[i2] = *(const f16x8*)((const char*)(base) + kc_ * 256u + 16u * (unsigned)n); } } while (0)
            f32x4 Sg[16];
            AT_GATHER(Kg, 0);
#pragma unroll
            for (int st = 0; st < 8; ++st) {
#pragma unroll
                for (int i2 = 0; i2 < 8; ++i2) *(LAS f16x8*)(Im + wa[i2]) = vr[i2];
                __builtin_amdgcn_sched_barrier(0);
                if (st + 1 < 8) AT_GATHER(Kg, st + 1); else AT_GATHER(Vg, 0);
                __builtin_amdgcn_sched_barrier(0);
#pragma unroll
                for (int rb = 0; rb < 2; ++rb) { f32x4 c = {0.f, 0.f, 0.f, 0.f};
#pragma unroll
                    for (int s4 = 0; s4 < 4; ++s4) c = __builtin_amdgcn_mfma_f32_16x16x32_f16(A[s4], *(const LAS f16x8*)(Im + ra[rb][s4]), c, 0, 0, 0);
                    const bool valid = sl[32 * st + 16 * rb + n] >= 0;
#pragma unroll
                    for (int i = 0; i < 4; ++i) Sg[2 * st + rb][i] = (valid && kq == 0) ? c[i] * scale : -INFINITY; }
                asm volatile("s_waitcnt lgkmcnt(0)" ::: "memory");
                __builtin_amdgcn_sched_barrier(0);
            }
            float mx[4], lsum[4];
#pragma unroll
            for (int i = 0; i < 4; ++i) { float m = Sg[0][i];
#pragma unroll
                for (int tile = 1; tile < 16; ++tile) m = fmaxf(m, Sg[tile][i]);
                mx[i] = wave_max(m); lsum[i] = 0.f; }
#pragma unroll
            for (int tile = 0; tile < 16; ++tile)
#pragma unroll
                for (int i = 0; i < 4; ++i) { Sg[tile][i] = __expf(Sg[tile][i] - mx[i]); lsum[i] += Sg[tile][i]; }
            float inv[4];
#pragma unroll
            for (int i = 0; i < 4; ++i) inv[i] = 1.0f / wave_sum(lsum[i]);
            if (kq == 0) {
#pragma unroll
                for (int tile = 0; tile < 16; ++tile)
#pragma unroll
                    for (int i = 0; i < 4; ++i) Pl[i * 256 + 16 * tile + n] = (_Float16)(Sg[tile][i] * inv[i]); }
            asm volatile("s_waitcnt lgkmcnt(0)" ::: "memory");
            f32x4 acc[8];
#pragma unroll
            for (int c = 0; c < 8; ++c) acc[c] = (f32x4){0.f, 0.f, 0.f, 0.f};
#pragma unroll 1
            for (int st = 0; st < 8; ++st) {
#pragma unroll
                for (int i2 = 0; i2 < 8; ++i2) *(LAS f16x8*)(Im + wa[i2]) = vr[i2];
                __builtin_amdgcn_sched_barrier(0);
                if (st + 1 < 8) AT_GATHER(Vg, st + 1);
                __builtin_amdgcn_sched_barrier(0);
                f16x8 a = *(const LAS f16x8*)(Pl + (n & 3) * 256 + 32 * st + 8 * kq);
#pragma unroll
                for (int j = 0; j < 8; ++j) a[j] = (n < 4) ? a[j] : (_Float16)0.f;
#pragma unroll
                for (int c = 0; c < 8; ++c) { const f16x4 v0 = tr16(Im + ta[c][0]), v1 = tr16(Im + ta[c][1]);
                    const f16x8 b = __builtin_shufflevector(v0, v1, 0, 1, 2, 3, 4, 5, 6, 7);
                    acc[c] = __builtin_amdgcn_mfma_f32_16x16x32_f16(a, b, acc[c], 0, 0, 0); }
                asm volatile("s_waitcnt lgkmcnt(0)" ::: "memory");
                __builtin_amdgcn_sched_barrier(0);
            }
#undef AT_GATHER
            if (kq == 0) {
#pragma unroll
                for (int c = 0; c < 8; ++c)
#pragma unroll
                    for (int i = 0; i < 4; ++i) ost[i * 128 + 16 * c + n] = (_Float16)acc[c][i]; }
            asm volatile("s_waitcnt lgkmcnt(0)" ::: "memory");
            { const u32x4 o = *(const LAS u32x4*)((const LAS unsigned char*)ost + 16 * lane);
              __builtin_nontemporal_store(o, (u32x4*)(Ob + (size_t)t * 2048 + (4 * g) * 128 + 8 * lane)); }
            asm volatile("s_waitcnt lgkmcnt(0)" ::: "memory");
            if (cmore) { int j = 0; if (lane == 0) j = (int)atomicAdd(cq, 1u); j = __builtin_amdgcn_readfirstlane(j);
                if (j < ccount) conv_item<true>(p, (LAS float*)Im, conv_map(cstage, j), lane); else cmore = false; }
            }
        }
    }
    while (cmore) { int j = 0; if (lane == 0) j = (int)atomicAdd(cq, 1u); j = __builtin_amdgcn_readfirstlane(j);
        if (j < ccount) conv_item<true>(p, (LAS float*)Im, conv_map(cstage, j), lane); else cmore = false; }
}

#ifndef MK_DUP
#define MK_DUP 0
#endif
#ifndef MK_SPLIT
#define MK_SPLIT 0
#endif
struct Args { P p; int ph_lo, ph_hi; };
__global__ void __launch_bounds__(512, 2) fwd(Args a) {
    extern __shared__ __attribute__((aligned(16))) unsigned char lds_raw[];
    LAS unsigned char* lds = (LAS unsigned char*)lds_raw;
    const P& p = a.p;
    volatile LAS unsigned* MISC = (volatile LAS unsigned*)(lds + LDS_MISC);
    for (int u = threadIdx.x; u < (LDS_BYTES - LDS_MISC) / 4; u += 512) MISC[u] = 0u;
    __syncthreads();
    unsigned* barw = (unsigned*)(p.ws + WS_CTL) + 4096;
    XcdBarrier bar; bar.bar = barw; bar.x = 0; bar.st = nullptr;
    if (!MK_SPLIT) bar = xcd_barrier_post(barw, MISC + 8);
    int ph = 0;
#define RUN(...) do { if (a.ph_lo <= ph && ph < a.ph_hi) { __VA_ARGS__; if (!MK_SPLIT && ph + 1 < a.ph_hi) xcd_barrier(bar); } ++ph; } while (0)
    const float* rope = (const float*)(p.ws + WS_ROPE);
    unsigned char* ws = p.ws;
    RUN({ phase_prologue(p, lds); if (MK_DUP & 32) { __syncthreads(); phase_prologue(p, lds); } });
    RUN(phase_mod_reduce(p));
    RUN({ phase_norm(p, 0, 0); if (MK_DUP & 64) { __syncthreads(); phase_norm(p, 0, 0); } });
    for (int l = 0; l < 4; ++l) {
        const int li = l >> 1;
        if ((l & 1) == 0) {
            RUN({ pg8::Gemm g{(const f16_t*)(ws + WS_H), (const f16_t*)(ws + WS_WAIN) + (size_t)li * A_INP * D_, S_, 4096, D_, 0};
                  pg8::EpiIn<0> E{(f16_t*)(ws + WS_Q), (f16_t*)(ws + WS_K), (f16_t*)(ws + WS_V), (f16_t*)(ws + WS_QI), (f16_t*)(ws + WS_KI), (float*)(ws + WS_WI), nullptr, rope, rope + S_ * 16, rope + S_ * 32, rope + S_ * 40};
                  pg8::StaticOrder S; S.init(S_, 4096, (int)gridDim.x, obid());
                  pg8::gemm_phase<pg8::EpiIn<0>, pg8::StaticOrder, true>(lds, g, S, E);
                  side_gemm_kiwi(p, lds, li); });
            RUN({ if (MK_DUP & 128) { phase_idx_topk<1>(p, lds, -1); __syncthreads(); } if (MK_DUP & 256) { phase_idx_topk<2>(p, lds, -1); __syncthreads(); } phase_idx_topk<3>(p, lds, MK_CONV_HOST == 1 ? 1 + li : -1); if (MK_DUP & 1) { __syncthreads(); phase_idx_topk<3>(p, lds, -1); } });
            RUN(phase_dsa_attn3(p, lds, li));
            RUN({ pg8::Gemm g{(const f16_t*)(ws + WS_O), (const f16_t*)(ws + WS_WAO) + (size_t)li * D_ * D_, S_, D_, D_, 0};
                  pg8::EpiF16 E{(f16_t*)(ws + WS_Y), D_, 0};
                  pg8::StaticOrder S; S.init(S_, D_, (int)gridDim.x, obid());
                  pg8::gemm_phase<pg8::EpiF16, pg8::StaticOrder, false>(lds, g, S, E); });
        } else {
            RUN({ pg8::Gemm g{(const f16_t*)(ws + WS_H), (const f16_t*)(ws + WS_WBIN) + (size_t)li * B_IN * D_, S_, B_IN, D_, 0};
                  pg8::EpiIn<1> E{(f16_t*)(ws + WS_Q), (f16_t*)(ws + WS_K), (f16_t*)(ws + WS_V), nullptr, nullptr, nullptr, (float*)(ws + WS_KSUM) + (size_t)li * 65536, rope, rope + S_ * 16, rope + S_ * 32, rope + S_ * 40};
                  pg8::StaticOrder S; S.init(S_, B_IN, (int)gridDim.x, obid());
                  pg8::gemm_phase<pg8::EpiIn<1>, pg8::StaticOrder, true>(lds, g, S, E); });
            RUN(phase_moba_gate(p, li));
            RUN({ phase_moba_past(p, lds, li); if (MK_DUP & 8) { __syncthreads(); phase_moba_past(p, lds, li); } });
            RUN({ phase_moba_own(p, lds); if (MK_DUP & 16) { __syncthreads(); phase_moba_own(p, lds); } });
            RUN({ pg8::Gemm g{(const f16_t*)(ws + WS_O), (const f16_t*)(ws + WS_WBO) + (size_t)li * D_ * D_, S_, D_, D_, 0};
                  pg8::EpiF16 E{(f16_t*)(ws + WS_Y), D_, 0};
                  pg8::StaticOrder S; S.init(S_, D_, (int)gridDim.x, obid());
                  pg8::gemm_phase<pg8::EpiF16, pg8::StaticOrder, false>(lds, g, S, E); });
        }
        RUN(phase_norm(p, 1, l));
        RUN({ pg8::Gemm g{(const f16_t*)(ws + WS_H), (const f16_t*)(ws + WS_WF1) + (size_t)l * 2 * DFF * D_, S_, 2 * DFF, D_, 0};
              pg8::EpiSwiglu E{(f16_t*)(ws + WS_ACT), DFF, 0};
              pg8::SplitTailOrder S; S.init(S_, 2 * DFF, (int)gridDim.x, obid(), (float*)(ws + WS_PB), (unsigned*)(ws + WS_CTL) + CW_SPLIT + l * 128);
              pg8::gemm_phase<pg8::EpiSwiglu, pg8::SplitTailOrder, true>(lds, g, S, E); });
        RUN({ pg8::Gemm g{(const f16_t*)(ws + WS_ACT), (const f16_t*)(ws + WS_WF2) + (size_t)l * D_ * DFF, S_, D_, DFF, 0};
              pg8::EpiF16 E{(f16_t*)(ws + WS_Y), D_, 0};
              pg8::StaticOrder S; S.init(S_, D_, (int)gridDim.x, obid());
              pg8::gemm_phase<pg8::EpiF16, pg8::StaticOrder, false>(lds, g, S, E);
              if (MK_DUP & 2048) { __syncthreads(); pg8::gemm_phase<pg8::EpiF16, pg8::StaticOrder, false>(lds, g, S, E); } });
        RUN(phase_norm(p, 2, l));
    }
#undef RUN
}
constexpr int N_PHASES = 3 + 2 * 8 + 2 * 9;

extern "C" void kernel_launch(void* const* d_in, const int* in_sizes, int n_in, void* d_out, int out_size, void* d_ws, size_t ws_size, hipStream_t stream) {
    if (n_in != 12 || ws_size < WS_END) { fprintf(stderr, "kernel_launch: unexpected inputs (n_in %d, ws %zu < %zu)\n", n_in, ws_size, (size_t)WS_END); return; }
    static int grid = 0;
    if (!grid) { int dev = 0, cus = 0, per_cu = 0; (void)hipGetDevice(&dev); (void)hipDeviceGetAttribute(&cus, hipDeviceAttributeMultiprocessorCount, dev);
        if (hipFuncSetAttribute((const void*)fwd, hipFuncAttributeMaxDynamicSharedMemorySize, LDS_BYTES) != hipSuccess) { fprintf(stderr, "kernel_launch: hipFuncSetAttribute failed\n"); grid = -1; return; }
        if (hipOccupancyMaxActiveBlocksPerMultiprocessor(&per_cu, (const void*)fwd, 512, LDS_BYTES) != hipSuccess || per_cu < 1) fprintf(stderr, "kernel_launch: note: occupancy query reports %d workgroups per CU\n", per_cu);
        (void)hipGetLastError();
        grid = cus > 0 ? cus : 256; }
    if (grid < 0) return;
    (void)hipMemsetAsync((char*)d_ws + WS_CTL, 0, 1 * MiB, stream);
    Args a{}; a.p.x = (const float*)d_in[0]; a.p.c = (const float*)d_in[1]; a.p.pos = (const int*)d_in[2]; a.p.a_w_in = (const float*)d_in[3]; a.p.a_w_o = (const float*)d_in[4];
    a.p.b_w_in = (const float*)d_in[5]; a.p.b_w_o = (const float*)d_in[6]; a.p.ada_w = (const float*)d_in[7]; a.p.ada_b = (const float*)d_in[8]; a.p.norm_g = (const float*)d_in[9];
    a.p.ffn_w_in = (const float*)d_in[10]; a.p.ffn_w_out = (const float*)d_in[11]; a.p.out = (float*)d_out; a.p.ws = (unsigned char*)d_ws;
    if (MK_SPLIT) { for (int ph = 0; ph < N_PHASES; ++ph) { a.ph_lo = ph; a.ph_hi = ph + 1; hipLaunchKernelGGL(fwd, dim3(grid), dim3(512), LDS_BYTES, stream, a); } }
    else { a.ph_lo = 0; a.ph_hi = N_PHASES; hipLaunchKernelGGL(fwd, dim3(grid), dim3(512), LDS_BYTES, stream, a); }
}
```

```cpp
#include <hip/hip_runtime.h>
#include <cstdio>
#include <cstdint>

#define LAS __attribute__((address_space(3)))
typedef unsigned short f16_t;
typedef _Float16 f16x8 __attribute__((ext_vector_type(8)));
typedef _Float16 f16x4 __attribute__((ext_vector_type(4)));
typedef _Float16 f16x2 __attribute__((ext_vector_type(2)));
typedef float f32x2 __attribute__((ext_vector_type(2)));
typedef float f32x4 __attribute__((ext_vector_type(4)));
typedef unsigned u32x4 __attribute__((ext_vector_type(4)));
typedef unsigned u32x2 __attribute__((ext_vector_type(2)));

constexpr int S_ = 8192, D_ = 2048, NH = 16, HD = 128, DFF = 5632;
constexpr int A_IN = 4176, A_INP = 4352, B_IN = 6144;
constexpr int NSEL = 256;
constexpr float EPS = 1e-6f;

__device__ __forceinline__ unsigned pk_f16(float lo, float hi) { f16x2 r = __builtin_convertvector((f32x2){lo, hi}, f16x2); return __builtin_bit_cast(unsigned, r); }
__device__ __forceinline__ float h2f(f16_t v) { return (float)__builtin_bit_cast(_Float16, v); }
template <int CTRL> __device__ __forceinline__ float dpp_f(float v) { const int iv = __builtin_bit_cast(int, v); return __builtin_bit_cast(float, __builtin_amdgcn_update_dpp(0, iv, CTRL, 0xF, 0xF, true)); }
__device__ __forceinline__ float row16_max(float v) { v = fmaxf(v, dpp_f<0xB1>(v)); v = fmaxf(v, dpp_f<0x4E>(v)); v = fmaxf(v, dpp_f<0x141>(v)); v = fmaxf(v, dpp_f<0x140>(v)); return v; }
__device__ __forceinline__ float row16_sum(float v) { v += dpp_f<0xB1>(v); v += dpp_f<0x4E>(v); v += dpp_f<0x141>(v); v += dpp_f<0x140>(v); return v; }

template <int CTRL, int ROWMASK> __device__ __forceinline__ unsigned dpp_u(unsigned v) { return (unsigned)__builtin_amdgcn_update_dpp(0, (int)v, CTRL, ROWMASK, 0xF, false); }
__device__ __forceinline__ unsigned wave_scan_incl(unsigned v) {
    v += dpp_u<0x111, 0xF>(v); v += dpp_u<0x112, 0xF>(v); v += dpp_u<0x114, 0xF>(v); v += dpp_u<0x118, 0xF>(v);
    v += dpp_u<0x142, 0xA>(v); v += dpp_u<0x143, 0xC>(v);
    return v;
}
__device__ __forceinline__ unsigned lane_get(unsigned v, int l) { return (unsigned)__builtin_amdgcn_readlane((int)v, __builtin_amdgcn_readfirstlane(l)); }
__device__ __forceinline__ float lanes16_other(float v, float& mine) { const unsigned u = __builtin_bit_cast(unsigned, v); const auto r = __builtin_amdgcn_permlane16_swap(u, u, false, false); const unsigned a = r[0], b = r[1]; mine = __builtin_bit_cast(float, a); return __builtin_bit_cast(float, b); }
__device__ __forceinline__ float lanes32_other(float v, float& mine) { const unsigned u = __builtin_bit_cast(unsigned, v); const auto r = __builtin_amdgcn_permlane32_swap(u, u, false, false); const unsigned a = r[0], b = r[1]; mine = __builtin_bit_cast(float, a); return __builtin_bit_cast(float, b); }
__device__ __forceinline__ float wave_sum(float v) { v = row16_sum(v); float a, b; b = lanes16_other(v, a); v = a + b; b = lanes32_other(v, a); return a + b; }
__device__ __forceinline__ float wave_max(float v) { v = row16_max(v); float a, b; b = lanes16_other(v, a); v = fmaxf(a, b); b = lanes32_other(v, a); return fmaxf(a, b); }
__device__ __forceinline__ float lane_xor_1632(float v, int xm) {
    float mine, other; const int lane = (int)(threadIdx.x & 63u);
    if (xm == 32) { other = lanes32_other(v, mine); return lane < 32 ? other : mine; }
    other = lanes16_other(v, mine); return (lane & 16) ? mine : other;
}
__device__ __forceinline__ float xor32_max(float v) { float a, b; b = lanes32_other(v, a); return fmaxf(a, b); }
__device__ __forceinline__ float xor32_sum(float v) { float a, b; b = lanes32_other(v, a); return a + b; }

__device__ __forceinline__ int otid() { int t = (int)threadIdx.x; asm volatile("" : "+v"(t)); return t; }
__device__ __forceinline__ int obid() { int b = (int)blockIdx.x; asm volatile("" : "+s"(b)); return b; }

#ifndef MK_CONV_HOST
#define MK_CONV_HOST 1
#endif
namespace pg8 {
constexpr int BM = 256, BK = 64, HALF = 128, HTB = HALF * BK * 2, STAGE_BYTES = 8 * HTB, NXCD = 8, WGM = 8;
__host__ __device__ __forceinline__ int lds_byte(int r, int c) { const int st = (r >> 4) * 2 + (c >> 5), rr = r & 15, cc = c & 31, ob = rr * 64 + cc * 2; return st * 1024 + (ob ^ (((ob >> 9) & 1) << 5)); }
__host__ __device__ __forceinline__ void stage_rc(int b, int& R, int& C) { const int st = b / 1024, sb = b % 1024, swz = sb ^ (((sb >> 9) & 1) << 5); R = (st >> 1) * 16 + swz / 64; C = (st & 1) * 32 + (swz % 64) / 2; }
__host__ __device__ __forceinline__ int perm32(int rho) { const int n = rho >> 4, i = rho & 15; return 8 * (i >> 2) + 4 * n + (i & 3); }
struct Unit { int pm, pn, ks; };
struct Gemm { const f16_t* A; const f16_t* Bt; int M, N, K, pad; };
struct StaticOrder {
    int nM, nN, nwg, G, c;
    __host__ __device__ void init(int M, int N, int G_, int c_) { nM = M / BM; nN = N / BM; nwg = nM * nN; G = G_; c = c_; }
    static constexpr bool SPLIT = false;
    __host__ __device__ bool next(int i, Unit& u) const { return map((long)i * G + c, u); }
    __host__ __device__ bool map(long L, Unit& u) const {
        u.ks = -1; if (L >= nwg) return false;
        int wgid = (int)L; { const int q = nwg / NXCD, r = nwg % NXCD, xcd = wgid % NXCD, off = wgid / NXCD; wgid = (xcd < r ? xcd * (q + 1) : r * (q + 1) + (xcd - r) * q) + off; }
        const int nig = WGM * nN, gid = wgid / nig, fm = gid * WGM, gsz = (nM - fm) < WGM ? (nM - fm) : WGM;
        u.pm = fm + ((wgid % nig) % gsz); u.pn = (wgid % nig) / gsz; return true;
    }
    __device__ __forceinline__ void a_ready(const Unit&) const {}
    __device__ __forceinline__ void done(const Unit&) const {}
};

struct SplitTailOrder {
    static constexpr bool SPLIT = true;
    StaticOrder s; int nfull, en; float* pb; unsigned* fl;
    __device__ void init(int M, int N, int G_, int c_, float* pb_, unsigned* fl_) { s.init(M, N, G_, c_); nfull = s.nwg / G_; const int tail = s.nwg - nfull * G_; en = ((G_ & 1) == 0 && tail > 0 && tail <= G_ / 2) ? 1 : 0; pb = pb_; fl = fl_; }
    __device__ bool next(int i, Unit& u) const {
        if (!en || i < nfull) return s.next(i, u);
        if (i > nfull) return false;
        const int half = s.G / 2, j = s.c % half;
        if (!s.map((long)nfull * s.G + j, u)) return false;
        u.ks = s.c / half; return true;
    }
    __device__ int slot() const { return s.c % (s.G / 2); }
    __device__ __forceinline__ void a_ready(const Unit&) const {}
    __device__ __forceinline__ void done(const Unit&) const {}
};

struct EpiF32 {
    static constexpr bool PERM = false, AFTER_DRAIN = false;
    float* C; int ldc, pad;
    __device__ __forceinline__ void operator()(const f32x4 (&acc)[2][2][4][2], const Unit& u, int wr, int wc, int fr, int fq) const {
        const int row0 = u.pm * BM + wr * 64 + fr, col0 = u.pn * BM + wc * 32 + 4 * fq;
#pragma unroll
        for (int ai = 0; ai < 2; ++ai)
#pragma unroll
            for (int m = 0; m < 4; ++m) { float* rowp = C + (size_t)(row0 + ai * HALF + m * 16) * ldc + col0;
#pragma unroll
                for (int bj = 0; bj < 2; ++bj)
#pragma unroll
                    for (int n = 0; n < 2; ++n) *(f32x4*)(rowp + bj * HALF + n * 16) = acc[ai][bj][m][n]; }
    }
};
struct EpiF16 {
    static constexpr bool PERM = true, AFTER_DRAIN = false;
    f16_t* C; int ldc, pad;
    __device__ __forceinline__ void operator()(const f32x4 (&acc)[2][2][4][2], const Unit& u, int wr, int wc, int fr, int fq) const {
        const int row0 = u.pm * BM + wr * 64 + fr, col0 = u.pn * BM + wc * 32 + 8 * fq;
#pragma unroll
        for (int ai = 0; ai < 2; ++ai)
#pragma unroll
            for (int m = 0; m < 4; ++m) { f16_t* rowp = C + (size_t)(row0 + ai * HALF + m * 16) * ldc + col0;
#pragma unroll
                for (int bj = 0; bj < 2; ++bj) { const f32x4 v0 = acc[ai][bj][m][0], v1 = acc[ai][bj][m][1];
                    u32x4 w; w.x = pk_f16(v0[0], v0[1]); w.y = pk_f16(v0[2], v0[3]); w.z = pk_f16(v1[0], v1[1]); w.w = pk_f16(v1[2], v1[3]);
                    *(u32x4*)(rowp + bj * HALF) = w; } }
    }
};
struct EpiSwiglu {
    static constexpr bool PERM = true, AFTER_DRAIN = false;
    f16_t* O; int ldc, pad;
    __device__ __forceinline__ void operator()(const f32x4 (&acc)[2][2][4][2], const Unit& u, int wr, int wc, int fr, int fq) const {
        const int row0 = u.pm * BM + wr * 64 + fr, col0 = u.pn * HALF + wc * 32 + 8 * fq;
#pragma unroll
        for (int ai = 0; ai < 2; ++ai)
#pragma unroll
            for (int m = 0; m < 4; ++m) { f16_t* rowp = O + (size_t)(row0 + ai * HALF + m * 16) * ldc + col0;
                float o[8];
#pragma unroll
                for (int n = 0; n < 2; ++n)
#pragma unroll
                    for (int j = 0; j < 4; ++j) { const float uu = acc[ai][0][m][n][j], g = acc[ai][1][m][n][j]; o[4 * n + j] = uu * g * __builtin_amdgcn_rcpf(1.0f + __expf(-g)); }
                u32x4 w; w.x = pk_f16(o[0], o[1]); w.y = pk_f16(o[2], o[3]); w.z = pk_f16(o[4], o[5]); w.w = pk_f16(o[6], o[7]);
                *(u32x4*)rowp = w; }
    }
};
__device__ __forceinline__ void rope8(f32x4& v0, f32x4& v1, const f32x4 c0, const f32x4 c1, const f32x4 s0, const f32x4 s1, float sgn, int xm, bool apply) {
#pragma unroll
    for (int j = 0; j < 4; ++j) {
        const float a0 = v0[j], a1 = v1[j]; const float o0 = lane_xor_1632(a0, xm), o1 = lane_xor_1632(a1, xm);
        if (apply) { v0[j] = v0[j] * c0[j] + sgn * o0 * s0[j]; v1[j] = v1[j] * c1[j] + sgn * o1 * s1[j]; }
    }
}
template <int MODE> struct EpiIn {
    static constexpr bool PERM = true, AFTER_DRAIN = false;
    f16_t *Q, *K, *V, *QI, *KI; float* WI; float* KS;
    const float *rcA, *rsA, *rcI, *rsI;
    __device__ __forceinline__ void operator()(const f32x4 (&acc)[2][2][4][2], const Unit& u, int wr, int wc, int fr, int fq) const {
        const int row0 = u.pm * BM + wr * 64 + fr; const int pn = u.pn;
        constexpr int NQ = 8, NK = (MODE == 0) ? 2 : 8, NV = (MODE == 0) ? 2 : 8;
        if (pn < NQ + NK + NV) {
            f16_t* base; int ldc, colt; bool rope;
            if (pn < NQ) { base = Q; ldc = 2048; colt = pn * BM; rope = true; }
            else if (pn < NQ + NK) { base = K; ldc = NK * BM; colt = (pn - NQ) * BM; rope = true; }
            else { base = V; ldc = NV * BM; colt = (pn - NQ - NK) * BM; rope = false; }
            size_t hstride = HALF;
            if (MODE == 0 && pn >= NQ) { base += (size_t)(colt >> 7) * S_ * 128; colt = 0; ldc = 128; hstride = (size_t)S_ * 128; }
            const int col0 = colt + wc * 32 + 8 * fq; const bool dorope = rope && (wc == 0);
            const float sgn = (fq < 2) ? -1.f : 1.f;
            const bool ksum = (MODE == 1) && pn >= NQ && pn < NQ + NK;
            float cs[2][8];
#pragma unroll
            for (int bj = 0; bj < 2; ++bj)
#pragma unroll
                for (int e = 0; e < 8; ++e) cs[bj][e] = 0.f;
#pragma unroll
            for (int ai = 0; ai < 2; ++ai)
#pragma unroll
                for (int m = 0; m < 4; ++m) { const int row = row0 + ai * HALF + m * 16; f16_t* rowp = base + (size_t)row * ldc + col0;
                    f32x4 c0, c1, s0, s1;
                    if (dorope) { const float* cp = rcA + (size_t)row * 16 + 8 * (fq & 1); const float* sp = rsA + (size_t)row * 16 + 8 * (fq & 1);
                        c0 = *(const f32x4*)cp; c1 = *(const f32x4*)(cp + 4); s0 = *(const f32x4*)sp; s1 = *(const f32x4*)(sp + 4); }
#pragma unroll
                    for (int bj = 0; bj < 2; ++bj) { f32x4 v0 = acc[ai][bj][m][0], v1 = acc[ai][bj][m][1];
                        if (dorope) rope8(v0, v1, c0, c1, s0, s1, sgn, 32, true);
                        if (ksum) {
#pragma unroll
                            for (int e = 0; e < 4; ++e) { cs[bj][e] += v0[e]; cs[bj][4 + e] += v1[e]; } }
                        u32x4 w; w.x = pk_f16(v0[0], v0[1]); w.y = pk_f16(v0[2], v0[3]); w.z = pk_f16(v1[0], v1[1]); w.w = pk_f16(v1[2], v1[3]);
                        *(u32x4*)(rowp + bj * hstride) = w; } }
            if (ksum) {
#pragma unroll
                for (int bj = 0; bj < 2; ++bj)
#pragma unroll
                    for (int e = 0; e < 8; ++e) { float v = row16_sum(cs[bj][e]);
                        if (fr == 0) atomicAdd(KS + ((size_t)(2 * (pn - NQ) + bj) * 32 + u.pm) * 128 + wc * 32 + 8 * fq + e, v); } }
        } else if (MODE == 0 && pn < 16) {
            const int col0 = (pn - 12) * BM + wc * 32 + 8 * fq; const bool ropew = ((wc & 1) == 0); const bool app = fq < 2; const float sgn = (fq == 0) ? -1.f : 1.f;
#pragma unroll
            for (int ai = 0; ai < 2; ++ai)
#pragma unroll
                for (int m = 0; m < 4; ++m) { const int row = row0 + ai * HALF + m * 16; f16_t* rowp = QI + (size_t)row * 1024 + col0;
                    f32x4 c0, c1, s0, s1;
                    if (ropew) { const float* cp = rcI + (size_t)row * 8; const float* sp = rsI + (size_t)row * 8; c0 = *(const f32x4*)cp; c1 = *(const f32x4*)(cp + 4); s0 = *(const f32x4*)sp; s1 = *(const f32x4*)(sp + 4); }
#pragma unroll
                    for (int bj = 0; bj < 2; ++bj) { f32x4 v0 = acc[ai][bj][m][0], v1 = acc[ai][bj][m][1];
                        if (ropew) rope8(v0, v1, c0, c1, s0, s1, sgn, 16, app);
                        u32x4 w; w.x = pk_f16(v0[0], v0[1]); w.y = pk_f16(v0[2], v0[3]); w.z = pk_f16(v1[0], v1[1]); w.w = pk_f16(v1[2], v1[3]);
                        *(u32x4*)(rowp + bj * HALF) = w; } }
        } else if (MODE == 0) {
            const bool ropew = (wc == 0); const bool app = fq < 2; const float sgn = (fq == 0) ? -1.f : 1.f;
#pragma unroll
            for (int ai = 0; ai < 2; ++ai)
#pragma unroll
                for (int m = 0; m < 4; ++m) { const int row = row0 + ai * HALF + m * 16;
                    f32x4 v0 = acc[ai][0][m][0], v1 = acc[ai][0][m][1];
                    if (ropew) { const float* cp = rcI + (size_t)row * 8; const float* sp = rsI + (size_t)row * 8;
                        const f32x4 c0 = *(const f32x4*)cp, c1 = *(const f32x4*)(cp + 4), s0 = *(const f32x4*)sp, s1 = *(const f32x4*)(sp + 4);
                        rope8(v0, v1, c0, c1, s0, s1, sgn, 16, app); }
                    if (wc < 2) { u32x4 w; w.x = pk_f16(v0[0], v0[1]); w.y = pk_f16(v0[2], v0[3]); w.z = pk_f16(v1[0], v1[1]); w.w = pk_f16(v1[2], v1[3]);
                        *(u32x4*)(KI + (size_t)row * 64 + wc * 32 + 8 * fq) = w; }
                    else if (wc == 2 && fq < 2) { float* wp = WI + (size_t)row * 16 + 8 * fq; *(f32x4*)wp = v0 * 0.03125f; *(f32x4*)(wp + 4) = v1 * 0.03125f; } }
        }
    }
};

template <class Epi, class Sched, bool ALIGN_EPI>
__device__ __forceinline__ void gemm_phase(LAS unsigned char* lds, const Gemm g, const Sched& S, const Epi& E) {
    const int tid = otid(), wid = __builtin_amdgcn_readfirstlane(tid >> 6), lane = tid & 63, wr = wid >> 2, wc = wid & 3, fr = lane & 15, fq = lane >> 4;
    const int K = g.K, nt = K / BK;
    unsigned voffA[2], voffB[2];
#pragma unroll
    for (int i = 0; i < 2; ++i) { int R, C; stage_rc(tid * 16 + i * 8192, R, C); const int Rb = Epi::PERM ? ((R & ~31) + perm32(R & 31)) : R;
        voffA[i] = (unsigned)(R * K + C) * 2u; voffB[i] = (unsigned)(Rb * K + C) * 2u; }
    const size_t kstep = (size_t)(BK * 2);
    const size_t hstep = (size_t)HALF * K * 2;
    const size_t tstep = 2 * hstep;
    const unsigned ldsw = (unsigned)wid * 1024u;
    const int aoff = lds_byte(wr * 64 + fr, fq * 8), boff = lds_byte(wc * 32 + fr, fq * 8);
#define PG8_SA(b, h) (((b) * 2 + (h)) * HTB)
#define PG8_SB(b, h) ((4 + (b) * 2 + (h)) * HTB)
#define PG8_STAGE(bufoff, gbase, voff) do { _Pragma("unroll") for (int _i = 0; _i < 2; ++_i) \
        __builtin_amdgcn_global_load_lds((const unsigned*)((const char*)(gbase) + (voff)[_i]), (LAS unsigned*)(lds + (bufoff) + ldsw + _i * 8192), 16, 0, 0); } while (0)
#define PG8_LDA(dst, b, h) do { _Pragma("unroll") for (int m = 0; m < 4; ++m) _Pragma("unroll") for (int k = 0; k < 2; ++k) dst[m][k] = *(const LAS f16x8*)(lds + PG8_SA(b, h) + aoff + m * 2048 + k * 1024); } while (0)
#define PG8_LDB(dst, b, h) do { _Pragma("unroll") for (int n = 0; n < 2; ++n) _Pragma("unroll") for (int k = 0; k < 2; ++k) dst[n][k] = *(const LAS f16x8*)(lds + PG8_SB(b, h) + boff + n * 2048 + k * 1024); } while (0)
#define PG8_MMA(ai, bj, At, Bt) do { __builtin_amdgcn_s_setprio(1); _Pragma("unroll") for (int m = 0; m < 4; ++m) _Pragma("unroll") for (int n = 0; n < 2; ++n) _Pragma("unroll") for (int k = 0; k < 2; ++k) \
        acc[ai][bj][m][n] = __builtin_amdgcn_mfma_f32_16x16x32_f16(Bt[n][k], At[m][k], acc[ai][bj][m][n], 0, 0, 0); __builtin_amdgcn_s_setprio(0); } while (0)
#define PG8_WAIT_V(n) asm volatile("s_waitcnt vmcnt(" #n ")" ::: "memory")
#define PG8_WAIT_L(n) asm volatile("s_waitcnt lgkmcnt(" #n ")" ::: "memory")
#define PG8_BAR __builtin_amdgcn_s_barrier()
#define PG8_SCHED __builtin_amdgcn_sched_barrier(0)
    Unit cur, nxt; int ui = 0;
    if (!S.next(0, cur)) return;
    f32x4 acc[2][2][4][2];
#pragma unroll
    for (int a = 0; a < 2; ++a)
#pragma unroll
        for (int b = 0; b < 2; ++b)
#pragma unroll
            for (int m = 0; m < 4; ++m)
#pragma unroll
                for (int n = 0; n < 2; ++n) acc[a][b][m][n] = (f32x4){0.f, 0.f, 0.f, 0.f};
    f16x8 At[4][2], B0[2][2], B1[2][2];
    static_assert(ALIGN_EPI || !Sched::SPLIT, "the split hand-over needs the wave halves aligned");
    const char* cA = (const char*)g.A + (size_t)cur.pm * tstep; const char* cB = (const char*)g.Bt + (size_t)cur.pn * tstep;
    if constexpr (Sched::SPLIT) { if (cur.ks > 0) { cA += K; cB += K; } }
    S.a_ready(cur);
    PG8_STAGE(PG8_SB(0, 0), cB, voffB); PG8_STAGE(PG8_SB(0, 1), cB + hstep, voffB); PG8_STAGE(PG8_SA(0, 0), cA, voffA); PG8_STAGE(PG8_SA(0, 1), cA + hstep, voffA);
    if (wr == 1) PG8_BAR;
    PG8_WAIT_V(2); PG8_BAR;
    PG8_STAGE(PG8_SB(1, 0), cB + kstep, voffB); PG8_STAGE(PG8_SA(1, 0), cA + kstep, voffA); PG8_STAGE(PG8_SB(1, 1), cB + hstep + kstep, voffB);
    PG8_WAIT_V(6); PG8_BAR;
    for (;;) {
        const bool has_next = S.next(ui + 1, nxt);
        const char* nA = has_next ? (const char*)g.A + (size_t)nxt.pm * tstep : cA; const char* nB = has_next ? (const char*)g.Bt + (size_t)nxt.pn * tstep : cB;
        int ntu = nt;
        if constexpr (Sched::SPLIT) { if (has_next && nxt.ks > 0) { nA += K; nB += K; } if (cur.ks >= 0) ntu = nt >> 1; }
        for (int t = 0; t < ntu; t += 2) {
            const bool last = (t == ntu - 2);
            const char* a1 = cA + (size_t)(t + 1) * kstep;
            const char* a2 = last ? nA : cA + (size_t)(t + 2) * kstep; const char* b2 = last ? nB : cB + (size_t)(t + 2) * kstep;
            const char* a3 = a2 + kstep; const char* b3 = b2 + kstep;
            if (last && has_next) S.a_ready(nxt);
            PG8_LDB(B0, 0, 0); PG8_LDB(B1, 0, 1); PG8_SCHED; PG8_LDA(At, 0, 0); PG8_STAGE(PG8_SA(1, 1), a1 + hstep, voffA);
            PG8_WAIT_V(8); PG8_WAIT_L(0); PG8_BAR; PG8_MMA(0, 0, At, B0); PG8_MMA(0, 1, At, B1); PG8_BAR; PG8_SCHED;
            PG8_LDA(At, 0, 1); PG8_STAGE(PG8_SB(0, 0), b2, voffB); PG8_STAGE(PG8_SB(0, 1), b2 + hstep, voffB); PG8_STAGE(PG8_SA(0, 0), a2, voffA);
            PG8_WAIT_V(8); PG8_WAIT_L(0); PG8_BAR; PG8_MMA(1, 0, At, B0); PG8_MMA(1, 1, At, B1); PG8_BAR; PG8_SCHED;
            PG8_LDB(B0, 1, 0); PG8_LDB(B1, 1, 1); PG8_SCHED; PG8_LDA(At, 1, 0); PG8_STAGE(PG8_SA(0, 1), a2 + hstep, voffA);
            PG8_WAIT_V(8); PG8_WAIT_L(0); PG8_BAR; PG8_MMA(0, 0, At, B0); PG8_MMA(0, 1, At, B1); PG8_BAR; PG8_SCHED;
            PG8_LDA(At, 1, 1); PG8_STAGE(PG8_SB(1, 0), b3, voffB); PG8_STAGE(PG8_SB(1, 1), b3 + hstep, voffB); PG8_STAGE(PG8_SA(1, 0), a3, voffA);
            PG8_WAIT_V(8); PG8_WAIT_L(0); PG8_BAR; PG8_MMA(1, 0, At, B0); PG8_MMA(1, 1, At, B1); PG8_BAR; PG8_SCHED;
        }
        if constexpr (ALIGN_EPI) { if (wr == 0) PG8_BAR; }
        bool epi = true;
        if constexpr (Sched::SPLIT) {
            if (cur.ks == 1) {
                char* pbb = (char*)S.pb + (size_t)S.slot() * 262144; unsigned po = (unsigned)tid * 16u; asm volatile("" : "+v"(po));
#pragma unroll
                for (int i = 0; i < 32; ++i) *(f32x4*)(pbb + (po + (unsigned)i * 8192u)) = acc[i >> 4][(i >> 3) & 1][(i >> 1) & 3][i & 1];
                asm volatile("s_waitcnt vmcnt(0)" ::: "memory"); PG8_BAR;
                if (tid == 0) { __builtin_amdgcn_fence(__ATOMIC_RELEASE, "agent"); __hip_atomic_store(S.fl + S.slot(), 1u, __ATOMIC_RELAXED, __HIP_MEMORY_SCOPE_AGENT); }
                epi = false;
            } else if (cur.ks == 0) {
                if (tid == 0) { unsigned sp = 0u; while (__hip_atomic_load(S.fl + S.slot(), __ATOMIC_RELAXED, __HIP_MEMORY_SCOPE_AGENT) == 0u && ++sp < (1u << 24)) __builtin_amdgcn_s_sleep(1);
                                __builtin_amdgcn_fence(__ATOMIC_ACQUIRE, "agent"); }
                PG8_BAR; asm volatile("" ::: "memory");
                const char* pbb = (const char*)S.pb + (size_t)S.slot() * 262144; unsigned po = (unsigned)tid * 16u; asm volatile("" : "+v"(po));
#pragma unroll
                for (int i0 = 0; i0 < 32; i0 += 16) { f32x4 t8[16];
#pragma unroll
                    for (int i = 0; i < 16; ++i) t8[i] = *(const f32x4*)(pbb + (po + (unsigned)(i0 + i) * 8192u));
                    __builtin_amdgcn_sched_barrier(0);
#pragma unroll
                    for (int i = 0; i < 16; ++i) { const int ii = i0 + i; acc[ii >> 4][(ii >> 3) & 1][(ii >> 1) & 3][ii & 1] += t8[i]; } }
            }
        }
        if (epi) E(acc, cur, wr, wc, fr, fq);
        S.done(cur);
        if (!has_next) break;
#pragma unroll
        for (int a = 0; a < 2; ++a)
#pragma unroll
            for (int b = 0; b < 2; ++b)
#pragma unroll
                for (int m = 0; m < 4; ++m)
#pragma unroll
                    for (int n = 0; n < 2; ++n) acc[a][b][m][n] = (f32x4){0.f, 0.f, 0.f, 0.f};
        cur = nxt; cA = nA; cB = nB; ++ui;
        if constexpr (ALIGN_EPI) { if (wr == 1) PG8_BAR; }
    }
    PG8_WAIT_V(0);
    if constexpr (!ALIGN_EPI) { if (wr == 0) PG8_BAR; }
    PG8_BAR;
#undef PG8_SA
#undef PG8_SB
#undef PG8_STAGE
#undef PG8_LDA
#undef PG8_LDB
#undef PG8_MMA
#undef PG8_WAIT_V
#undef PG8_WAIT_L
#undef PG8_BAR
#undef PG8_SCHED
}
}

constexpr size_t MiB = 1u << 20;
constexpr size_t WS_CTL = 0;
constexpr size_t WS_MOD = 1 * MiB;
constexpr size_t WS_MODP_OLD = 2 * MiB;
constexpr size_t WS_ROPE = 6 * MiB;
constexpr size_t WS_KMEAN = 8 * MiB;
constexpr size_t WS_WAIN = 16 * MiB;
constexpr size_t WS_WAO = WS_WAIN + 2 * (size_t)A_INP * D_ * 2;
constexpr size_t WS_WBIN = WS_WAO + 2 * (size_t)D_ * D_ * 2;
constexpr size_t WS_WBO = WS_WBIN + 2 * (size_t)B_IN * D_ * 2;
constexpr size_t WS_WF1 = WS_WBO + 2 * (size_t)D_ * D_ * 2;
constexpr size_t WS_WF2 = WS_WF1 + 4 * (size_t)2 * DFF * D_ * 2;
constexpr size_t WS_H = WS_WF2 + 4 * (size_t)D_ * DFF * 2;
constexpr size_t WS_Q = WS_H + (size_t)S_ * D_ * 2;
constexpr size_t WS_K = WS_Q + (size_t)S_ * D_ * 2;
constexpr size_t WS_V = WS_K + (size_t)S_ * D_ * 2;
constexpr size_t WS_QI = WS_V + (size_t)S_ * D_ * 2;
constexpr size_t WS_KI = WS_QI + (size_t)S_ * 1024 * 2;
constexpr size_t WS_WI = WS_KI + (size_t)S_ * 64 * 2;
constexpr size_t WS_SEL = WS_WI + (size_t)S_ * 16 * 4;
constexpr size_t WS_O = WS_SEL + (size_t)S_ * NSEL * 4;
constexpr size_t WS_Y = WS_O + (size_t)S_ * D_ * 2;
constexpr size_t WS_ACT = WS_Y + (size_t)S_ * D_ * 4;
constexpr size_t WS_LIST = WS_ACT + (size_t)S_ * DFF * 2;
constexpr size_t WS_PO = WS_LIST + (size_t)16 * 32 * 8192 * 2;
constexpr size_t WS_PML = WS_PO + (size_t)S_ * 16 * 3 * 128 * 2;
constexpr size_t WS_SC = WS_PML + (size_t)S_ * 16 * 3 * 2 * 4;
constexpr size_t WS_PB = WS_SC + (size_t)65792 * 2048;
constexpr size_t WS_END = WS_PB + (size_t)128 * 65536 * 4;
constexpr size_t WS_MODP = WS_PB;
constexpr int CW_CONVQ = 17408;
constexpr int CW_SPLIT = 16384;
constexpr size_t WS_KMH = 9 * MiB, WS_KML = 10 * MiB;
constexpr size_t WS_SEL3 = 11 * MiB;
constexpr int CW_DSAQ = 12288;
constexpr size_t WS_KSUM = 512 * 1024;
constexpr int CW_MCNT = 8192;

struct P {
    const float *x, *c; const int* pos; const float *a_w_in, *a_w_o, *b_w_in, *b_w_o, *ada_w, *ada_b, *norm_g, *ffn_w_in, *ffn_w_out;
    float* out; unsigned char* ws;
};

template <int MAP> __device__ __forceinline__ void transpose_item(const float* W, int K, int N, f16_t* WT, LAS float* scr, int item, int nblk, int lane) {
    const int kb = item / nblk, nb = item % nblk, k0 = 64 * kb, n0 = 32 * nb;
    const int ncol = n0 + (lane & 31); const bool ok = ncol < N;
#pragma unroll 8
    for (int i = 0; i < 32; ++i) { const int kk = 2 * i + (lane >> 5); scr[kk * 33 + (lane & 31)] = ok ? W[(size_t)(k0 + kk) * N + ncol] : 0.f; }
    asm volatile("s_waitcnt lgkmcnt(0)" ::: "memory");
    const int c = lane & 7;
#pragma unroll
    for (int j = 0; j < 4; ++j) { const int n = (lane >> 3) + 8 * j; const LAS float* s = scr + (8 * c) * 33 + n;
        u32x4 o; o.x = pk_f16(s[0 * 33], s[1 * 33]); o.y = pk_f16(s[2 * 33], s[3 * 33]); o.z = pk_f16(s[4 * 33], s[5 * 33]); o.w = pk_f16(s[6 * 33], s[7 * 33]);
        int nn = n0 + n, row;
        if (MAP == 1) { const int isg = nn >= DFF ? 1 : 0, cc = nn - isg * DFF; row = (cc >> 7) * 256 + isg * 128 + (cc & 127); } else row = nn;
        *(u32x4*)(WT + (size_t)row * K + k0 + 8 * c) = o; }
    asm volatile("s_waitcnt lgkmcnt(0)" ::: "memory");
}


#define XB_TMO      128
#define XB_XCNT(j)  (256  + 64 * (j))
#define XB_XSUB(j)  (1280 + 64 * (j))
#define XB_XGEN(j)  (2304 + 64 * (j))
#define XB_TOP      3328
#define XB_TOPGEN   3392
#define XCD_BAR_WORDS 3456
#define XB_SPIN_CAP (1u << 22)
__device__ __forceinline__ unsigned xb_ld(unsigned* p)              { return __hip_atomic_load(p, __ATOMIC_RELAXED, __HIP_MEMORY_SCOPE_AGENT); }
__device__ __forceinline__ unsigned xb_add(unsigned* p, unsigned v) { return __hip_atomic_fetch_add(p, v, __ATOMIC_RELAXED, __HIP_MEMORY_SCOPE_AGENT); }
__device__ __forceinline__ unsigned xb_xcc_id() { return (unsigned)__builtin_amdgcn_s_getreg((3 << 11) | 20) & 0xFu; }
#define XB_SPIN(cond, bar) do { unsigned _sp = 0; while (cond) { __builtin_amdgcn_s_sleep(1); \
    if ((++_sp & 255u) == 0u) { if (xb_ld(&(bar)[XB_TMO])) break; if (_sp > XB_SPIN_CAP) { atomicAdd(&(bar)[XB_TMO], 1u); break; } } } } while (0)
struct XcdBarrier { unsigned* bar; unsigned x; volatile LAS unsigned* st; };
__device__ __forceinline__ XcdBarrier xcd_barrier_post(unsigned* bar, volatile LAS unsigned* st) {
    XcdBarrier b; b.bar = bar; b.x = xb_xcc_id(); b.st = st;
    if (threadIdx.x == 0) (void)xb_add(&bar[XB_XCNT(b.x)], 1u);
    return b;
}
__device__ __forceinline__ void xcd_barrier_complete(unsigned* bar, unsigned x, unsigned& nloc, unsigned& nx) {
    const unsigned G = gridDim.x * gridDim.y * gridDim.z;
    unsigned sum, cnt, mine, sp = 0u;
    for (;;) {
        sum = 0u; cnt = 0u; mine = 0u;
#pragma unroll
        for (unsigned j = 0; j < 16; ++j) { const unsigned c = xb_ld(&bar[XB_XCNT(j)]); sum += c; cnt += (c > 0u) ? 1u : 0u; mine = (j == x) ? c : mine; }
        if (sum == G) break;
        __builtin_amdgcn_s_sleep(1);
        if ((++sp & 255u) == 0u) { if (xb_ld(&bar[XB_TMO])) break; if (sp > XB_SPIN_CAP) { atomicAdd(&bar[XB_TMO], 1u); break; } }
    }
    nloc = mine > 0u ? mine : 1u; nx = cnt > 0u ? cnt : 1u;
}
__device__ __forceinline__ void xcd_barrier(const XcdBarrier& b) {
    asm volatile("s_waitcnt vmcnt(0)" ::: "memory");
    __syncthreads();
    if (threadIdx.x == 0) {
        unsigned* bar = b.bar;
        __builtin_amdgcn_s_waitcnt(0);
        unsigned nloc = b.st[0], nx = b.st[1];
        if (nloc == 0u) { xcd_barrier_complete(bar, b.x, nloc, nx); b.st[0] = nloc; b.st[1] = nx; }
        const unsigned old = xb_add(&bar[XB_XSUB(b.x)], 1u);
        const unsigned gen = old / nloc;
        if (old + 1u == (gen + 1u) * nloc) {
            __builtin_amdgcn_fence(__ATOMIC_RELEASE, "agent");
            asm volatile("s_waitcnt vmcnt(0)" ::: "memory");
            const unsigned og = xb_add(&bar[XB_TOP], 1u);
            const unsigned tg = og / nx;
            if (og + 1u == (tg + 1u) * nx) xb_add(&bar[XB_TOPGEN], 1u);
            else XB_SPIN(xb_ld(&bar[XB_TOPGEN]) == tg, bar);
            __builtin_amdgcn_fence(__ATOMIC_ACQUIRE, "agent");
            xb_add(&bar[XB_XGEN(b.x)], 1u);
            asm volatile("s_waitcnt vmcnt(0)" ::: "memory");
        } else {
            XB_SPIN(xb_ld(&bar[XB_XGEN(b.x)]) == gen, bar);
            __builtin_amdgcn_fence(__ATOMIC_ACQUIRE, "agent");
            asm volatile("s_waitcnt vmcnt(0)" ::: "memory");
        }
    }
    __syncthreads();
}

constexpr int LDS_RING = 131072, LDS_MISC = LDS_RING, LDS_BYTES = 147456;
template <int MAP, bool NT> __device__ __forceinline__ void transpose_item64(const float* W, int K, int N, f16_t* WT, LAS float* scr, int item, int nblk, int lane) {
    const int kb = item / nblk, nb = item % nblk, k0 = 64 * kb, n0 = 64 * nb;
    const int r4 = lane >> 4, c4 = lane & 15, ncol = n0 + 4 * c4; const bool ok = ncol < N;
    f32x4 v[16];
#pragma unroll
    for (int i = 0; i < 16; ++i) { const f32x4* wp = (const f32x4*)(W + (size_t)(k0 + 4 * i + r4) * N + ncol); v[i] = ok ? (NT ? __builtin_nontemporal_load(wp) : *wp) : (f32x4){0.f, 0.f, 0.f, 0.f}; }
    __builtin_amdgcn_sched_barrier(0);
#pragma unroll
    for (int i = 0; i < 16; ++i) { const int kk = 4 * i + r4; *(LAS f32x4*)(scr + kk * 64 + ((4 * c4) ^ (8 * (kk >> 3)))) = v[i]; }
    asm volatile("s_waitcnt lgkmcnt(0)" ::: "memory");
    const int c = lane & 7;
#pragma unroll
    for (int j = 0; j < 8; ++j) { const int n = (lane >> 3) + 8 * j; const LAS float* s = scr + (8 * c) * 64 + (n ^ (8 * c));
        u32x4 o; o.x = pk_f16(s[0 * 64], s[1 * 64]); o.y = pk_f16(s[2 * 64], s[3 * 64]); o.z = pk_f16(s[4 * 64], s[5 * 64]); o.w = pk_f16(s[6 * 64], s[7 * 64]);
        int nn = n0 + n, row;
        if (MAP == 1) { const int isg = nn >= DFF ? 1 : 0, cc = nn - isg * DFF; row = (cc >> 7) * 256 + isg * 128 + (cc & 127); } else row = nn;
        if (NT) __builtin_nontemporal_store(o, (u32x4*)(WT + (size_t)row * K + k0 + 8 * c)); else *(u32x4*)(WT + (size_t)row * K + k0 + 8 * c) = o; }
    asm volatile("s_waitcnt lgkmcnt(0)" ::: "memory");
}

namespace cv {
constexpr int NB_A = A_INP / 64, I_A = (D_ / 64) * NB_A;
constexpr int NB_O = D_ / 64, I_O = (D_ / 64) * NB_O;
constexpr int NB_B = B_IN / 64, I_B = (D_ / 64) * NB_B;
constexpr int NB_1 = 2 * DFF / 64, I_1 = (D_ / 64) * NB_1;
constexpr int NB_2 = D_ / 64, I_2 = (DFF / 64) * NB_2;
constexpr int O_A = 0, O_AO = O_A + 2 * I_A, O_B = O_AO + 2 * I_O, O_BO = O_B + 2 * I_B, O_1 = O_BO + 2 * I_O, O_2 = O_1 + 4 * I_1, TOT = O_2 + 4 * I_2;
constexpr int N_LA = I_A + I_O + I_1 + I_2, N_LB = I_B + I_O + I_1 + I_2;
}
__device__ __forceinline__ int conv_map_a(int j, int la, int l) { using namespace cv;
    if (j < I_A) return O_A + la * I_A + j; j -= I_A; if (j < I_O) return O_AO + la * I_O + j; j -= I_O; if (j < I_1) return O_1 + l * I_1 + j; j -= I_1; return O_2 + l * I_2 + j; }
__device__ __forceinline__ int conv_map_b(int j, int lb, int l) { using namespace cv;
    if (j < I_B) return O_B + lb * I_B + j; j -= I_B; if (j < I_O) return O_BO + lb * I_O + j; j -= I_O; if (j < I_1) return O_1 + l * I_1 + j; j -= I_1; return O_2 + l * I_2 + j; }
__device__ __forceinline__ int conv_count(int stage) { return stage == 0 ? cv::N_LA : stage == 1 ? cv::N_LB + cv::N_LA : cv::N_LB; }
__device__ __forceinline__ int conv_map(int stage, int j) {
    if (stage == 0) return conv_map_a(j, 0, 0);
    if (stage == 1) return j < cv::N_LB ? conv_map_b(j, 0, 1) : conv_map_a(j - cv::N_LB, 1, 2);
    return conv_map_b(j, 1, 3);
}
template <bool NT> __device__ __forceinline__ void conv_item(const P& p, LAS float* scr, int it, int lane) {
    using namespace cv; unsigned char* ws = p.ws; int r = it;
    if (r < 2 * I_A) { const int l = r / I_A; transpose_item64<0, NT>(p.a_w_in + (size_t)l * D_ * A_IN, D_, A_IN, (f16_t*)(ws + WS_WAIN) + (size_t)l * A_INP * D_, scr, r % I_A, NB_A, lane); return; } r -= 2 * I_A;
    if (r < 2 * I_O) { const int l = r / I_O; transpose_item64<0, NT>(p.a_w_o + (size_t)l * D_ * D_, D_, D_, (f16_t*)(ws + WS_WAO) + (size_t)l * D_ * D_, scr, r % I_O, NB_O, lane); return; } r -= 2 * I_O;
    if (r < 2 * I_B) { const int l = r / I_B; transpose_item64<0, NT>(p.b_w_in + (size_t)l * D_ * B_IN, D_, B_IN, (f16_t*)(ws + WS_WBIN) + (size_t)l * B_IN * D_, scr, r % I_B, NB_B, lane); return; } r -= 2 * I_B;
    if (r < 2 * I_O) { const int l = r / I_O; transpose_item64<0, NT>(p.b_w_o + (size_t)l * D_ * D_, D_, D_, (f16_t*)(ws + WS_WBO) + (size_t)l * D_ * D_, scr, r % I_O, NB_O, lane); return; } r -= 2 * I_O;
    if (r < 4 * I_1) { const int l = r / I_1; transpose_item64<1, NT>(p.ffn_w_in + (size_t)l * D_ * 2 * DFF, D_, 2 * DFF, (f16_t*)(ws + WS_WF1) + (size_t)l * 2 * DFF * D_, scr, r % I_1, NB_1, lane); return; } r -= 4 * I_1;
    { const int l = r / I_2; transpose_item64<0, NT>(p.ffn_w_out + (size_t)l * DFF * D_, DFF, D_, (f16_t*)(ws + WS_WF2) + (size_t)l * D_ * DFF, scr, r % I_2, NB_2, lane); }
}

__device__ __forceinline__ void phase_prologue(const P& p, LAS unsigned char* lds) {
    const int tid = otid(), lane = tid & 63, wave = tid >> 6; const int bid = obid();
    LAS float* scr = (LAS float*)(lds + wave * 16384);
    const int gw = bid * 8 + wave, NGW = gridDim.x * 8;
    unsigned char* ws = p.ws;
    { const int n0 = conv_count(0);
        for (int j = gw; j < n0; j += NGW) conv_item<false>(p, scr, conv_map(0, j), lane); }
    {
        float* part = (float*)(ws + WS_MODP);
        for (int it = gw; it < 4 * 32 * 48; it += NGW) {
            const int l = it / 1536, kc = (it % 1536) / 48, nc = it % 48;
            const float* W = p.ada_w + ((size_t)l * D_ + kc * 64) * 12288 + nc * 256 + 4 * lane;
            f32x4 a = {0.f, 0.f, 0.f, 0.f};
#pragma unroll 8
            for (int k = 0; k < 64; ++k) { const float cv = p.c[kc * 64 + k]; const float sv = cv / (1.0f + __expf(-cv)); a += sv * *(const f32x4*)(W + (size_t)k * 12288); }
            *(f32x4*)(part + ((size_t)(l * 32 + kc)) * 12288 + nc * 256 + 4 * lane) = a;
        }
    }
    {
        float* rcA = (float*)(ws + WS_ROPE); float* rsA = rcA + S_ * 16; float* rcI = rsA + S_ * 16; float* rsI = rcI + S_ * 8;
        for (int i = bid * 512 + tid; i < S_ * 24; i += gridDim.x * 512) {
            const int t = i / 24, j = i % 24; const double pos = (double)p.pos[t];
            if (j < 16) { const double ang = pos * pow(500000.0, -(double)j / 16.0); rcA[t * 16 + j] = (float)cos(ang); rsA[t * 16 + j] = (float)sin(ang); }
            else { const int jj = j - 16; const double ang = pos * pow(500000.0, -(double)jj / 8.0); rcI[t * 8 + jj] = (float)cos(ang); rsI[t * 8 + jj] = (float)sin(ang); }
        }
    }
}
__device__ __forceinline__ void phase_mod_reduce(const P& p) {
    const float* part = (const float*)(p.ws + WS_MODP);
    for (int i = obid() * 512 + otid(); i < 4 * 12288; i += gridDim.x * 512) {
        const int l = i / 12288, n = i % 12288; float s = p.ada_b[i];
#pragma unroll
        for (int kc = 0; kc < 32; ++kc) s += part[(size_t)(l * 32 + kc) * 12288 + n];
        ((float*)(p.ws + WS_MOD))[i] = s; }
}

__device__ __forceinline__ void nr_unpack8(const u32x4 w, f32x4& a, f32x4& b) {
    const unsigned w0 = w.x, w1 = w.y, w2 = w.z, w3 = w.w;
    const f16x2 h0 = __builtin_bit_cast(f16x2, w0), h1 = __builtin_bit_cast(f16x2, w1), h2 = __builtin_bit_cast(f16x2, w2), h3 = __builtin_bit_cast(f16x2, w3);
    a = (f32x4){(float)h0[0], (float)h0[1], (float)h1[0], (float)h1[1]}; b = (f32x4){(float)h2[0], (float)h2[1], (float)h3[0], (float)h3[1]};
}
template <bool HAS_Y, bool HAS_H, bool XI16, bool XO16>
__device__ __forceinline__ void norm_rows(const void* xin_, const f16_t* y, const float* gate, const float* gamY, void* xout_,
                                          const float* gamH, const float* sc, const float* sh, f16_t* hout) {
    const int tid_ = otid(); const int lane = tid_ & 63, gw = obid() * 8 + (tid_ >> 6), NGW = (int)gridDim.x * 8;
    f32x4 cA[8], cB[8], cC[8];
#pragma unroll
    for (int j = 0; j < 8; ++j) { const int o = 8 * lane + 512 * (j >> 1) + 4 * (j & 1);
        if (HAS_Y) cA[j] = *(const f32x4*)(gate + o) * *(const f32x4*)(gamY + o);
        if (HAS_H) { cB[j] = *(const f32x4*)(gamH + o) * (1.0f + *(const f32x4*)(sc + o)); cC[j] = *(const f32x4*)(sh + o); } }
    f32x4 xv[8], yv[8];
    for (int r = gw; r < S_; r += NGW) {
        const size_t o = (size_t)r * D_ + 8 * lane;
#pragma unroll
        for (int jj = 0; jj < 4; ++jj) {
            if (XI16) { const u32x4 xw = __builtin_nontemporal_load((const u32x4*)((const f16_t*)xin_ + o + 512 * jj)); nr_unpack8(xw, xv[2 * jj], xv[2 * jj + 1]); }
            else { xv[2 * jj] = *(const f32x4*)((const float*)xin_ + o + 512 * jj); xv[2 * jj + 1] = *(const f32x4*)((const float*)xin_ + o + 512 * jj + 4); }
            if (HAS_Y) { const u32x4 yw = __builtin_nontemporal_load((const u32x4*)(y + o + 512 * jj)); nr_unpack8(yw, yv[2 * jj], yv[2 * jj + 1]); } }
        __builtin_amdgcn_sched_barrier(0);
        if (HAS_Y) {
            float ss = 0.f;
#pragma unroll
            for (int j = 0; j < 8; ++j) ss += (yv[j].x * yv[j].x + yv[j].y * yv[j].y) + (yv[j].z * yv[j].z + yv[j].w * yv[j].w);
            const float rstd = 1.0f / sqrtf(wave_sum(ss) * (1.0f / D_) + EPS);
#pragma unroll
            for (int j = 0; j < 8; ++j) xv[j] = xv[j] + cA[j] * (yv[j] * rstd);
#pragma unroll
            for (int jj = 0; jj < 4; ++jj) {
                if (XO16) { u32x4 w; w.x = pk_f16(xv[2 * jj].x, xv[2 * jj].y); w.y = pk_f16(xv[2 * jj].z, xv[2 * jj].w); w.z = pk_f16(xv[2 * jj + 1].x, xv[2 * jj + 1].y); w.w = pk_f16(xv[2 * jj + 1].z, xv[2 * jj + 1].w);
                    __builtin_nontemporal_store(w, (u32x4*)((f16_t*)xout_ + o + 512 * jj)); nr_unpack8(w, xv[2 * jj], xv[2 * jj + 1]); }
                else { __builtin_nontemporal_store(xv[2 * jj], (f32x4*)((float*)xout_ + o + 512 * jj)); __builtin_nontemporal_store(xv[2 * jj + 1], (f32x4*)((float*)xout_ + o + 512 * jj + 4)); } }
        }
        if (HAS_H) {
            float ss = 0.f;
#pragma unroll
            for (int j = 0; j < 8; ++j) ss += (xv[j].x * xv[j].x + xv[j].y * xv[j].y) + (xv[j].z * xv[j].z + xv[j].w * xv[j].w);
            const float rstd = 1.0f / sqrtf(wave_sum(ss) * (1.0f / D_) + EPS);
#pragma unroll
            for (int jj = 0; jj < 4; ++jj) { const f32x4 h0 = (xv[2 * jj] * rstd) * cB[2 * jj] + cC[2 * jj], h1 = (xv[2 * jj + 1] * rstd) * cB[2 * jj + 1] + cC[2 * jj + 1];
                u32x4 w; w.x = pk_f16(h0.x, h0.y); w.y = pk_f16(h0.z, h0.w); w.z = pk_f16(h1.x, h1.y); w.w = pk_f16(h1.z, h1.w); *(u32x4*)(hout + o + 512 * jj) = w; }
        }
        __builtin_amdgcn_sched_barrier(0);
    }
}
__device__ __forceinline__ void phase_norm(const P& p, int mode, int l) {
    const float* mod = (const float*)(p.ws + WS_MOD) + (size_t)l * 12288; const float* ng = p.norm_g + (size_t)l * 4 * D_;
    const f16_t* y = (const f16_t*)(p.ws + WS_Y); f16_t* H = (f16_t*)(p.ws + WS_H);
    f16_t* X16 = (f16_t*)(p.ws + WS_Y + (size_t)S_ * D_ * 2);
    if (mode == 0) norm_rows<false, true, false, false>(p.x, nullptr, nullptr, nullptr, nullptr, ng, mod + 1 * D_, mod + 0 * D_, H);
    else if (mode == 1) { if (l == 0) norm_rows<true, true, false, true>(p.x, y, mod + 2 * D_, ng + D_, X16, ng + 2 * D_, mod + 4 * D_, mod + 3 * D_, H);
                          else norm_rows<true, true, true, true>(X16, y, mod + 2 * D_, ng + D_, X16, ng + 2 * D_, mod + 4 * D_, mod + 3 * D_, H); }
    else { const float* modn = mod + 12288; const float* ngn = ng + 4 * D_;
        if (l < 3) norm_rows<true, true, true, true>(X16, y, mod + 5 * D_, ng + 3 * D_, X16, ngn, modn + 1 * D_, modn + 0 * D_, H);
        else norm_rows<true, false, true, false>(X16, y, mod + 5 * D_, ng + 3 * D_, p.out, nullptr, nullptr, nullptr, nullptr); }
}

__device__ __forceinline__ unsigned ordkey(float f) { const unsigned u = __float_as_uint(f); return (u & 0x80000000u) ? ~u : (u | 0x80000000u); }
__device__ __forceinline__ void phase_naive_topk(const P& p, LAS unsigned char* lds) {
    const int tid_ = otid(); const int half = tid_ >> 8, tid = tid_ & 255, lane = tid & 63, wave = tid >> 6; const int bid = obid();
    LAS float* qi = (LAS float*)(lds + half * 40960); LAS float* wv = qi + 1024; LAS unsigned* keys = (LAS unsigned*)(wv + 16); LAS unsigned* red = keys + S_;
    const f16_t* KI = (const f16_t*)(p.ws + WS_KI);
    for (int t0 = bid * 2; t0 < S_; t0 += gridDim.x * 2) {
        const int t = t0 + half;
        const f16_t* QI = (const f16_t*)(p.ws + WS_QI) + (size_t)t * 1024; const float* WI = (const float*)(p.ws + WS_WI) + (size_t)t * 16;
        int* sel = (int*)(p.ws + WS_SEL) + (size_t)t * NSEL;
        for (int i = tid; i < 1024; i += 256) qi[i] = h2f(QI[i]);
        if (tid < 16) wv[tid] = WI[tid];
        __syncthreads();
        const int n = t + 1; const bool small = n <= NSEL;
        if (!small) for (int s = tid; s < n; s += 256) {
            float kk[64];
            const u32x4* kp = (const u32x4*)(KI + (size_t)s * 64);
#pragma unroll
            for (int c = 0; c < 8; ++c) { const u32x4 w = kp[c];
#pragma unroll
                for (int e = 0; e < 4; ++e) { kk[8 * c + 2 * e] = h2f((f16_t)(w[e] & 0xffff)); kk[8 * c + 2 * e + 1] = h2f((f16_t)(w[e] >> 16)); } }
            float sc = 0.f;
            for (int h = 0; h < 16; ++h) { float d = 0.f;
#pragma unroll
                for (int e = 0; e < 64; ++e) d = fmaf(qi[h * 64 + e], kk[e], d);
                sc = fmaf(wv[h], fmaxf(d, 0.f), sc); }
            keys[s] = ordkey(sc + 0.0f);
        }
        __syncthreads();
        unsigned prefix = 0u; int k = NSEL;
        for (int bit = 31; bit >= 0; --bit) {
            const unsigned want = (prefix >> bit) | 1u; int cnt = 0;
            if (!small) for (int s = tid; s < n; s += 256) cnt += ((keys[s] >> bit) == want) ? 1 : 0;
#pragma unroll
            for (int o = 1; o < 64; o <<= 1) cnt += __shfl_xor(cnt, o);
            if (lane == 0) red[wave] = (unsigned)cnt;
            __syncthreads();
            const int tot = (int)(red[0] + red[1] + red[2] + red[3]);
            __syncthreads();
            if (tot >= k) prefix |= (1u << bit); else k -= tot;
        }
        if (small) sel[tid] = tid < n ? tid : -1;
        else if (wave == 0) {
            int outc = 0, eqc = 0;
            for (int s0 = 0; s0 < n; s0 += 64) { const int s = s0 + lane; const unsigned key = s < n ? keys[s] : 0u; const bool gt = s < n && key > prefix, eq = s < n && key == prefix;
                const unsigned long long beq = __ballot(eq); const unsigned long long lt = (1ull << lane) - 1ull;
                const bool take = gt || (eq && (eqc + __popcll(beq & lt)) < k);
                const unsigned long long bt = __ballot(take);
                if (take) { const int pos = outc + __popcll(bt & lt); if (pos < NSEL) sel[pos] = s; }
                outc += __popcll(bt); eqc += __popcll(beq); }
        }
        __syncthreads();
    }
}
__device__ __forceinline__ void phase_naive_dsa_attn(const P& p, LAS unsigned char* lds) {
    const int tid_ = otid(); const int half = tid_ >> 8, tid = tid_ & 255, lane = tid & 63, wave = tid >> 6; const int bid = obid();
    LAS float* q = (LAS float*)(lds + half * 32768); LAS float* Sm = q + 2048; LAS int* sl = (LAS int*)(Sm + 16 * NSEL);
    const f16_t* K = (const f16_t*)(p.ws + WS_K); const f16_t* V = (const f16_t*)(p.ws + WS_V);
    for (int t0 = bid * 2; t0 < S_; t0 += gridDim.x * 2) {
        const int t = t0 + half;
        const f16_t* Q = (const f16_t*)(p.ws + WS_Q) + (size_t)t * 2048; const int* sel = (const int*)(p.ws + WS_SEL) + (size_t)t * NSEL;
        for (int i = tid; i < 2048; i += 256) q[i] = h2f(Q[i]);
        sl[tid] = sel[tid];
        __syncthreads();
        { const int key = sl[tid]; const bool valid = key >= 0 && key <= t; const float scale = 0.08838834764831845f;
            for (int g = 0; g < 4; ++g) { float kk[128];
                if (valid) { const u32x4* kp = (const u32x4*)(K + (size_t)key * 512 + g * 128);
#pragma unroll
                    for (int c = 0; c < 16; ++c) { const u32x4 w = kp[c];
#pragma unroll
                        for (int e = 0; e < 4; ++e) { kk[8 * c + 2 * e] = h2f((f16_t)(w[e] & 0xffff)); kk[8 * c + 2 * e + 1] = h2f((f16_t)(w[e] >> 16)); } } }
                for (int r = 0; r < 4; ++r) { const int h = 4 * g + r; float d = 0.f;
                    if (valid) {
#pragma unroll
                        for (int e = 0; e < 128; ++e) d = fmaf(q[h * 128 + e], kk[e], d); }
                    Sm[h * NSEL + tid] = valid ? d * scale : -INFINITY; } } }
        __syncthreads();
        for (int r = 0; r < 4; ++r) { const int h = 4 * wave + r; float v[4]; float mx = -INFINITY;
#pragma unroll
            for (int i = 0; i < 4; ++i) { v[i] = Sm[h * NSEL + lane + 64 * i]; mx = fmaxf(mx, v[i]); }
            mx = wave_max(mx); float sum = 0.f;
#pragma unroll
            for (int i = 0; i < 4; ++i) { v[i] = __expf(v[i] - mx); sum += v[i]; }
            sum = wave_sum(sum); const float inv = 1.0f / sum;
#pragma unroll
            for (int i = 0; i < 4; ++i) Sm[h * NSEL + lane + 64 * i] = v[i] * inv; }
        __syncthreads();
        { const int h = tid >> 4, dc = tid & 15, g = h >> 2; float acc[8];
#pragma unroll
            for (int e = 0; e < 8; ++e) acc[e] = 0.f;
            for (int k = 0; k < NSEL; ++k) { const float pr = Sm[h * NSEL + k]; if (pr == 0.f) continue; const int key = sl[k];
                const u32x4 w = *(const u32x4*)(V + (size_t)key * 512 + g * 128 + 8 * dc);
#pragma unroll
                for (int e = 0; e < 4; ++e) { acc[2 * e] = fmaf(pr, h2f((f16_t)(w[e] & 0xffff)), acc[2 * e]); acc[2 * e + 1] = fmaf(pr, h2f((f16_t)(w[e] >> 16)), acc[2 * e + 1]); } }
            u32x4 o; o.x = pk_f16(acc[0], acc[1]); o.y = pk_f16(acc[2], acc[3]); o.z = pk_f16(acc[4], acc[5]); o.w = pk_f16(acc[6], acc[7]);
            *(u32x4*)((f16_t*)(p.ws + WS_O) + (size_t)t * 2048 + h * 128 + 8 * dc) = o; }
        __syncthreads();
    }
}
__device__ __forceinline__ void phase_naive_moba_kmean(const P& p) {
    const int tid_ = otid(); const int sub = tid_ >> 7, d = tid_ & 127;
    for (int it = obid() * 4 + sub; it < 512; it += gridDim.x * 4) {
        const int n = it >> 4, h = it & 15; const f16_t* K = (const f16_t*)(p.ws + WS_K) + (size_t)n * 256 * 2048 + h * 128 + d;
        float s = 0.f; for (int i = 0; i < 256; ++i) s += h2f(K[(size_t)i * 2048]);
        ((float*)(p.ws + WS_KMEAN))[(size_t)it * 128 + d] = s * (1.0f / 256.0f); }
}
__device__ __forceinline__ void phase_naive_moba_attn(const P& p, LAS unsigned char* lds) {
    const int tid_ = otid(); const int half = tid_ >> 8, tid = tid_ & 255, lane = tid & 63, wave = tid >> 6; const int bid = obid();
    LAS float* q = (LAS float*)(lds + half * 8192); LAS float* gate = q + 128; LAS int* sb = (LAS int*)(gate + 32); LAS float* Sm = (LAS float*)(sb + 4); LAS float* red = Sm + 1024; LAS float* oacc = red + 8;
    const float* km = (const float*)(p.ws + WS_KMEAN);
    for (int it0 = bid * 2; it0 < S_ * 16; it0 += gridDim.x * 2) {
        const int it = it0 + half, t = it >> 4, h = it & 15, j = t >> 8;
        const f16_t* Q = (const f16_t*)(p.ws + WS_Q) + (size_t)t * 2048 + h * 128; const f16_t* K = (const f16_t*)(p.ws + WS_K) + h * 128; const f16_t* V = (const f16_t*)(p.ws + WS_V) + h * 128;
        if (tid < 128) q[tid] = h2f(Q[tid]);
        __syncthreads();
        if (tid < 32) { float g = -INFINITY; if (tid < j) { g = 0.f; const float* kp = km + ((size_t)tid * 16 + h) * 128; for (int d = 0; d < 128; ++d) g = fmaf(q[d], kp[d], g); } gate[tid] = g; }
        __syncthreads();
        if (tid == 0) { unsigned used = 0u;
            for (int s = 0; s < 3; ++s) { int best = -1; float bv = -INFINITY; for (int n = 0; n < 32; ++n) if (!((used >> n) & 1u) && n < j && (best < 0 || gate[n] > bv)) { best = n; bv = gate[n]; }
                sb[s] = best; if (best >= 0) used |= 1u << best; } }
        __syncthreads();
        const float scale = 0.08838834764831845f;
        for (int slot = 0; slot < 4; ++slot) { const int i = slot * 256 + tid; int key; bool valid;
            if (slot < 3) { valid = sb[slot] >= 0; key = (valid ? sb[slot] : 0) * 256 + tid; } else { key = j * 256 + tid; valid = key <= t; }
            float d = -INFINITY;
            if (valid) { d = 0.f; const u32x4* kp = (const u32x4*)(K + (size_t)key * 2048);
#pragma unroll
                for (int c = 0; c < 16; ++c) { const u32x4 w = kp[c];
#pragma unroll
                    for (int e = 0; e < 4; ++e) { d = fmaf(q[8 * c + 2 * e], h2f((f16_t)(w[e] & 0xffff)), d); d = fmaf(q[8 * c + 2 * e + 1], h2f((f16_t)(w[e] >> 16)), d); } }
                d *= scale; }
            Sm[i] = d; }
        __syncthreads();
        float mx = -INFINITY;
#pragma unroll
        for (int i = 0; i < 4; ++i) mx = fmaxf(mx, Sm[tid + 256 * i]);
        mx = wave_max(mx); if (lane == 0) red[wave] = mx; __syncthreads();
        mx = fmaxf(fmaxf(red[0], red[1]), fmaxf(red[2], red[3])); __syncthreads();
        float sum = 0.f;
#pragma unroll
        for (int i = 0; i < 4; ++i) { const float e = __expf(Sm[tid + 256 * i] - mx); Sm[tid + 256 * i] = e; sum += e; }
        sum = wave_sum(sum); if (lane == 0) red[wave] = sum; __syncthreads();
        const float inv = 1.0f / (red[0] + red[1] + red[2] + red[3]);
        { const int part = tid >> 6; float a0 = 0.f, a1 = 0.f;
            int blk; if (part < 3) blk = sb[part]; else blk = j;
            if (blk >= 0) for (int i = 0; i < 256; ++i) { const float pr = Sm[part * 256 + i]; if (pr == 0.f) continue; const int key = blk * 256 + i;
                const unsigned w = *(const unsigned*)(V + (size_t)key * 2048 + 2 * lane); a0 = fmaf(pr, h2f((f16_t)(w & 0xffff)), a0); a1 = fmaf(pr, h2f((f16_t)(w >> 16)), a1); }
            oacc[part * 128 + 2 * lane] = a0; oacc[part * 128 + 2 * lane + 1] = a1; }
        __syncthreads();
        if (tid < 64) { const float o0 = (oacc[2 * tid] + oacc[128 + 2 * tid] + oacc[256 + 2 * tid] + oacc[384 + 2 * tid]) * inv, o1 = (oacc[2 * tid + 1] + oacc[128 + 2 * tid + 1] + oacc[256 + 2 * tid + 1] + oacc[384 + 2 * tid + 1]) * inv;
            *(unsigned*)((f16_t*)(p.ws + WS_O) + (size_t)t * 2048 + h * 128 + 2 * tid) = pk_f16(o0, o1); }
        __syncthreads();
    }
}


typedef float f32x16 __attribute__((ext_vector_type(16)));
__device__ __forceinline__ unsigned lds_add(LAS unsigned* p, unsigned v) { return __hip_atomic_fetch_add(p, v, __ATOMIC_RELAXED, __HIP_MEMORY_SCOPE_WORKGROUP); }
__device__ __forceinline__ unsigned lds_or(LAS unsigned* p, unsigned v) { return __hip_atomic_fetch_or(p, v, __ATOMIC_RELAXED, __HIP_MEMORY_SCOPE_WORKGROUP); }
constexpr int IX_CAP = 1024;
template <int PASS>
__device__ __forceinline__ void idx_pass(const f16_t* __restrict__ KI, const f16x8 (&a)[4][4], const float (&w)[4][16], int t0g, int ntiles, int kq, int lane,
                                         LAS unsigned* hist, int qbase, const LAS int* tbv, LAS unsigned* candcnt,
                                         LAS unsigned* bm, LAS unsigned* cand_key, LAS unsigned short* cand_idx, float* __restrict__ SCu, int rowlen) {
    const int n = lane & 31, kh = lane >> 5;
    int tb[4];
    if (PASS == 2) {
#pragma unroll
        for (int pr = 0; pr < 4; ++pr) tb[pr] = tbv[qbase + 2 * pr + kh];
    }
    f16x8 b[4];
    { const f16_t* kb = KI + (size_t)(32 * (kq < ntiles ? kq : 0) + n) * 64 + 32 * kh;
#pragma unroll
        for (int s = 0; s < 4; ++s) b[s] = *(const f16x8*)(kb + 8 * s); }
    for (int kt = kq; kt < ntiles; kt += 4) {
        f16x8 bn[4];
        { const int ktn = (kt + 4 < ntiles) ? kt + 4 : kt; const f16_t* kb = KI + (size_t)(32 * ktn + n) * 64 + 32 * kh;
#pragma unroll
            for (int s = 0; s < 4; ++s) bn[s] = *(const f16x8*)(kb + 8 * s); }
        const int key = 32 * kt + n;
#pragma unroll
        for (int pr = 0; pr < 4; ++pr) {
            f32x16 c;
#pragma unroll
            for (int r = 0; r < 16; ++r) c[r] = 0.f;
#pragma unroll
            for (int s = 0; s < 4; ++s) c = __builtin_amdgcn_mfma_f32_32x32x16_f16(a[pr][s], b[s], c, 0, 0, 0);
            float sc = 0.f;
#pragma unroll
            for (int r = 0; r < 16; ++r) { const float cr_ = c[r]; const int ci_ = __builtin_bit_cast(int, cr_); const float rl = __builtin_bit_cast(float, ci_ > 0 ? ci_ : 0); sc = __builtin_fmaf(w[pr][r], rl, sc); }
            sc += 0.0f;
            const int ql = qbase + 2 * pr + kh;
            const int tq = t0g + 2 * pr + kh;
            const bool valid = key <= tq;
            const unsigned ok = ordkey(sc); const int bin = (int)(ok >> 20);
            if (PASS == 1) { SCu[ql * rowlen + key] = sc; if (valid) lds_add(hist + ql * 2048 + (bin >> 1), (bin & 1) ? 65536u : 1u); }
            else {
                const unsigned long long hm = __ballot(valid && bin > tb[pr]);
                if (n == 0) bm[ql * 256 + kt] = (unsigned)(hm >> (32 * kh));
                if (valid && bin == tb[pr]) { const unsigned slot = lds_add(candcnt + ql, 1u); if (slot < (unsigned)IX_CAP) { cand_key[ql * IX_CAP + slot] = ok; cand_idx[ql * IX_CAP + slot] = (unsigned short)key; } }
            }
        }
#pragma unroll
        for (int s = 0; s < 4; ++s) b[s] = bn[s];
    }
}
template <int STAGES> __device__ __forceinline__ void idx_unit(const P& p, LAS unsigned char* lds, int unit, int tid) {
    const int lane = tid & 63, wave = __builtin_amdgcn_readfirstlane(tid >> 6), group = wave & 1, kq = wave >> 1;
    const int t0 = unit * 16, t0g = t0 + 8 * group, qbase = 8 * group;
    const f16_t* QI = (const f16_t*)(p.ws + WS_QI); const f16_t* KI = (const f16_t*)(p.ws + WS_KI); const float* WI = (const float*)(p.ws + WS_WI);
    LAS unsigned* hist = (LAS unsigned*)lds;
    LAS unsigned* bm = (LAS unsigned*)lds;
    LAS unsigned* cand_key = (LAS unsigned*)(lds + 16384);
    LAS unsigned short* cand_idx = (LAS unsigned short*)(lds + 16384 + 65536);
    LAS int* tbv = (LAS int*)(lds + LDS_MISC + 256);
    LAS unsigned* above = (LAS unsigned*)(lds + LDS_MISC + 320);
    LAS unsigned* candcnt = (LAS unsigned*)(lds + LDS_MISC + 448);
    f16x8 a[4][4]; float w[4][16];
    { const int m = lane & 31, kh = lane >> 5, aa = m >> 3, him = (m >> 2) & 1, bb = m & 3;
#pragma unroll
        for (int pr = 0; pr < 4; ++pr) { const f16_t* qp = QI + (size_t)(t0g + 2 * pr + him) * 1024 + (4 * aa + bb) * 64 + 32 * kh;
#pragma unroll
            for (int s = 0; s < 4; ++s) a[pr][s] = *(const f16x8*)(qp + 8 * s);
            const float* wp = WI + (size_t)(t0g + 2 * pr + kh) * 16;
#pragma unroll
            for (int r4 = 0; r4 < 4; ++r4) { const f32x4 v = *(const f32x4*)(wp + 4 * r4); w[pr][4 * r4] = v.x; w[pr][4 * r4 + 1] = v.y; w[pr][4 * r4 + 2] = v.z; w[pr][4 * r4 + 3] = v.w; } } }
    const int ntiles = (t0 + 16 + 31) >> 5;
    { LAS u32x4* z = (LAS u32x4*)lds;
#pragma unroll
        for (int i = 0; i < 16; ++i) z[tid + 512 * i] = (u32x4){0u, 0u, 0u, 0u}; }
    __syncthreads();
    const int rowlen = ntiles * 32;
    float* SCu = (float*)(p.ws + WS_SC) + (size_t)((unit & 1) ? ((unit >> 1) + 1) * ((unit >> 1) + 1) : (unit >> 1) * ((unit >> 1) + 1)) * 512;
    idx_pass<1>(KI, a, w, t0g, ntiles, kq, lane, hist, qbase, tbv, candcnt, bm, cand_key, cand_idx, SCu, rowlen);
    __syncthreads();
    if (STAGES == 1) return;
#pragma unroll 1
    for (int i = 0; i < 2; ++i) {
        const int q = 2 * wave + i; const LAS unsigned* H = hist + q * 2048;
        unsigned sL = 0u;
#pragma unroll 8
        for (int k = 0; k < 32; ++k) { const unsigned v = H[2047 - 32 * lane - ((k + lane) & 31)]; sL += (v & 0xffffu) + (v >> 16); }
        const unsigned Pf = wave_scan_incl(sL);
        const unsigned total = lane_get(Pf, 63);
        int tbq = -1; unsigned ab = 0u;
        if (total >= (unsigned)NSEL) {
            const unsigned long long m1 = __ballot(Pf >= (unsigned)NSEL); const int Ls = __builtin_ctzll(m1);
            const unsigned ab0 = lane_get(Pf, Ls) - lane_get(sL, Ls);
            const int bin = 4095 - 64 * Ls - lane; const unsigned wv = H[bin >> 1]; const unsigned c = (bin & 1) ? (wv >> 16) : (wv & 0xffffu);
            const unsigned Pc = wave_scan_incl(c);
            const unsigned long long m2 = __ballot(ab0 + Pc >= (unsigned)NSEL); const int l2 = __builtin_ctzll(m2);
            tbq = 4095 - 64 * Ls - l2; ab = ab0 + lane_get(Pc, l2) - lane_get(c, l2);
        }
        if (lane == 0) { tbv[q] = tbq; above[q] = ab; candcnt[q] = 0u; }
    }
    __syncthreads();
    {
        const int q0 = 2 * wave; const int tb0 = tbv[q0], tb1 = tbv[q0 + 1];
        const float* row0 = SCu + q0 * rowlen; const float* row1 = row0 + rowlen;
        const int nch = (rowlen + 255) >> 8; unsigned cnt0 = 0u, cnt1 = 0u;
        const unsigned long long ltm = (1ull << lane) - 1ull;
        const int sh4 = 4 * (lane & 7);
#pragma unroll 1
        for (int c0 = 0; c0 < nch; c0 += 16) {
            f32x4 v0[16], v1[16];
#pragma unroll
            for (int j = 0; j < 16; ++j) { const int key = 256 * (c0 + j) + 4 * lane; const int kc = key < rowlen ? key : rowlen - 4; v0[j] = *(const f32x4*)(row0 + kc); v1[j] = *(const f32x4*)(row1 + kc); }
#pragma unroll
            for (int j = 0; j < 16; ++j) {
                if (c0 + j < nch) {
                    const int key = 256 * (c0 + j) + 4 * lane;
#pragma unroll
                    for (int rr = 0; rr < 2; ++rr) {
                        const int tq = t0 + q0 + rr, tb = rr ? tb1 : tb0, q = q0 + rr; const f32x4 vv = rr ? v1[j] : v0[j];
                        unsigned nb = 0u, cadd = 0u;
#pragma unroll
                        for (int e4 = 0; e4 < 4; ++e4) {
                            const float sv = vv[e4]; const unsigned ok = ordkey(sv); const int bin = (int)(ok >> 20); const bool valid = key + e4 <= tq;
                            nb |= (valid && bin > tb) ? (1u << e4) : 0u;
                            const bool cd = valid && bin == tb; const unsigned long long cm = __ballot(cd);
                            if (cd) { const unsigned slot = (rr ? cnt1 : cnt0) + cadd + (unsigned)__popcll(cm & ltm); if (slot < (unsigned)IX_CAP) { cand_key[q * IX_CAP + slot] = ok; cand_idx[q * IX_CAP + slot] = (unsigned short)(key + e4); } }
                            cadd += (unsigned)__popcll(cm);
                        }
                        if (rr) cnt1 += cadd; else cnt0 += cadd;
                        unsigned wd = nb << sh4;
                        wd |= (unsigned)__builtin_amdgcn_update_dpp(0, (int)wd, 0xB1, 0xF, 0xF, true);
                        wd |= (unsigned)__builtin_amdgcn_update_dpp(0, (int)wd, 0x4E, 0xF, 0xF, true);
                        wd |= (unsigned)__builtin_amdgcn_update_dpp(0, (int)wd, 0x141, 0xF, 0xF, true);
                        if ((lane & 7) == 0) bm[q * 256 + 8 * (c0 + j) + (lane >> 3)] = wd;
                    }
                }
            }
        }
        if (lane == 0) { candcnt[q0] = cnt0; candcnt[q0 + 1] = cnt1; }
    }
    __syncthreads();
    if (STAGES == 2) return;
#pragma unroll 1
    for (int i = 0; i < 2; ++i) {
        const int q = 2 * wave + i; const int t = t0 + q;
        const int nc = (int)min(candcnt[q], (unsigned)IX_CAP); const int tbq = tbv[q];
        const int need = (tbq >= 0) ? (NSEL - (int)above[q]) : 0;
        const LAS unsigned* ck = cand_key + q * IX_CAP; const LAS unsigned short* ci = cand_idx + q * IX_CAP;
        if (need > 0) {
            unsigned prefix = 0u; int kk = need;
            for (int bit = 19; bit >= 0; --bit) { const unsigned want = (prefix >> bit) | 1u; int cnt = 0;
                for (int c0 = 0; c0 < nc; c0 += 64) { const int c = c0 + lane; const bool hit = c < nc && (((ck[c] & 0xfffffu) >> bit) == want); cnt += __popcll(__ballot(hit)); }
                if (cnt >= kk) prefix |= (1u << bit); else kk -= cnt; }
            int neq = 0;
            for (int c0 = 0; c0 < nc; c0 += 64) { const int c = c0 + lane; neq += __popcll(__ballot(c < nc && (ck[c] & 0xfffffu) == prefix)); }
            for (int c0 = 0; c0 < nc; c0 += 64) { const int c = c0 + lane; const bool act = c < nc;
                const unsigned mk = act ? (ck[c] & 0xfffffu) : 0u; const unsigned mi = act ? ci[c] : 0u;
                bool take = act && mk > prefix;
                if (neq == kk) take = take || (act && mk == prefix);
                else if (__ballot(act && mk == prefix)) { int rank = 0;
                    for (int j = 0; j < nc; ++j) rank += ((ck[j] & 0xfffffu) == prefix && (unsigned)ci[j] < mi) ? 1 : 0;
                    take = take || (act && mk == prefix && rank < kk); }
                if (take) lds_or(bm + q * 256 + (mi >> 5), 1u << (mi & 31)); }
        }
        asm volatile("s_waitcnt lgkmcnt(0)" ::: "memory");
        unsigned v[4]; int cn = 0;
#pragma unroll
        for (int k = 0; k < 4; ++k) { const int wd = 4 * lane + k; v[k] = (wd < ntiles) ? bm[q * 256 + wd] : 0u; cn += __popc(v[k]); }
        const int incl = (int)wave_scan_incl((unsigned)cn);
        const int total = (int)lane_get((unsigned)incl, 63); int pos = incl - cn;
        int* sel = (int*)(p.ws + WS_SEL) + (size_t)t * NSEL;
#pragma unroll
        for (int k = 0; k < 4; ++k) { unsigned x = v[k]; while (x) { const int b = __builtin_ctz(x); x &= x - 1u; if (pos < NSEL) sel[pos] = 32 * (4 * lane + k) + b; ++pos; } }
#pragma unroll
        for (int k = 0; k < 4; ++k) { const int ps = lane + 64 * k; if (ps >= total) sel[ps] = -1; }
    }
    __syncthreads();
}
template <int STAGES> __device__ __forceinline__ void phase_idx_topk(const P& p, LAS unsigned char* lds, int cstage) {
    const int tid = otid(), bid = obid();
    const int G8 = (int)gridDim.x * 8, ccount = cstage >= 0 ? conv_count(cstage) : 0, R = (ccount + G8 - 1) / G8;
    int r = 0, slot = 0;
    for (int pi = bid; pi < 256; pi += (int)gridDim.x) {
#pragma unroll 1
        for (int half = 0; half < 2; ++half) {
            idx_unit<STAGES>(p, lds, half ? 511 - pi : pi, tid);
            ++slot; const int rend = (pi + (int)gridDim.x < 256 || half == 0) ? min(R, (R * slot + 1) / 2) : R;
            if (r < rend) {
                const int t2 = otid(), lane = t2 & 63, wave = __builtin_amdgcn_readfirstlane(t2 >> 6);
                for (; r < rend; ++r) { const int j = (r * (int)gridDim.x + bid) * 8 + wave; if (j < ccount) conv_item<true>(p, (LAS float*)(lds + wave * 16384), conv_map(cstage, j), lane); }
                __syncthreads();
            }
        }
    }
}

__device__ __forceinline__ void phase_dsa_attn(const P& p, LAS unsigned char* lds) {
    const int tid = otid(), lane = tid & 63, wave = __builtin_amdgcn_readfirstlane(tid >> 6), bid = obid();
    const int n = lane & 15, kq = lane >> 4;
    LAS unsigned char* Pl = lds + wave * 9216;
    LAS int* sl = (LAS int*)(Pl + 8192);
    const f16_t* Qb = (const f16_t*)(p.ws + WS_Q); const f16_t* Kb = (const f16_t*)(p.ws + WS_K); const f16_t* Vb = (const f16_t*)(p.ws + WS_V);
    const int* SELb = (const int*)(p.ws + WS_SEL); f16_t* Ob = (f16_t*)(p.ws + WS_O);
    const float scale = 0.08838834764831845f;
    for (int t = bid * 8 + wave; t < S_; t += (int)gridDim.x * 8) {
        { const u32x4 v = *(const u32x4*)(SELb + (size_t)t * NSEL + 4 * lane); *(LAS u32x4*)(sl + 4 * lane) = v; }
        f16x8 A[16];
        { const f16_t* qp = Qb + (size_t)t * 2048 + n * 128 + 8 * kq; f16x8 qr[4]; f16x8 zero;
#pragma unroll
            for (int j = 0; j < 8; ++j) zero[j] = (_Float16)0.f;
#pragma unroll
            for (int s4 = 0; s4 < 4; ++s4) qr[s4] = *(const f16x8*)(qp + 32 * s4);
#pragma unroll
            for (int s = 0; s < 16; ++s) A[s] = ((n >> 2) == (s >> 2)) ? qr[s & 3] : zero; }
        asm volatile("s_waitcnt lgkmcnt(0)" ::: "memory");
        f32x4 Sg[16];
#pragma unroll
        for (int tile = 0; tile < 16; ++tile) {
            const int key = sl[16 * tile + n]; const bool valid = key >= 0; const int kc = valid ? key : 0;
            const f16_t* kp = Kb + (size_t)kc * 512 + 8 * kq;
            f32x4 c = {0.f, 0.f, 0.f, 0.f};
#pragma unroll
            for (int s = 0; s < 16; ++s) { const f16x8 b = *(const f16x8*)(kp + 32 * s); c = __builtin_amdgcn_mfma_f32_16x16x32_f16(A[s], b, c, 0, 0, 0); }
#pragma unroll
            for (int i = 0; i < 4; ++i) Sg[tile][i] = valid ? c[i] * scale : -INFINITY;
        }
        float mx[4], lsum[4];
#pragma unroll
        for (int i = 0; i < 4; ++i) { float m = Sg[0][i];
#pragma unroll
            for (int tile = 1; tile < 16; ++tile) m = fmaxf(m, Sg[tile][i]);
            m = fmaxf(m, __shfl_xor(m, 1)); m = fmaxf(m, __shfl_xor(m, 2)); m = fmaxf(m, __shfl_xor(m, 4)); m = fmaxf(m, __shfl_xor(m, 8)); mx[i] = m; lsum[i] = 0.f; }
#pragma unroll
        for (int tile = 0; tile < 16; ++tile) { float pv[4];
#pragma unroll
            for (int i = 0; i < 4; ++i) { pv[i] = __expf(Sg[tile][i] - mx[i]); lsum[i] += pv[i]; }
            u32x2 w; w.x = pk_f16(pv[0], pv[1]); w.y = pk_f16(pv[2], pv[3]);
            *(LAS u32x2*)(Pl + (16 * tile + n) * 32 + kq * 8) = w; }
        float inv[4];
#pragma unroll
        for (int i = 0; i < 4; ++i) { float l = lsum[i]; l += __shfl_xor(l, 1); l += __shfl_xor(l, 2); l += __shfl_xor(l, 4); l += __shfl_xor(l, 8); inv[i] = 1.0f / l; }
        asm volatile("s_waitcnt lgkmcnt(0)" ::: "memory");
        float acc[4][8];
#pragma unroll
        for (int r = 0; r < 4; ++r)
#pragma unroll
            for (int j = 0; j < 8; ++j) acc[r][j] = 0.f;
#pragma unroll 8
        for (int k = 0; k < NSEL; ++k) {
            const int key = __builtin_amdgcn_readfirstlane(sl[k]); const int kc = key < 0 ? 0 : key;
            const f16x8 v = *(const f16x8*)(Vb + (size_t)kc * 512 + 8 * lane);
            const f16x4 pr = *(const LAS f16x4*)(Pl + k * 32 + kq * 8);
#pragma unroll
            for (int r = 0; r < 4; ++r)
#pragma unroll
                for (int j = 0; j < 8; ++j) acc[r][j] = __builtin_fmaf((float)pr[r], (float)v[j], acc[r][j]);
        }
#pragma unroll
        for (int r = 0; r < 4; ++r) { u32x4 o; o.x = pk_f16(acc[r][0] * inv[r], acc[r][1] * inv[r]); o.y = pk_f16(acc[r][2] * inv[r], acc[r][3] * inv[r]);
            o.z = pk_f16(acc[r][4] * inv[r], acc[r][5] * inv[r]); o.w = pk_f16(acc[r][6] * inv[r], acc[r][7] * inv[r]);
            *(u32x4*)(Ob + (size_t)t * 2048 + (4 * kq + r) * 128 + 8 * n) = o; }
        asm volatile("s_waitcnt lgkmcnt(0)" ::: "memory");
    }
}

typedef short s16x4 __attribute__((ext_vector_type(4)));
__device__ __forceinline__ unsigned off_b(unsigned row, unsigned ch) { return 256u * row + 16u * (ch ^ (((row & 3u) << 2) | ((row >> 2) & 3u))); }
__device__ __forceinline__ f16x4 tr16(const LAS unsigned char* p) { return __builtin_bit_cast(f16x4, __builtin_amdgcn_ds_read_tr16_b64_v4i16((LAS s16x4*)p)); }
__device__ __forceinline__ int crow(int i, int h) { return (i & 3) + 8 * (i >> 2) + 4 * h; }
__device__ __forceinline__ void phase_moba_kmean(const P& p) {
    const int tid_ = otid(); const int sub = tid_ >> 7, d = tid_ & 127;
    for (int it = obid() * 4 + sub; it < 512; it += (int)gridDim.x * 4) {
        const int n = it >> 4, h = it & 15; const f16_t* K = (const f16_t*)(p.ws + WS_K) + (size_t)n * 256 * 2048 + h * 128 + d;
        float s = 0.f; for (int i = 0; i < 256; ++i) s += h2f(K[(size_t)i * 2048]);
        s *= (1.0f / 256.0f);
        const _Float16 hi = (_Float16)s; const _Float16 lo = (_Float16)(s - (float)hi);
        ((_Float16*)(p.ws + WS_KMH))[((size_t)h * 32 + n) * 128 + d] = hi; ((_Float16*)(p.ws + WS_KML))[((size_t)h * 32 + n) * 128 + d] = lo; }
}
__device__ __forceinline__ void phase_moba_gate(const P& p, int lb) {
    const int tid = otid(), lane = tid & 63, wave = __builtin_amdgcn_readfirstlane(tid >> 6), bid = obid();
    const int r = lane & 31, hh = lane >> 5;
    const f16_t* Qb = (const f16_t*)(p.ws + WS_Q); const float* KS = (const float*)(p.ws + WS_KSUM) + (size_t)lb * 65536;
    unsigned* SEL3 = (unsigned*)(p.ws + WS_SEL3); unsigned short* LIST = (unsigned short*)(p.ws + WS_LIST); unsigned* CNT = (unsigned*)(p.ws + WS_CTL) + CW_MCNT + lb * 512;
    for (int it = bid * 8 + wave; it < 256 * 16; it += (int)gridDim.x * 8) {
        const int qt = it >> 4, h = it & 15, t = qt * 32 + r, j = t >> 8;
        f32x16 g;
#pragma unroll
        for (int i = 0; i < 16; ++i) g[i] = 0.f;
        const f16_t* qp = Qb + (size_t)t * 2048 + h * 128 + 8 * hh; const float* kp = KS + ((size_t)h * 32 + r) * 128 + 8 * hh;
        f16x8 qfr[8]; f32x4 kr0[8], kr1[8];
#pragma unroll
        for (int st = 0; st < 8; ++st) { qfr[st] = *(const f16x8*)(qp + 16 * st); kr0[st] = *(const f32x4*)(kp + 16 * st); kr1[st] = *(const f32x4*)(kp + 16 * st + 4); }
        __builtin_amdgcn_sched_barrier(0);
#pragma unroll
        for (int st = 0; st < 8; ++st) { const f16x8 qf = qfr[st];
            const f32x4 k0 = kr0[st] * (1.0f / 256.0f), k1 = kr1[st] * (1.0f / 256.0f);
            f16x8 kh, kl;
#pragma unroll
            for (int e = 0; e < 4; ++e) { kh[e] = (_Float16)k0[e]; kl[e] = (_Float16)(k0[e] - (float)kh[e]); kh[4 + e] = (_Float16)k1[e]; kl[4 + e] = (_Float16)(k1[e] - (float)kh[4 + e]); }
            g = __builtin_amdgcn_mfma_f32_32x32x16_f16(kh, qf, g, 0, 0, 0);
            g = __builtin_amdgcn_mfma_f32_32x32x16_f16(kl, qf, g, 0, 0, 0); }
        float bv[3] = {-INFINITY, -INFINITY, -INFINITY}; int bi[3] = {255, 255, 255};
#pragma unroll
        for (int i = 0; i < 16; ++i) { const int n = crow(i, hh); const float v = (n < j) ? g[i] : -INFINITY;
            const bool b0 = v > bv[0] || (v == bv[0] && n < bi[0]), b1 = v > bv[1] || (v == bv[1] && n < bi[1]), b2 = v > bv[2] || (v == bv[2] && n < bi[2]);
            if (n < j) {
                if (b0) { bv[2] = bv[1]; bi[2] = bi[1]; bv[1] = bv[0]; bi[1] = bi[0]; bv[0] = v; bi[0] = n; }
                else if (b1) { bv[2] = bv[1]; bi[2] = bi[1]; bv[1] = v; bi[1] = n; }
                else if (b2) { bv[2] = v; bi[2] = n; } } }
        float ov[3]; int oi[3];
#pragma unroll
        for (int k = 0; k < 3; ++k) { ov[k] = __shfl_xor(bv[k], 32); oi[k] = __shfl_xor(bi[k], 32); }
        int sel[3]; { int ia = 0, ib = 0;
#pragma unroll
            for (int k = 0; k < 3; ++k) { const float av = ia == 0 ? bv[0] : (ia == 1 ? bv[1] : bv[2]); const int ai = ia == 0 ? bi[0] : (ia == 1 ? bi[1] : bi[2]);
                const float cv = ib == 0 ? ov[0] : (ib == 1 ? ov[1] : ov[2]); const int ci = ib == 0 ? oi[0] : (ib == 1 ? oi[1] : oi[2]);
                const bool ta = av > cv || (av == cv && ai < ci);
                sel[k] = ta ? ai : ci; if (ta) ++ia; else ++ib; } }
        if (hh == 0) SEL3[(size_t)t * 16 + h] = (unsigned)sel[0] | ((unsigned)sel[1] << 8) | ((unsigned)sel[2] << 16);
#pragma unroll
        for (int k = 0; k < 3; ++k) {
            const int b = sel[k]; int cntv = 0, rank = 0, lead = 0;
            for (int nb = 0; nb < j; ++nb) { const unsigned mm = (unsigned)__ballot(b == nb);
                if (b == nb) { cntv = __popc(mm); rank = __popc(mm & ((1u << r) - 1u)); lead = __builtin_ctz(mm | 0x80000000u); } }
            unsigned base = 0u;
            if (hh == 0 && b != 255 && rank == 0) base = atomicAdd(CNT + h * 32 + b, (unsigned)cntv);
            base = (unsigned)__shfl((int)base, lead);
            if (hh == 0 && b != 255) LIST[((size_t)h * 32 + b) * 8192 + base + rank] = (unsigned short)(t | (k << 13));
        }
    }
}
template <bool CAUSAL>
__device__ __forceinline__ void moba_core(const f16x8 (&qf)[8], const LAS unsigned char* Kimg, const LAS unsigned char* Vimg, int lane, int ntile, int qin, float& m, float& l, f32x16 (&o)[4]) {
    const int r = lane & 31, hh = lane >> 5, blk = (lane >> 4) & 1, q4 = (lane & 15) >> 2, p4 = lane & 3;
    const float scale = 0.08838834764831845f;
    unsigned ka[8], va[4][2][2];
#pragma unroll
    for (int st = 0; st < 8; ++st) ka[st] = off_b(r, 2 * st + hh);
#pragma unroll
    for (int c = 0; c < 4; ++c)
#pragma unroll
        for (int s2 = 0; s2 < 2; ++s2)
#pragma unroll
            for (int t2 = 0; t2 < 2; ++t2) va[c][s2][t2] = off_b(16 * s2 + 8 * t2 + 4 * hh + q4, 4 * c + 2 * blk + (p4 >> 1)) + 8 * (p4 & 1);
    m = -INFINITY; l = 0.f;
#pragma unroll
    for (int c = 0; c < 4; ++c)
#pragma unroll
        for (int i = 0; i < 16; ++i) o[c][i] = 0.f;
    for (int kt = 0; kt < ntile; ++kt) {
        const LAS unsigned char* Kt = Kimg + kt * 8192; const LAS unsigned char* Vt = Vimg + kt * 8192;
        f32x16 sT; f16x8 kfr[8];
#pragma unroll
        for (int i = 0; i < 16; ++i) sT[i] = 0.f;
#pragma unroll
        for (int st = 0; st < 8; ++st) kfr[st] = *(const LAS f16x8*)(Kt + ka[st]);
        __builtin_amdgcn_sched_barrier(0);
#pragma unroll
        for (int st = 0; st < 8; ++st) sT = __builtin_amdgcn_mfma_f32_32x32x16_f16(kfr[st], qf[st], sT, 0, 0, 0);
        float tmax = -INFINITY;
#pragma unroll
        for (int i = 0; i < 16; ++i) { float v = sT[i] * scale; if (CAUSAL) { if (32 * kt + crow(i, hh) > qin) v = -INFINITY; } sT[i] = v; tmax = fmaxf(tmax, v); }
        f16x4 vfr[4][2][2];
#pragma unroll
        for (int c = 0; c < 4; ++c)
#pragma unroll
            for (int s2 = 0; s2 < 2; ++s2) { vfr[c][s2][0] = tr16(Vt + va[c][s2][0]); vfr[c][s2][1] = tr16(Vt + va[c][s2][1]); }
        __builtin_amdgcn_sched_barrier(0);
        tmax = xor32_max(tmax);
        const float mn = fmaxf(m, tmax);
        const float alpha = __expf(m - mn); m = mn;
        float ps = 0.f; f16x8 pf[2];
#pragma unroll
        for (int i = 0; i < 16; ++i) { const float e = __expf(sT[i] - mn); ps += e; pf[i >> 3][i & 7] = (_Float16)e; }
        l = l * alpha + ps;
#pragma unroll
        for (int c = 0; c < 4; ++c) {
#pragma unroll
            for (int i = 0; i < 16; ++i) o[c][i] *= alpha;
#pragma unroll
            for (int s2 = 0; s2 < 2; ++s2) {
                const f16x8 vf = __builtin_shufflevector(vfr[c][s2][0], vfr[c][s2][1], 0, 1, 2, 3, 4, 5, 6, 7);
                o[c] = __builtin_amdgcn_mfma_f32_32x32x16_f16(vf, pf[s2], o[c], 0, 0, 0); } }
    }
    l = xor32_sum(l);
}
__device__ __forceinline__ void moba_load_kv(const P& p, LAS unsigned char* lds, int h, int n, int tid) {
    const f16_t* Kg = (const f16_t*)(p.ws + WS_K) + (size_t)n * 256 * 2048 + h * 128; const f16_t* Vg = (const f16_t*)(p.ws + WS_V) + (size_t)n * 256 * 2048 + h * 128;
    u32x4 kr[8], vr[8];
#pragma unroll
    for (int i = 0; i < 8; ++i) { const int cid = tid + 512 * i, row = cid >> 4, ch = cid & 15;
        kr[i] = *(const u32x4*)(Kg + (size_t)row * 2048 + 8 * ch); vr[i] = *(const u32x4*)(Vg + (size_t)row * 2048 + 8 * ch); }
    __builtin_amdgcn_sched_barrier(0);
#pragma unroll
    for (int i = 0; i < 8; ++i) { const int cid = tid + 512 * i, row = cid >> 4, ch = cid & 15;
        *(LAS u32x4*)(lds + off_b(row, ch)) = kr[i]; *(LAS u32x4*)(lds + 65536 + off_b(row, ch)) = vr[i]; }
}
__device__ __forceinline__ void phase_moba_past(const P& p, LAS unsigned char* lds, int lb) {
    const int tid = otid(), lane = tid & 63, wave = __builtin_amdgcn_readfirstlane(tid >> 6), bid = obid();
    const int r = lane & 31, hh = lane >> 5;
    LAS int* start = (LAS int*)(lds + LDS_MISC + 1024);
    const unsigned* CNT = (const unsigned*)(p.ws + WS_CTL) + CW_MCNT + lb * 512;
    const unsigned short* LIST = (const unsigned short*)(p.ws + WS_LIST); const f16_t* Qb = (const f16_t*)(p.ws + WS_Q);
    f16_t* PO = (f16_t*)(p.ws + WS_PO); float* PML = (float*)(p.ws + WS_PML);
    { const int c = ((int)__hip_atomic_load(CNT + tid, __ATOMIC_RELAXED, __HIP_MEMORY_SCOPE_AGENT) + 255) >> 8; int incl = c;
#pragma unroll
        for (int o = 1; o < 64; o <<= 1) { const int tt = __shfl_up(incl, o); if (lane >= o) incl += tt; }
        LAS int* wsum = (LAS int*)(lds + LDS_MISC + 512);
        if (lane == 63) wsum[wave] = incl;
        __syncthreads();
        int base = 0;
#pragma unroll
        for (int w2 = 0; w2 < 8; ++w2) base += (w2 < wave) ? wsum[w2] : 0;
        start[tid] = base + incl - c; if (tid == 511) start[512] = base + incl;
        __syncthreads(); }
    const int total = start[512];
    const int ipw = (total + (int)gridDim.x - 1) / (int)gridDim.x, it0 = bid * ipw, it1 = (it0 + ipw < total) ? it0 + ipw : total;
    int cur = 0, loaded = -1;
    for (int it = it0; it < it1; ++it) {
        while (start[cur + 1] <= it) ++cur;
        const int h = cur >> 5, n = cur & 31, ck = it - start[cur]; const int cnt = (int)CNT[cur] - 256 * ck;
        const bool reload = cur != loaded;
        if (reload) { __syncthreads();
            moba_load_kv(p, lds, h, n, tid); loaded = cur; }
        const int row0 = 32 * wave; const bool active = row0 < cnt;
        const int ri = (row0 + r < cnt) ? row0 + r : (active ? row0 : 0);
        const unsigned e = LIST[(size_t)cur * 8192 + 256 * ck + ri]; const int t = e & 0x1fff, slot = e >> 13;
        f16x8 qf[8];
        { const f16_t* qp = Qb + (size_t)t * 2048 + h * 128 + 8 * hh;
#pragma unroll
            for (int st = 0; st < 8; ++st) qf[st] = *(const f16x8*)(qp + 16 * st); }
        if (reload) __syncthreads();
        if (active) {
            float m, l; f32x16 o[4];
            moba_core<false>(qf, lds, lds + 65536, lane, 8, 0, m, l, o);
            if (row0 + r < cnt) {
                const float inv = 1.0f / l; const size_t pi = ((size_t)t * 16 + h) * 3 + slot;
                if (hh == 0) { PML[pi * 2] = m; PML[pi * 2 + 1] = l; }
#pragma unroll
                for (int c = 0; c < 4; ++c)
#pragma unroll
                    for (int g4 = 0; g4 < 4; ++g4) { u32x2 w; w.x = pk_f16(o[c][4 * g4] * inv, o[c][4 * g4 + 1] * inv); w.y = pk_f16(o[c][4 * g4 + 2] * inv, o[c][4 * g4 + 3] * inv);
                        *(u32x2*)(PO + pi * 128 + 32 * c + 8 * g4 + 4 * hh) = w; }
            }
        }
    }
}
__device__ __forceinline__ void phase_moba_own(const P& p, LAS unsigned char* lds) {
    const int tid = otid(), lane = tid & 63, wave = __builtin_amdgcn_readfirstlane(tid >> 6), bid = obid();
    const int r = lane & 31, hh = lane >> 5;
    const f16_t* Qb = (const f16_t*)(p.ws + WS_Q); const f16_t* PO = (const f16_t*)(p.ws + WS_PO); const float* PML = (const float*)(p.ws + WS_PML);
    const unsigned* SEL3 = (const unsigned*)(p.ws + WS_SEL3); f16_t* Ob = (f16_t*)(p.ws + WS_O);
    for (int it = bid; it < 512; it += (int)gridDim.x) {
        const int h = it & 15, j = it >> 4;
        __syncthreads();
        moba_load_kv(p, lds, h, j, tid);
        const int qin = 32 * wave + r, t = 256 * j + qin;
        f16x8 qf[8];
        { const f16_t* qp = Qb + (size_t)t * 2048 + h * 128 + 8 * hh;
#pragma unroll
            for (int st = 0; st < 8; ++st) qf[st] = *(const f16x8*)(qp + 16 * st); }
        __syncthreads();
        float m, l; f32x16 o[4];
        moba_core<true>(qf, lds, lds + 65536, lane, wave + 1, qin, m, l, o);
        u32x2 pw[3][16];
#pragma unroll
        for (int k = 0; k < 3; ++k) { const size_t pi = ((size_t)t * 16 + h) * 3 + k;
#pragma unroll
            for (int c = 0; c < 4; ++c)
#pragma unroll
                for (int g4 = 0; g4 < 4; ++g4) pw[k][4 * c + g4] = *(const u32x2*)(PO + pi * 128 + 32 * c + 8 * g4 + 4 * hh); }
        const unsigned s3 = SEL3[(size_t)t * 16 + h];
        float ms[3], ls[3]; float M = m;
#pragma unroll
        for (int k = 0; k < 3; ++k) { const bool v = ((s3 >> (8 * k)) & 0xffu) != 0xffu; const size_t pi = ((size_t)t * 16 + h) * 3 + k;
            const float pm_ = PML[pi * 2], pl_ = PML[pi * 2 + 1];
            ms[k] = v ? pm_ : -INFINITY; ls[k] = v ? pl_ : 0.f; M = fmaxf(M, ms[k]); }
        __builtin_amdgcn_sched_barrier(0);
        const float w0 = l * __expf(m - M); float L = w0;
        const float a0 = __expf(m - M);
#pragma unroll
        for (int c = 0; c < 4; ++c)
#pragma unroll
            for (int i = 0; i < 16; ++i) o[c][i] *= a0;
#pragma unroll
        for (int k = 0; k < 3; ++k) { const float wk = ls[k] * __expf(ms[k] - M); L += wk;
            if (wk != 0.f) {
#pragma unroll
                for (int c = 0; c < 4; ++c)
#pragma unroll
                    for (int g4 = 0; g4 < 4; ++g4) { const u32x2 w = pw[k][4 * c + g4];
                        const unsigned wx = w.x, wy = w.y; const f16x2 x0 = __builtin_bit_cast(f16x2, wx), x1 = __builtin_bit_cast(f16x2, wy);
                        o[c][4 * g4] += wk * (float)x0[0]; o[c][4 * g4 + 1] += wk * (float)x0[1]; o[c][4 * g4 + 2] += wk * (float)x1[0]; o[c][4 * g4 + 3] += wk * (float)x1[1]; } } }
        const float inv = 1.0f / L;
#pragma unroll
        for (int c = 0; c < 4; ++c)
#pragma unroll
            for (int g4 = 0; g4 < 4; ++g4) { u32x2 w; w.x = pk_f16(o[c][4 * g4] * inv, o[c][4 * g4 + 1] * inv); w.y = pk_f16(o[c][4 * g4 + 2] * inv, o[c][4 * g4 + 3] * inv);
                *(u32x2*)(Ob + (size_t)t * 2048 + h * 128 + 32 * c + 8 * g4 + 4 * hh) = w; }
    }
}

__device__ __forceinline__ void phase_dsa_qk(const P& p, LAS unsigned char* lds, int la) {
    const int tid = otid(), lane = tid & 63, wave = __builtin_amdgcn_readfirstlane(tid >> 6);
    const int n = lane & 15, kq = lane >> 4;
    LAS unsigned char* Ki = lds + wave * 9216;
    LAS int* sl = (LAS int*)(Ki + 8192);
    LAS int* grab = (LAS int*)(lds + 8 * 9216);
    const f16_t* Qb = (const f16_t*)(p.ws + WS_Q); const f16_t* Kb = (const f16_t*)(p.ws + WS_K);
    const int* SELb = (const int*)(p.ws + WS_SEL); f16_t* PG = (f16_t*)(p.ws + WS_PO);
    unsigned* qhead = (unsigned*)(p.ws + WS_CTL) + CW_DSAQ + la * 512;
    const float scale = 0.08838834764831845f;
    const int xcc = (int)xb_xcc_id();
    unsigned wa[8], ra[2][4];
#pragma unroll
    for (int i2 = 0; i2 < 8; ++i2) wa[i2] = off_b(4 * i2 + kq, n);
#pragma unroll
    for (int rb = 0; rb < 2; ++rb)
#pragma unroll
        for (int s4 = 0; s4 < 4; ++s4) ra[rb][s4] = off_b(n + 16 * rb, 4 * s4 + kq);
    for (int gi = 0; gi < 4; ++gi) {
        const int g = (xcc + gi) & 3;
        const f16_t* Kg = Kb + (size_t)g * S_ * 128;
        for (;;) {
            __syncthreads();
            if (tid == 0) grab[0] = (int)atomicAdd(qhead + g * 64, 32u);
            __syncthreads();
            const int t0 = grab[0];
            if (t0 >= S_) break;
#pragma unroll 1
            for (int ti = 0; ti < 4; ++ti) {
            const int t = t0 + 8 * ti + wave;
            { const u32x4 v = __builtin_nontemporal_load((const u32x4*)(SELb + (size_t)t * NSEL + 4 * lane)); *(LAS u32x4*)(sl + 4 * lane) = v; }
            f16x8 A[4];
            { const f16_t* qp = Qb + (size_t)t * 2048 + (4 * g + (n & 3)) * 128 + 8 * kq;
#pragma unroll
                for (int s4 = 0; s4 < 4; ++s4) { const f16x8 qv = __builtin_nontemporal_load((const f16x8*)(qp + 32 * s4));
#pragma unroll
                    for (int j = 0; j < 8; ++j) A[s4][j] = (n < 4) ? qv[j] : (_Float16)0.f; } }
            asm volatile("s_waitcnt lgkmcnt(0)" ::: "memory");
            f32x4 Sg[16]; f16x8 vr[8];
#define QK_GATHER(st) do { _Pragma("unroll") for (int i2 = 0; i2 < 8; ++i2) { const int key_ = sl[32 * (st) + 4 * i2 + kq]; const unsigned kc_ = key_ < 0 ? 0u : (unsigned)key_; \
                vr[i2] = *(const f16x8*)((const char*)Kg + kc_ * 256u + 16u * (unsigned)n); } } while (0)
            QK_GATHER(0);
#pragma unroll
            for (int st = 0; st < 8; ++st) {
#pragma unroll
                for (int i2 = 0; i2 < 8; ++i2) *(LAS f16x8*)(Ki + wa[i2]) = vr[i2];
                __builtin_amdgcn_sched_barrier(0);
                if (st + 1 < 8) QK_GATHER(st + 1);
                __builtin_amdgcn_sched_barrier(0);
#pragma unroll
                for (int rb = 0; rb < 2; ++rb) { f32x4 c = {0.f, 0.f, 0.f, 0.f};
#pragma unroll
                    for (int s4 = 0; s4 < 4; ++s4) c = __builtin_amdgcn_mfma_f32_16x16x32_f16(A[s4], *(const LAS f16x8*)(Ki + ra[rb][s4]), c, 0, 0, 0);
                    const bool valid = sl[32 * st + 16 * rb + n] >= 0;
#pragma unroll
                    for (int i = 0; i < 4; ++i) Sg[2 * st + rb][i] = (valid && kq == 0) ? c[i] * scale : -INFINITY; }
                asm volatile("s_waitcnt lgkmcnt(0)" ::: "memory");
                __builtin_amdgcn_sched_barrier(0);
            }
#undef QK_GATHER
            float mx[4], lsum[4];
#pragma unroll
            for (int i = 0; i < 4; ++i) { float m = Sg[0][i];
#pragma unroll
                for (int tile = 1; tile < 16; ++tile) m = fmaxf(m, Sg[tile][i]);
                mx[i] = wave_max(m); lsum[i] = 0.f; }
#pragma unroll
            for (int tile = 0; tile < 16; ++tile)
#pragma unroll
                for (int i = 0; i < 4; ++i) { Sg[tile][i] = __expf(Sg[tile][i] - mx[i]); lsum[i] += Sg[tile][i]; }
            float inv[4];
#pragma unroll
            for (int i = 0; i < 4; ++i) inv[i] = 1.0f / wave_sum(lsum[i]);
            { _Float16* pg = (_Float16*)PG + ((size_t)t * 4 + g) * 1024 + kq * 256 + n;
#pragma unroll
                for (int tile = 0; tile < 16; ++tile) { const float p0 = __shfl(Sg[tile][0] * inv[0], n), p1 = __shfl(Sg[tile][1] * inv[1], n), p2 = __shfl(Sg[tile][2] * inv[2], n), p3 = __shfl(Sg[tile][3] * inv[3], n);
                    const float pm = kq == 0 ? p0 : (kq == 1 ? p1 : (kq == 2 ? p2 : p3)); pg[16 * tile] = (_Float16)pm; } }
            asm volatile("s_waitcnt lgkmcnt(0)" ::: "memory");
            }
        }
    }
}
__device__ __forceinline__ void phase_dsa_pv(const P& p, LAS unsigned char* lds, int la) {
    const int tid = otid(), lane = tid & 63, wave = __builtin_amdgcn_readfirstlane(tid >> 6);
    const int n = lane & 15, kq = lane >> 4;
    LAS unsigned char* Vi = lds + wave * 10240;
    LAS int* sl = (LAS int*)(Vi + 8192);
    LAS _Float16* ost = (LAS _Float16*)(Vi + 9216);
    LAS int* grab = (LAS int*)(lds + 8 * 10240);
    const f16_t* Vb = (const f16_t*)(p.ws + WS_V); const int* SELb = (const int*)(p.ws + WS_SEL); const f16_t* PG = (const f16_t*)(p.ws + WS_PO); f16_t* Ob = (f16_t*)(p.ws + WS_O);
    unsigned* qhead = (unsigned*)(p.ws + WS_CTL) + CW_DSAQ + la * 512 + 256;
    const int xcc = (int)xb_xcc_id();
    unsigned wa[8], ta[8][2];
#pragma unroll
    for (int i2 = 0; i2 < 8; ++i2) wa[i2] = off_b(4 * i2 + kq, n);
    { const unsigned q4 = (lane & 15) >> 2, p4 = lane & 3;
#pragma unroll
        for (int c = 0; c < 8; ++c)
#pragma unroll
            for (int t2 = 0; t2 < 2; ++t2) ta[c][t2] = off_b(8 * kq + 4 * t2 + q4, 2 * c + (p4 >> 1)) + 8 * (p4 & 1); }
    for (int gi = 0; gi < 4; ++gi) {
        const int g = (xcc + gi) & 3;
        const f16_t* Vg = Vb + (size_t)g * S_ * 128;
        for (;;) {
            __syncthreads();
            if (tid == 0) grab[0] = (int)atomicAdd(qhead + g * 64, 32u);
            __syncthreads();
            const int t0 = grab[0];
            if (t0 >= S_) break;
#pragma unroll 1
            for (int ti = 0; ti < 4; ++ti) {
            const int t = t0 + 8 * ti + wave;
            { const u32x4 v = __builtin_nontemporal_load((const u32x4*)(SELb + (size_t)t * NSEL + 4 * lane)); *(LAS u32x4*)(sl + 4 * lane) = v; }
            f16x8 A[8];
            { const f16_t* pg = PG + ((size_t)t * 4 + g) * 1024 + (n & 3) * 256 + 8 * kq;
#pragma unroll
                for (int st = 0; st < 8; ++st) { const f16x8 pv = __builtin_nontemporal_load((const f16x8*)(pg + 32 * st));
#pragma unroll
                    for (int j = 0; j < 8; ++j) A[st][j] = (n < 4) ? pv[j] : (_Float16)0.f; } }
            asm volatile("s_waitcnt lgkmcnt(0)" ::: "memory");
            f32x4 acc[8];
#pragma unroll
            for (int c = 0; c < 8; ++c) acc[c] = (f32x4){0.f, 0.f, 0.f, 0.f};
            f16x8 vr[8];
#define PV_GATHER(st) do { _Pragma("unroll") for (int i2 = 0; i2 < 8; ++i2) { const int key_ = sl[32 * (st) + 4 * i2 + kq]; const unsigned kc_ = key_ < 0 ? 0u : (unsigned)key_; \
                vr[i2] = *(const f16x8*)((const char*)Vg + kc_ * 256u + 16u * (unsigned)n); } } while (0)
            PV_GATHER(0);
#pragma unroll 1
            for (int st = 0; st < 8; ++st) {
#pragma unroll
                for (int i2 = 0; i2 < 8; ++i2) *(LAS f16x8*)(Vi + wa[i2]) = vr[i2];
                __builtin_amdgcn_sched_barrier(0);
                if (st + 1 < 8) PV_GATHER(st + 1);
                __builtin_amdgcn_sched_barrier(0);
                const f16x8 a = st == 0 ? A[0] : (st == 1 ? A[1] : (st == 2 ? A[2] : (st == 3 ? A[3] : (st == 4 ? A[4] : (st == 5 ? A[5] : (st == 6 ? A[6] : A[7]))))));
#pragma unroll
                for (int c = 0; c < 8; ++c) { const f16x4 v0 = tr16(Vi + ta[c][0]), v1 = tr16(Vi + ta[c][1]);
                    const f16x8 b = __builtin_shufflevector(v0, v1, 0, 1, 2, 3, 4, 5, 6, 7);
                    acc[c] = __builtin_amdgcn_mfma_f32_16x16x32_f16(a, b, acc[c], 0, 0, 0); }
                asm volatile("s_waitcnt lgkmcnt(0)" ::: "memory");
                __builtin_amdgcn_sched_barrier(0);
            }
#undef PV_GATHER
            if (kq == 0) {
#pragma unroll
                for (int c = 0; c < 8; ++c)
#pragma unroll
                    for (int i = 0; i < 4; ++i) ost[i * 128 + 16 * c + n] = (_Float16)acc[c][i]; }
            asm volatile("s_waitcnt lgkmcnt(0)" ::: "memory");
            { const u32x4 o = *(const LAS u32x4*)((const LAS unsigned char*)ost + 16 * lane);
              __builtin_nontemporal_store(o, (u32x4*)(Ob + (size_t)t * 2048 + (4 * g) * 128 + 8 * lane)); }
            asm volatile("s_waitcnt lgkmcnt(0)" ::: "memory");
            }
        }
    }
}

__device__ __forceinline__ void side_gemm_kiwi(const P& p, LAS unsigned char* lds, int li) {
    const int tid = otid(), lane = tid & 63, wave = __builtin_amdgcn_readfirstlane(tid >> 6), bid = obid();
    const int n = lane & 15, kq = lane >> 4;
    const f16_t* H = (const f16_t*)(p.ws + WS_H); const f16_t* Wt = (const f16_t*)(p.ws + WS_WAIN) + (size_t)li * A_INP * D_ + (size_t)4096 * D_;
    const float* rope = (const float*)(p.ws + WS_ROPE); const float* rcI = rope + S_ * 32; const float* rsI = rope + S_ * 40;
    f16_t* KI = (f16_t*)(p.ws + WS_KI); float* WI = (float*)(p.ws + WS_WI);
    LAS float* part = (LAS float*)lds;
    LAS float* fin = (LAS float*)(lds + 81920);
    for (int rb = bid; rb < S_ / 32; rb += (int)gridDim.x) {
        const int row0 = 32 * rb;
        f32x4 c[2][5];
#pragma unroll
        for (int mt = 0; mt < 2; ++mt)
#pragma unroll
            for (int nt = 0; nt < 5; ++nt) c[mt][nt] = (f32x4){0.f, 0.f, 0.f, 0.f};
#pragma unroll 1
        for (int k4 = 0; k4 < 2; ++k4) {
            f16x8 a[4][2], b[4][5];
#pragma unroll
            for (int u = 0; u < 4; ++u) { const int ks = 8 * wave + 4 * k4 + u;
#pragma unroll
                for (int mt = 0; mt < 2; ++mt) a[u][mt] = *(const f16x8*)(H + (size_t)(row0 + 16 * mt + n) * D_ + 32 * ks + 8 * kq);
#pragma unroll
                for (int nt = 0; nt < 5; ++nt) b[u][nt] = *(const f16x8*)(Wt + (size_t)(16 * nt + n) * D_ + 32 * ks + 8 * kq); }
            __builtin_amdgcn_sched_barrier(0);
#pragma unroll
            for (int u = 0; u < 4; ++u)
#pragma unroll
                for (int mt = 0; mt < 2; ++mt)
#pragma unroll
                    for (int nt = 0; nt < 5; ++nt) c[mt][nt] = __builtin_amdgcn_mfma_f32_16x16x32_f16(a[u][mt], b[u][nt], c[mt][nt], 0, 0, 0);
        }
        __syncthreads();
#pragma unroll
        for (int mt = 0; mt < 2; ++mt)
#pragma unroll
            for (int nt = 0; nt < 5; ++nt)
#pragma unroll
                for (int i = 0; i < 4; ++i) part[(wave * 32 + 16 * mt + 4 * kq + i) * 80 + 16 * nt + n] = c[mt][nt][i];
        __syncthreads();
        for (int idx = tid; idx < 32 * 80; idx += 512) { float sum = 0.f;
#pragma unroll
            for (int w2 = 0; w2 < 8; ++w2) sum += part[w2 * 2560 + idx];
            fin[idx] = sum; }
        __syncthreads();
        for (int idx = tid; idx < 32 * 80; idx += 512) { const int r = idx / 80, col = idx - 80 * r, t = row0 + r; const float v = fin[idx];
            if (col < 64) { float o = v;
                if (col < 16) { const float pv = fin[r * 80 + (col ^ 8)], cc = rcI[(size_t)t * 8 + (col & 7)], ss = rsI[(size_t)t * 8 + (col & 7)]; o = (col < 8) ? v * cc - pv * ss : v * cc + pv * ss; }
                ((_Float16*)KI)[(size_t)t * 64 + col] = (_Float16)o; }
            else WI[(size_t)t * 16 + (col - 64)] = v * 0.03125f; }
    }
}

__device__ __forceinline__ void phase_dsa_attn3(const P& p, LAS unsigned char* lds, int la) {
    const int tid = otid(), lane = tid & 63, wave = __builtin_amdgcn_readfirstlane(tid >> 6);
    const int n = lane & 15, kq = lane >> 4;
    LAS unsigned char* Im = lds + wave * 16384;
    LAS int* sl = (LAS int*)(Im + 8192);
    LAS _Float16* Pl = (LAS _Float16*)(Im + 9216);
    LAS _Float16* ost = (LAS _Float16*)(Im + 11264);
    LAS int* grab = (LAS int*)(lds + 8 * 16384);
    unsigned* cq = (unsigned*)(p.ws + WS_CTL) + CW_CONVQ + la * 64; const int cstage = 1 + la, ccount = conv_count(cstage); bool cmore = (MK_CONV_HOST == 0);
    const f16_t* Qb = (const f16_t*)(p.ws + WS_Q); const f16_t* Kb = (const f16_t*)(p.ws + WS_K); const f16_t* Vb = (const f16_t*)(p.ws + WS_V);
    const int* SELb = (const int*)(p.ws + WS_SEL); f16_t* Ob = (f16_t*)(p.ws + WS_O);
    unsigned* qhead = (unsigned*)(p.ws + WS_CTL) + CW_DSAQ + la * 512;
    const float scale = 0.08838834764831845f;
    const int xcc = (int)xb_xcc_id();
    unsigned wa[8], ra[2][4], ta[8][2];
#pragma unroll
    for (int i2 = 0; i2 < 8; ++i2) wa[i2] = off_b(4 * i2 + kq, n);
#pragma unroll
    for (int rb = 0; rb < 2; ++rb)
#pragma unroll
        for (int s4 = 0; s4 < 4; ++s4) ra[rb][s4] = off_b(n + 16 * rb, 4 * s4 + kq);
    { const unsigned q4 = (lane & 15) >> 2, p4 = lane & 3;
#pragma unroll
        for (int c = 0; c < 8; ++c)
#pragma unroll
            for (int t2 = 0; t2 < 2; ++t2) ta[c][t2] = off_b(8 * kq + 4 * t2 + q4, 2 * c + (p4 >> 1)) + 8 * (p4 & 1); }
    for (int gi = 0; gi < 4; ++gi) {
        const int g = (xcc + gi) & 3;
        const f16_t* Kg = Kb + (size_t)g * S_ * 128; const f16_t* Vg = Vb + (size_t)g * S_ * 128;
        for (;;) {
            __syncthreads();
            if (tid == 0) grab[0] = (int)atomicAdd(qhead + g * 64, 32u);
            __syncthreads();
            const int t0 = grab[0];
            if (t0 >= S_) break;
            u32x4 selv; f16x8 qraw[4];
#define AT_ITEM_LOAD(tt) do { selv = __builtin_nontemporal_load((const u32x4*)(SELb + (size_t)(tt) * NSEL + 4 * lane)); \
                const f16_t* qp_ = Qb + (size_t)(tt) * 2048 + (4 * g + (n & 3)) * 128 + 8 * kq; \
                _Pragma("unroll") for (int s4 = 0; s4 < 4; ++s4) qraw[s4] = __builtin_nontemporal_load((const f16x8*)(qp_ + 32 * s4)); } while (0)
            AT_ITEM_LOAD(t0 + wave);
#pragma unroll 1
            for (int ti = 0; ti < 4; ++ti) {
            const int t = t0 + 8 * ti + wave;
            *(LAS u32x4*)(sl + 4 * lane) = selv;
            f16x8 A[4];
#pragma unroll
            for (int s4 = 0; s4 < 4; ++s4) {
#pragma unroll
                for (int j = 0; j < 8; ++j) A[s4][j] = (n < 4) ? qraw[s4][j] : (_Float16)0.f; }
            asm volatile("s_waitcnt lgkmcnt(0)" ::: "memory");
            f16x8 vr[8];
#define AT_GATHER(base, st) do { _Pragma("unroll") for (int i2 = 0; i2 < 8; ++i2) { const int key_ = sl[32 * (st) + 4 * i2 + kq]; const unsigned kc_ = key_ < 0 ? 0u : (unsigned)key_; \
                vr[i2] = *(const f16x8*)((const char*)(base) + kc_ * 256u + 16u * (unsigned)n); } } while (0)
            f32x4 Sg[16];
            AT_GATHER(Kg, 0);
#pragma unroll
            for (int st = 0; st < 8; ++st) {
#pragma unroll
                for (int i2 = 0; i2 < 8; ++i2) *(LAS f16x8*)(Im + wa[i2]) = vr[i2];
                __builtin_amdgcn_sched_barrier(0);
                if (st + 1 < 8) AT_GATHER(Kg, st + 1); else AT_GATHER(Vg, 0);
                __builtin_amdgcn_sched_barrier(0);
                f16x8 kfr[2][4];
#pragma unroll
                for (int rb = 0; rb < 2; ++rb)
#pragma unroll
                    for (int s4 = 0; s4 < 4; ++s4) kfr[rb][s4] = *(const LAS f16x8*)(Im + ra[rb][s4]);
                __builtin_amdgcn_sched_barrier(0);
#pragma unroll
                for (int rb = 0; rb < 2; ++rb) { f32x4 c = {0.f, 0.f, 0.f, 0.f};
#pragma unroll
                    for (int s4 = 0; s4 < 4; ++s4) c = __builtin_amdgcn_mfma_f32_16x16x32_f16(A[s4], kfr[rb][s4], c, 0, 0, 0);
                    const bool valid = sl[32 * st + 16 * rb + n] >= 0;
#pragma unroll
                    for (int i = 0; i < 4; ++i) Sg[2 * st + rb][i] = (valid && kq == 0) ? c[i] * scale : -INFINITY; }
                asm volatile("s_waitcnt lgkmcnt(0)" ::: "memory");
                __builtin_amdgcn_sched_barrier(0);
            }
            float mx[4], lsum[4];
#pragma unroll
            for (int i = 0; i < 4; ++i) { float m = Sg[0][i];
#pragma unroll
                for (int tile = 1; tile < 16; ++tile) m = fmaxf(m, Sg[tile][i]);
                const float rm = row16_max(m); mx[i] = (kq == 0) ? rm : 0.f; lsum[i] = 0.f; }
#pragma unroll
            for (int tile = 0; tile < 16; ++tile)
#pragma unroll
                for (int i = 0; i < 4; ++i) { Sg[tile][i] = __expf(Sg[tile][i] - mx[i]); lsum[i] += Sg[tile][i]; }
            float inv[4];
#pragma unroll
            for (int i = 0; i < 4; ++i) inv[i] = 1.0f / row16_sum(lsum[i]);
            if (kq == 0) {
#pragma unroll
                for (int tile = 0; tile < 16; ++tile)
#pragma unroll
                    for (int i = 0; i < 4; ++i) Pl[i * 256 + 16 * tile + n] = (_Float16)(Sg[tile][i] * inv[i]); }
            asm volatile("s_waitcnt lgkmcnt(0)" ::: "memory");
            if (ti + 1 < 4) AT_ITEM_LOAD(t + 8);
            __builtin_amdgcn_sched_barrier(0);
            f32x4 acc[8];
#pragma unroll
            for (int c = 0; c < 8; ++c) acc[c] = (f32x4){0.f, 0.f, 0.f, 0.f};
#pragma unroll 1
            for (int st = 0; st < 8; ++st) {
#pragma unroll
                for (int i2 = 0; i2 < 8; ++i2) *(LAS f16x8*)(Im + wa[i2]) = vr[i2];
                __builtin_amdgcn_sched_barrier(0);
                if (st + 1 < 8) AT_GATHER(Vg, st + 1);
                __builtin_amdgcn_sched_barrier(0);
                f16x4 tv[8][2];
                f16x8 a = *(const LAS f16x8*)(Pl + (n & 3) * 256 + 32 * st + 8 * kq);
#pragma unroll
                for (int j = 0; j < 8; ++j) a[j] = (n < 4) ? a[j] : (_Float16)0.f;
#pragma unroll
                for (int c = 0; c < 8; ++c) { tv[c][0] = tr16(Im + ta[c][0]); tv[c][1] = tr16(Im + ta[c][1]); }
                __builtin_amdgcn_sched_barrier(0);
#pragma unroll
                for (int c = 0; c < 8; ++c) {
                    const f16x8 b = __builtin_shufflevector(tv[c][0], tv[c][1], 0, 1, 2, 3, 4, 5, 6, 7);
                    acc[c] = __builtin_amdgcn_mfma_f32_16x16x32_f16(a, b, acc[c], 0, 0, 0); }
                asm volatile("s_waitcnt lgkmcnt(0)" ::: "memory");
                __builtin_amdgcn_sched_barrier(0);
            }
#undef AT_GATHER
            if (kq == 0) {
#pragma unroll
                for (int c = 0; c < 8; ++c)
#pragma unroll
                    for (int i = 0; i < 4; ++i) ost[i * 128 + 16 * c + n] = (_Float16)acc[c][i]; }
            asm volatile("s_waitcnt lgkmcnt(0)" ::: "memory");
            { const u32x4 o = *(const LAS u32x4*)((const LAS unsigned char*)ost + 16 * lane);
              __builtin_nontemporal_store(o, (u32x4*)(Ob + (size_t)t * 2048 + (4 * g) * 128 + 8 * lane)); }
            asm volatile("s_waitcnt lgkmcnt(0)" ::: "memory");
            if (cmore) { int j = 0; if (lane == 0) j = (int)atomicAdd(cq, 1u); j = __builtin_amdgcn_readfirstlane(j);
                if (j < ccount) conv_item<true>(p, (LAS float*)Im, conv_map(cstage, j), lane); else cmore = false; }
            }
        }
    }
    while (cmore) { int j = 0; if (lane == 0) j = (int)atomicAdd(cq, 1u); j = __builtin_amdgcn_readfirstlane(j);
        if (j < ccount) conv_item<true>(p, (LAS float*)Im, conv_map(cstage, j), lane); else cmore = false; }
}

#ifndef MK_PRIO
#define MK_PRIO 15
#endif
#define PRIO_ON(bit) do { if ((MK_PRIO & (bit)) && (threadIdx.x >> 6) >= 4) __builtin_amdgcn_s_setprio(1); } while (0)
#define PRIO_OFF(bit) do { if (MK_PRIO & (bit)) __builtin_amdgcn_s_setprio(0); } while (0)
#ifndef MK_DUP
#define MK_DUP 0
#endif
#ifndef MK_SPLIT
#define MK_SPLIT 0
#endif
struct Args { P p; int ph_lo, ph_hi; };
__global__ void __launch_bounds__(512, 2) fwd(Args a) {
    extern __shared__ __attribute__((aligned(16))) unsigned char lds_raw[];
    LAS unsigned char* lds = (LAS unsigned char*)lds_raw;
    const P& p = a.p;
    volatile LAS unsigned* MISC = (volatile LAS unsigned*)(lds + LDS_MISC);
    for (int u = threadIdx.x; u < (LDS_BYTES - LDS_MISC) / 4; u += 512) MISC[u] = 0u;
    __syncthreads();
    unsigned* barw = (unsigned*)(p.ws + WS_CTL) + 4096;
    XcdBarrier bar; bar.bar = barw; bar.x = 0; bar.st = nullptr;
    if (!MK_SPLIT) bar = xcd_barrier_post(barw, MISC + 8);
    int ph = 0;
#define RUN(...) do { if (a.ph_lo <= ph && ph < a.ph_hi) { __VA_ARGS__; if (!MK_SPLIT && ph + 1 < a.ph_hi) xcd_barrier(bar); } ++ph; } while (0)
    const float* rope = (const float*)(p.ws + WS_ROPE);
    unsigned char* ws = p.ws;
    RUN({ phase_prologue(p, lds); if (MK_DUP & 32) { __syncthreads(); phase_prologue(p, lds); } });
    RUN(phase_mod_reduce(p));
    RUN({ phase_norm(p, 0, 0); if (MK_DUP & 64) { __syncthreads(); phase_norm(p, 0, 0); } });
    for (int l = 0; l < 4; ++l) {
        const int li = l >> 1;
        if ((l & 1) == 0) {
            RUN({ pg8::Gemm g{(const f16_t*)(ws + WS_H), (const f16_t*)(ws + WS_WAIN) + (size_t)li * A_INP * D_, S_, 4096, D_, 0};
                  pg8::EpiIn<0> E{(f16_t*)(ws + WS_Q), (f16_t*)(ws + WS_K), (f16_t*)(ws + WS_V), (f16_t*)(ws + WS_QI), (f16_t*)(ws + WS_KI), (float*)(ws + WS_WI), nullptr, rope, rope + S_ * 16, rope + S_ * 32, rope + S_ * 40};
                  pg8::StaticOrder S; S.init(S_, 4096, (int)gridDim.x, obid());
                  pg8::gemm_phase<pg8::EpiIn<0>, pg8::StaticOrder, true>(lds, g, S, E);
                  side_gemm_kiwi(p, lds, li); });
            RUN({ if (MK_DUP & 128) { phase_idx_topk<1>(p, lds, -1); __syncthreads(); } if (MK_DUP & 256) { phase_idx_topk<2>(p, lds, -1); __syncthreads(); } PRIO_ON(1); phase_idx_topk<3>(p, lds, MK_CONV_HOST == 1 ? 1 + li : -1); PRIO_OFF(1); if (MK_DUP & 1) { __syncthreads(); phase_idx_topk<3>(p, lds, -1); } });
            RUN({ PRIO_ON(2); phase_dsa_attn3(p, lds, li); PRIO_OFF(2); });
            RUN({ pg8::Gemm g{(const f16_t*)(ws + WS_O), (const f16_t*)(ws + WS_WAO) + (size_t)li * D_ * D_, S_, D_, D_, 0};
                  pg8::EpiF16 E{(f16_t*)(ws + WS_Y), D_, 0};
                  pg8::StaticOrder S; S.init(S_, D_, (int)gridDim.x, obid());
                  pg8::gemm_phase<pg8::EpiF16, pg8::StaticOrder, false>(lds, g, S, E); });
        } else {
            RUN({ pg8::Gemm g{(const f16_t*)(ws + WS_H), (const f16_t*)(ws + WS_WBIN) + (size_t)li * B_IN * D_, S_, B_IN, D_, 0};
                  pg8::EpiIn<1> E{(f16_t*)(ws + WS_Q), (f16_t*)(ws + WS_K), (f16_t*)(ws + WS_V), nullptr, nullptr, nullptr, (float*)(ws + WS_KSUM) + (size_t)li * 65536, rope, rope + S_ * 16, rope + S_ * 32, rope + S_ * 40};
                  pg8::StaticOrder S; S.init(S_, B_IN, (int)gridDim.x, obid());
                  pg8::gemm_phase<pg8::EpiIn<1>, pg8::StaticOrder, true>(lds, g, S, E); });
            RUN(phase_moba_gate(p, li));
            RUN({ PRIO_ON(4); phase_moba_past(p, lds, li); PRIO_OFF(4); if (MK_DUP & 8) { __syncthreads(); phase_moba_past(p, lds, li); } });
            RUN({ PRIO_ON(8); phase_moba_own(p, lds); PRIO_OFF(8); if (MK_DUP & 16) { __syncthreads(); phase_moba_own(p, lds); } });
            RUN({ pg8::Gemm g{(const f16_t*)(ws + WS_O), (const f16_t*)(ws + WS_WBO) + (size_t)li * D_ * D_, S_, D_, D_, 0};
                  pg8::EpiF16 E{(f16_t*)(ws + WS_Y), D_, 0};
                  pg8::StaticOrder S; S.init(S_, D_, (int)gridDim.x, obid());
                  pg8::gemm_phase<pg8::EpiF16, pg8::StaticOrder, false>(lds, g, S, E); });
        }
        RUN(phase_norm(p, 1, l));
        RUN({ pg8::Gemm g{(const f16_t*)(ws + WS_H), (const f16_t*)(ws + WS_WF1) + (size_t)l * 2 * DFF * D_, S_, 2 * DFF, D_, 0};
              pg8::EpiSwiglu E{(f16_t*)(ws + WS_ACT), DFF, 0};
              pg8::SplitTailOrder S; S.init(S_, 2 * DFF, (int)gridDim.x, obid(), (float*)(ws + WS_PB), (unsigned*)(ws + WS_CTL) + CW_SPLIT + l * 128);
              pg8::gemm_phase<pg8::EpiSwiglu, pg8::SplitTailOrder, true>(lds, g, S, E); });
        RUN({ pg8::Gemm g{(const f16_t*)(ws + WS_ACT), (const f16_t*)(ws + WS_WF2) + (size_t)l * D_ * DFF, S_, D_, DFF, 0};
              pg8::EpiF16 E{(f16_t*)(ws + WS_Y), D_, 0};
              pg8::StaticOrder S; S.init(S_, D_, (int)gridDim.x, obid());
              pg8::gemm_phase<pg8::EpiF16, pg8::StaticOrder, false>(lds, g, S, E);
              if (MK_DUP & 2048) { __syncthreads(); pg8::gemm_phase<pg8::EpiF16, pg8::StaticOrder, false>(lds, g, S, E); } });
        RUN(phase_norm(p, 2, l));
    }
#undef RUN
}
constexpr int N_PHASES = 3 + 2 * 8 + 2 * 9;

extern "C" void kernel_launch(void* const* d_in, const int* in_sizes, int n_in, void* d_out, int out_size, void* d_ws, size_t ws_size, hipStream_t stream) {
    if (n_in != 12 || ws_size < WS_END) { fprintf(stderr, "kernel_launch: unexpected inputs (n_in %d, ws %zu < %zu)\n", n_in, ws_size, (size_t)WS_END); return; }
    static int grid = 0;
    if (!grid) { int dev = 0, cus = 0, per_cu = 0; (void)hipGetDevice(&dev); (void)hipDeviceGetAttribute(&cus, hipDeviceAttributeMultiprocessorCount, dev);
        if (hipFuncSetAttribute((const void*)fwd, hipFuncAttributeMaxDynamicSharedMemorySize, LDS_BYTES) != hipSuccess) { fprintf(stderr, "kernel_launch: hipFuncSetAttribute failed\n"); grid = -1; return; }
        if (hipOccupancyMaxActiveBlocksPerMultiprocessor(&per_cu, (const void*)fwd, 512, LDS_BYTES) != hipSuccess || per_cu < 1) fprintf(stderr, "kernel_launch: note: occupancy query reports %d workgroups per CU\n", per_cu);
        (void)hipGetLastError();
        grid = cus > 0 ? cus : 256; }
    if (grid < 0) return;
    (void)hipMemsetAsync((char*)d_ws + WS_CTL, 0, 1 * MiB, stream);
    Args a{}; a.p.x = (const float*)d_in[0]; a.p.c = (const float*)d_in[1]; a.p.pos = (const int*)d_in[2]; a.p.a_w_in = (const float*)d_in[3]; a.p.a_w_o = (const float*)d_in[4];
    a.p.b_w_in = (const float*)d_in[5]; a.p.b_w_o = (const float*)d_in[6]; a.p.ada_w = (const float*)d_in[7]; a.p.ada_b = (const float*)d_in[8]; a.p.norm_g = (const float*)d_in[9];
    a.p.ffn_w_in = (const float*)d_in[10]; a.p.ffn_w_out = (const float*)d_in[11]; a.p.out = (float*)d_out; a.p.ws = (unsigned char*)d_ws;
    if (MK_SPLIT) { for (int ph = 0; ph < N_PHASES; ++ph) { a.ph_lo = ph; a.ph_hi = ph + 1; hipLaunchKernelGGL(fwd, dim3(grid), dim3(512), LDS_BYTES, stream, a); } }
    else { a.ph_lo = 0; a.ph_hi = N_PHASES; hipLaunchKernelGGL(fwd, dim3(grid), dim3(512), LDS_BYTES, stream, a); }
}
```
